# Optimizing an MI355X kernel written in HIP

```python
import math
import jax, jax.numpy as jnp
from jax import lax

D_MODEL = 1024
BATCH = 4
SEQ = 4096
DEPTH = 2

RET_HEADS = 4
RET_DK = 128
RET_DV = 128
RET_CHUNK = 128
ROPE_BASE = 10000.0
S5_WIDTH = D_MODEL // 2
S5_GROUP = 16
S5_GROUPS = S5_WIDTH // S5_GROUP
S5_STATE = 64
S5_DT_MIN = 1e-3
S5_DT_MAX = 1e-1
ATT_HEADS = 8
ATT_DH = D_MODEL // ATT_HEADS
DILATED_BRANCHES = ((128, 1), (512, 4), (2048, 16))
N_GROUPS = 4
EXPERTS_PER_GROUP = 4
TOP_K = 2
D_EXPERT = 512
RMS_EPS = 1e-6
GN_EPS = 1e-6
N_EVEN = (DEPTH + 1) // 2
N_ODD = DEPTH // 2
RET_QK_W = RET_HEADS * RET_DK
RET_V_W = RET_HEADS * RET_DV
AB_IN_W = 2 * RET_QK_W + 2 * RET_V_W + S5_WIDTH
AB_OUT_W = RET_V_W + S5_WIDTH

kernel_name = "hybrid_retention_s5_dilated_hmoe"


def rmsnorm(x, g):
    xf = x.astype(jnp.float32)
    y = xf * lax.rsqrt(jnp.mean(xf * xf, axis=-1, keepdims=True) + RMS_EPS)
    return (y * g.astype(jnp.float32)).astype(x.dtype)


def rotary(x, pos):
    half = x.shape[-1] // 2
    inv = ROPE_BASE ** (-jnp.arange(half, dtype=jnp.float32) / half)
    ang = pos.astype(jnp.float32)[:, None] * inv[None, :]
    cos = jnp.cos(ang)[None, :, None, :]
    sin = jnp.sin(ang)[None, :, None, :]
    xf = x.astype(jnp.float32)
    x1, x2 = xf[..., :half], xf[..., half:]
    return jnp.concatenate([x1 * cos - x2 * sin, x1 * sin + x2 * cos], axis=-1)


def retention(q, k, v):
    B, L, H, _ = q.shape
    C = RET_CHUNK
    N = L // C
    lg = jnp.log1p(-jnp.exp2(-5.0 - jnp.arange(H, dtype=jnp.float32)))
    idx = jnp.arange(C, dtype=jnp.float32)
    diff = idx[:, None] - idx[None, :]
    decay = jnp.where(diff[None] >= 0, jnp.exp(jnp.maximum(diff, 0.0)[None] * lg[:, None, None]), 0.0)
    xi = jnp.exp((idx + 1.0)[None, :] * lg[:, None])
    zeta = jnp.exp((C - 1.0 - idx)[None, :] * lg[:, None])
    chunk_decay = jnp.exp(C * lg)

    def to_chunks(t):
        return t.reshape(B, N, C, H, t.shape[-1]).transpose(0, 3, 1, 2, 4)

    qc, kc, vc = to_chunks(q), to_chunks(k), to_chunks(v)
    scores = jnp.einsum('bhncd,bhnsd->bhncs', qc, kc) * decay[None, :, None]
    intra = jnp.einsum('bhncs,bhnse->bhnce', scores, vc)
    kv = jnp.einsum('bhnsd,bhnse->bhnde', kc * zeta[None, :, None, :, None], vc)

    def step(state, kv_n):
        return state * chunk_decay[None, :, None, None] + kv_n, state

    init = jnp.zeros((B, H, kv.shape[-2], kv.shape[-1]), jnp.float32)
    _, prev = lax.scan(step, init, jnp.moveaxis(kv, 2, 0))
    prev = jnp.moveaxis(prev, 0, 2)
    cross = jnp.einsum('bhncd,bhnde->bhnce', qc * xi[None, :, None, :, None], prev)
    return (intra + cross).transpose(0, 2, 3, 1, 4).reshape(B, L, H, -1)


def s5_mixer(u, a_re, a_im, b_re, b_im, c_re, c_im, d_skip, log_dt, w_glu, b_glu):
    B, L, _ = u.shape
    f32 = jnp.float32
    uf = u.astype(f32).reshape(B, L, S5_GROUPS, S5_GROUP)
    a_re, a_im = a_re.astype(f32), a_im.astype(f32)
    b_re, b_im = b_re.astype(f32), b_im.astype(f32)
    dt = jnp.exp(log_dt.astype(f32))[:, None]
    zr, zi = a_re * dt, a_im * dt
    mag = jnp.exp(zr)
    lam_re, lam_im = mag * jnp.cos(zi), mag * jnp.sin(zi)
    nr, ni = lam_re - 1.0, lam_im
    den = a_re * a_re + a_im * a_im
    coef_re = (nr * a_re + ni * a_im) / den
    coef_im = (ni * a_re - nr * a_im) / den
    bb_re = coef_re[..., None] * b_re - coef_im[..., None] * b_im
    bb_im = coef_re[..., None] * b_im + coef_im[..., None] * b_re
    bu_re = jnp.einsum('blgh,gph->blgp', uf, bb_re)
    bu_im = jnp.einsum('blgh,gph->blgp', uf, bb_im)
    ar = jnp.broadcast_to(lam_re, bu_re.shape)
    ai = jnp.broadcast_to(lam_im, bu_im.shape)

    def combine(e1, e2):
        a1r, a1i, b1r, b1i = e1
        a2r, a2i, b2r, b2i = e2
        return (a1r * a2r - a1i * a2i,
                a1r * a2i + a1i * a2r,
                a2r * b1r - a2i * b1i + b2r,
                a2r * b1i + a2i * b1r + b2i)

    _, _, xr, xim = lax.associative_scan(combine, (ar, ai, bu_re, bu_im), axis=1)
    y = (jnp.einsum('blgp,ghp->blgh', xr, c_re.astype(f32))
         - jnp.einsum('blgp,ghp->blgh', xim, c_im.astype(f32))
         + d_skip.astype(f32) * uf)
    g = jax.nn.gelu(y.reshape(B, L, S5_WIDTH))
    return g * jax.nn.sigmoid(g @ w_glu.astype(f32) + b_glu.astype(f32))


def parallel_retention_s5(xn, w_in, w_out, a_re, a_im, b_re, b_im, c_re, c_im, d_skip, log_dt, w_glu, b_glu, pos):
    B, L, _ = xn.shape
    proj = xn @ w_in
    q, k, v, gate, u = jnp.split(
        proj, [RET_QK_W, 2 * RET_QK_W, 2 * RET_QK_W + RET_V_W, 2 * RET_QK_W + 2 * RET_V_W], axis=-1)
    q = rotary(q.reshape(B, L, RET_HEADS, RET_DK), pos)
    k = rotary(k.reshape(B, L, RET_HEADS, RET_DK), pos) * (RET_DK ** -0.5)
    v = v.astype(jnp.float32).reshape(B, L, RET_HEADS, RET_DV)
    o = retention(q, k, v)
    mu = jnp.mean(o, axis=-1, keepdims=True)
    var = jnp.mean(jnp.square(o - mu), axis=-1, keepdims=True)
    o = (o - mu) * lax.rsqrt(var + GN_EPS)
    ret_out = jax.nn.silu(gate.astype(jnp.float32)) * o.reshape(B, L, RET_V_W)
    s5_out = s5_mixer(u, a_re, a_im, b_re, b_im, c_re, c_im, d_skip, log_dt, w_glu, b_glu)
    merged = jnp.concatenate([ret_out, s5_out], axis=-1).astype(xn.dtype)
    return merged @ w_out


def dilated_branch(q, k, v, window, dilation):
    B, L, H, dh = q.shape
    band = window // dilation
    ls = L // dilation
    nb = -(-ls // band)
    pad = nb * band - ls

    def to_sub(t):
        t = t.reshape(B, ls, dilation, H, dh).transpose(0, 2, 3, 1, 4)
        t = jnp.pad(t, ((0, 0), (0, 0), (0, 0), (0, pad), (0, 0)))
        return t.reshape(B, dilation, H, nb, band, dh)

    def with_prev(t):
        prev = jnp.pad(t, ((0, 0), (0, 0), (0, 0), (1, 0), (0, 0), (0, 0)))[:, :, :, :-1]
        return jnp.concatenate([prev, t], axis=4)

    qs = to_sub(q)
    kb, vb = with_prev(to_sub(k)), with_prev(to_sub(v))
    s = jnp.einsum('brhnqd,brhnkd->brhnqk', qs, kb) * (dh ** -0.5)
    qi = jnp.arange(band)[:, None]
    kj = jnp.arange(2 * band)[None, :]
    dist = band + qi - kj
    in_band = (dist >= 0) & (dist <= band)
    has_prev = (jnp.arange(nb)[:, None, None] > 0) | (kj >= band)[None]
    valid = in_band[None] & has_prev
    s = jnp.where(valid, s, -jnp.inf)
    m = jnp.max(s, axis=-1, keepdims=True)
    p = jnp.exp(s - m)
    l = jnp.sum(p, axis=-1, keepdims=True)
    o = jnp.einsum('brhnqk,brhnkd->brhnqd', p, vb) / l
    lse = (m + jnp.log(l))[..., 0]
    o = o.reshape(B, dilation, H, nb * band, dh)[:, :, :, :ls].transpose(0, 3, 1, 2, 4).reshape(B, L, H, dh)
    lse = lse.reshape(B, dilation, H, nb * band)[..., :ls].transpose(0, 3, 1, 2).reshape(B, L, H)
    return o, lse


def dilated_attention(xn, w_qkv, w_out):
    B, L, _ = xn.shape
    qkv = (xn @ w_qkv).astype(jnp.float32).reshape(B, L, 3, ATT_HEADS, ATT_DH)
    q, k, v = qkv[:, :, 0], qkv[:, :, 1], qkv[:, :, 2]
    outs, lses = [], []
    for window, dilation in DILATED_BRANCHES:
        o, lse = dilated_branch(q, k, v, window, dilation)
        outs.append(o)
        lses.append(lse)
    wts = jax.nn.softmax(jnp.stack(lses, axis=0), axis=0)
    o = jnp.sum(wts[..., None] * jnp.stack(outs, axis=0), axis=0)
    return o.reshape(B, L, ATT_HEADS * ATT_DH).astype(xn.dtype) @ w_out


def hier_moe(xn, w_group, b_group, w_router, b_router, w_gate, w_up, w_down):
    B, L, D = xn.shape
    t = xn.reshape(B * L, D)
    tf = t.astype(jnp.float32)
    glog = tf @ w_group.astype(jnp.float32) + b_group.astype(jnp.float32)
    gval, gsel = lax.top_k(jax.nn.softmax(glog, axis=-1), 1)
    elog = jnp.einsum('td,dge->tge', tf, w_router.astype(jnp.float32)) + b_router.astype(jnp.float32)
    elog_sel = jnp.take_along_axis(elog, gsel[:, :, None], axis=1)[:, 0]
    top_v, top_i = lax.top_k(elog_sel, TOP_K)
    top_w = jax.nn.softmax(top_v, axis=-1) * gval
    w_in_group = jnp.sum(jax.nn.one_hot(top_i, EXPERTS_PER_GROUP) * top_w[..., None], axis=1)
    combine = jax.nn.one_hot(gsel[:, 0], N_GROUPS)[:, :, None] * w_in_group[:, None, :]
    out = jnp.zeros((B * L, D), jnp.float32)
    for g in range(N_GROUPS):
        h = jax.nn.silu(jnp.einsum('td,edf->tef', t, w_gate[g])) * jnp.einsum('td,edf->tef', t, w_up[g])
        out = out + jnp.einsum('tef,efd->td', h * combine[:, g, :, None], w_down[g])
    return out.reshape(B, L, D).astype(xn.dtype)


def _normal(k, shape, scale):
    return jax.random.normal(k, shape, jnp.float32) * scale


def setup_inputs(seed: int = 0) -> dict:
    key = jax.random.key(seed)
    ks = jax.random.split(key, 32)
    G, P, Hs = S5_GROUPS, S5_STATE, S5_GROUP
    a_im0 = math.pi * jnp.arange(P, dtype=jnp.float32)
    return {
        "x": _normal(ks[0], (BATCH, SEQ, D_MODEL), 1.0),
        "mix_norm": 1.0 + _normal(ks[1], (DEPTH, D_MODEL), 0.01),
        "ffn_norm": 1.0 + _normal(ks[2], (DEPTH, D_MODEL), 0.01),
        "final_norm": 1.0 + _normal(ks[3], (D_MODEL,), 0.01),
        "ab_w_in": _normal(ks[4], (N_EVEN, D_MODEL, AB_IN_W), D_MODEL ** -0.5),
        "ab_w_out": _normal(ks[5], (N_EVEN, AB_OUT_W, D_MODEL), AB_OUT_W ** -0.5),
        "s5_a_re": -0.5 + _normal(ks[6], (N_EVEN, G, P), 0.01),
        "s5_a_im": a_im0[None, None, :] + _normal(ks[7], (N_EVEN, G, P), 0.01),
        "s5_b_re": _normal(ks[8], (N_EVEN, G, P, Hs), Hs ** -0.5),
        "s5_b_im": _normal(ks[9], (N_EVEN, G, P, Hs), Hs ** -0.5),
        "s5_c_re": _normal(ks[10], (N_EVEN, G, Hs, P), P ** -0.5),
        "s5_c_im": _normal(ks[11], (N_EVEN, G, Hs, P), P ** -0.5),
        "s5_d": _normal(ks[12], (N_EVEN, G, Hs), 1.0),
        "s5_log_dt": jax.random.uniform(ks[13], (N_EVEN, G), jnp.float32,
                                        math.log(S5_DT_MIN), math.log(S5_DT_MAX)),
        "s5_w_glu": _normal(ks[14], (N_EVEN, S5_WIDTH, S5_WIDTH), S5_WIDTH ** -0.5),
        "s5_b_glu": _normal(ks[15], (N_EVEN, S5_WIDTH), 0.01),
        "c_w_qkv": _normal(ks[16], (N_ODD, D_MODEL, 3 * ATT_HEADS * ATT_DH), D_MODEL ** -0.5),
        "c_w_out": _normal(ks[17], (N_ODD, ATT_HEADS * ATT_DH, D_MODEL), (ATT_HEADS * ATT_DH) ** -0.5),
        "moe_w_group": _normal(ks[18], (DEPTH, D_MODEL, N_GROUPS), D_MODEL ** -0.5),
        "moe_b_group": _normal(ks[19], (DEPTH, N_GROUPS), 0.01),
        "moe_w_router": _normal(ks[20], (DEPTH, D_MODEL, N_GROUPS, EXPERTS_PER_GROUP), D_MODEL ** -0.5),
        "moe_b_router": _normal(ks[21], (DEPTH, N_GROUPS, EXPERTS_PER_GROUP), 0.01),
        "moe_w_gate": _normal(ks[22], (DEPTH, N_GROUPS, EXPERTS_PER_GROUP, D_MODEL, D_EXPERT), D_MODEL ** -0.5),
        "moe_w_up": _normal(ks[23], (DEPTH, N_GROUPS, EXPERTS_PER_GROUP, D_MODEL, D_EXPERT), D_MODEL ** -0.5),
        "moe_w_down": _normal(ks[24], (DEPTH, N_GROUPS, EXPERTS_PER_GROUP, D_EXPERT, D_MODEL), D_EXPERT ** -0.5),
    }


def reference(x, mix_norm, ffn_norm, final_norm, ab_w_in, ab_w_out, s5_a_re, s5_a_im, s5_b_re, s5_b_im,
              s5_c_re, s5_c_im, s5_d, s5_log_dt, s5_w_glu, s5_b_glu, c_w_qkv, c_w_out,
              moe_w_group, moe_b_group, moe_w_router, moe_b_router, moe_w_gate, moe_w_up, moe_w_down):
    h = x
    pos = jnp.arange(x.shape[1])
    for layer in range(DEPTH):
        i = layer // 2
        hn = rmsnorm(h, mix_norm[layer])
        if layer % 2 == 0:
            mixed = parallel_retention_s5(hn, ab_w_in[i], ab_w_out[i], s5_a_re[i], s5_a_im[i], s5_b_re[i],
                                          s5_b_im[i], s5_c_re[i], s5_c_im[i], s5_d[i], s5_log_dt[i],
                                          s5_w_glu[i], s5_b_glu[i], pos)
        else:
            mixed = dilated_attention(hn, c_w_qkv[i], c_w_out[i])
        h = h + mixed
        h = h + hier_moe(rmsnorm(h, ffn_norm[layer]), moe_w_group[layer], moe_b_group[layer],
                         moe_w_router[layer], moe_b_router[layer], moe_w_gate[layer],
                         moe_w_up[layer], moe_w_down[layer])
    return rmsnorm(h, final_norm)
```

```cpp
#include <hip/hip_runtime.h>
#include <stdint.h>
#include <stdio.h>

#define LAS __attribute__((address_space(3)))
#define GAS __attribute__((address_space(1)))
typedef unsigned short bf16_t;
typedef short bf16x8 __attribute__((ext_vector_type(8)));
typedef short s16x4 __attribute__((ext_vector_type(4)));
typedef float f32x4 __attribute__((ext_vector_type(4)));
typedef float f32x2 __attribute__((ext_vector_type(2)));
typedef float f32x16 __attribute__((ext_vector_type(16)));
typedef unsigned u32x4 __attribute__((ext_vector_type(4)));
typedef unsigned u32x2 __attribute__((ext_vector_type(2)));

__device__ __forceinline__ float bf2f(bf16_t v) { return __uint_as_float(((unsigned)v) << 16); }
__device__ __forceinline__ unsigned f2bf(float f) { unsigned u = __float_as_uint(f); return (u + 0x7fffu + ((u >> 16) & 1u)) >> 16; }
__device__ __forceinline__ unsigned pk2(float lo, float hi) { return f2bf(lo) | (f2bf(hi) << 16); }
__device__ __forceinline__ float bflo(unsigned w) { return __uint_as_float(w << 16); }
__device__ __forceinline__ float bfhi(unsigned w) { return __uint_as_float(w & 0xffff0000u); }
__device__ __forceinline__ float wave_sum(float v) {
#pragma unroll
    for (int o = 1; o < 64; o <<= 1) v += __shfl_xor(v, o);
    return v;
}
__device__ __forceinline__ float dpp_add(float v, int ctrl_sel) {
    const int x = __float_as_int(v); int y;
    if (ctrl_sel == 0) y = __builtin_amdgcn_update_dpp(0, x, 0xB1, 0xF, 0xF, false);
    else if (ctrl_sel == 1) y = __builtin_amdgcn_update_dpp(0, x, 0x4E, 0xF, 0xF, false);
    else if (ctrl_sel == 2) y = __builtin_amdgcn_update_dpp(0, x, 0x124, 0xF, 0xF, false);
    else y = __builtin_amdgcn_update_dpp(0, x, 0x128, 0xF, 0xF, false);
    return v + __int_as_float(y);
}
__device__ __forceinline__ float wave_allsum(float v) {
    v = dpp_add(v, 0); v = dpp_add(v, 1); v = dpp_add(v, 2); v = dpp_add(v, 3);
    {   const auto r = __builtin_amdgcn_permlane16_swap(__float_as_uint(v), __float_as_uint(v), false, false);
        v = __uint_as_float(r[0]) + __uint_as_float(r[1]);
        const auto q = __builtin_amdgcn_permlane32_swap(__float_as_uint(v), __float_as_uint(v), false, false);
        v = __uint_as_float(q[0]) + __uint_as_float(q[1]); }
    return v;
}
__device__ __forceinline__ float fast_sigmoid(float x) { return __builtin_amdgcn_rcpf(1.0f + __builtin_amdgcn_exp2f(-1.4426950408889634f * x)); }

namespace pg8 {
constexpr int BM = 256, BK = 64, HALF = 128, HTB = HALF * BK * 2, STAGE_BYTES = 8 * HTB;
__host__ __device__ __forceinline__ int lds_byte(int r, int c) { const int st = (r >> 4) * 2 + (c >> 5), rr = r & 15, cc = c & 31, ob = rr * 64 + cc * 2; return st * 1024 + (ob ^ (((ob >> 9) & 1) << 5)); }
__host__ __device__ __forceinline__ void stage_rc(int b, int& R, int& C) { const int st = b / 1024, sb = b % 1024, swz = sb ^ (((sb >> 9) & 1) << 5); R = (st >> 1) * 16 + swz / 64; C = (st & 1) * 32 + (swz % 64) / 2; }
__host__ __device__ __forceinline__ int perm32(int rho) { const int n = rho >> 4, i = rho & 15; return 8 * (i >> 2) + 4 * n + (i & 3); }

struct Unit { int pm, pn, cls, nvalid; };

__device__ __forceinline__ unsigned cvt_pk_bf16(float lo, float hi) { unsigned r; asm volatile("s_nop 1\n\tv_cvt_pk_bf16_f32 %0, %1, %2" : "=v"(r) : "v"(lo), "v"(hi)); return r; }
typedef __bf16 bf16x2_t __attribute__((ext_vector_type(2)));
__device__ __forceinline__ unsigned cvt_pk_bf16_c(float lo, float hi) { f32x2 v = {lo, hi}; bf16x2_t b = __builtin_convertvector(v, bf16x2_t); return __builtin_bit_cast(unsigned, b); }

template <class Epi, class Sched, bool ALIGN_EPI, bool GATHER, bool BJUMP>
__device__ __forceinline__ void gemm_phase(LAS unsigned char* lds, const int lda, const int ldb, const int K, const Sched& S, const Epi& E) {
    const int tid = threadIdx.x, wid = __builtin_amdgcn_readfirstlane(tid >> 6), lane = tid & 63, wr = wid >> 2, wc = wid & 3, fr = lane & 15, fq = lane >> 4;
    const int nt = K / BK;
    int Rr[2], Cc[2];
    unsigned voffA[2], voffB[2];
#pragma unroll
    for (int i = 0; i < 2; ++i) { int R, C; stage_rc(tid * 16 + i * 8192, R, C); const int Rb = Epi::PERM ? ((R & ~31) + perm32(R & 31)) : R;
        Rr[i] = R; Cc[i] = C;
        voffA[i] = (unsigned)(R * lda + C) * 2u; voffB[i] = (unsigned)(Rb * ldb + C) * 2u; }
    const size_t kstep = (size_t)(BK * 2);
    const size_t hstepA = GATHER ? 0 : (size_t)HALF * lda * 2, hstepB = (size_t)HALF * ldb * 2;
    const unsigned ldsw = (unsigned)wid * 1024u;
    const int aoff = lds_byte(wr * 64 + fr, fq * 8), boff = lds_byte(wc * 32 + fr, fq * 8);
#define PG8_SA(b, h) (((b) * 2 + (h)) * HTB)
#define PG8_SB(b, h) ((4 + (b) * 2 + (h)) * HTB)
#define PG8_STG(bufoff, gbase, o0, o1) do { \
        __builtin_amdgcn_global_load_lds((const unsigned*)((const char*)(gbase) + (o0)), (LAS unsigned*)(lds + (bufoff) + ldsw), 16, 0, 0); \
        __builtin_amdgcn_global_load_lds((const unsigned*)((const char*)(gbase) + (o1)), (LAS unsigned*)(lds + (bufoff) + ldsw + 8192), 16, 0, 0); } while (0)
#define PG8_STGB(bufoff, gbase) PG8_STG(bufoff, gbase, voffB[0], voffB[1])
#define PG8_STGA_CUR(bufoff, gbase, h) PG8_STG(bufoff, (gbase) + (h) * hstepA, GATHER ? gvc[h][0] : voffA[0], GATHER ? gvc[h][1] : voffA[1])
#define PG8_STGA_SEL(bufoff, gbase, h) PG8_STG(bufoff, (gbase) + (h) * hstepA, GATHER ? gvs[h][0] : voffA[0], GATHER ? gvs[h][1] : voffA[1])
#define PG8_LDA(dst, b, h) do { _Pragma("unroll") for (int m = 0; m < 4; ++m) _Pragma("unroll") for (int k = 0; k < 2; ++k) dst[m][k] = *(const LAS bf16x8*)(lds + PG8_SA(b, h) + aoff + m * 2048 + k * 1024); } while (0)
#define PG8_LDB(dst, b, h) do { _Pragma("unroll") for (int n = 0; n < 2; ++n) _Pragma("unroll") for (int k = 0; k < 2; ++k) dst[n][k] = *(const LAS bf16x8*)(lds + PG8_SB(b, h) + boff + n * 2048 + k * 1024); } while (0)
#define PG8_MMA(ai, bj, At, Bt) do { __builtin_amdgcn_s_setprio(1); _Pragma("unroll") for (int m = 0; m < 4; ++m) _Pragma("unroll") for (int n = 0; n < 2; ++n) _Pragma("unroll") for (int k = 0; k < 2; ++k) \
        acc[ai][bj][m][n] = __builtin_amdgcn_mfma_f32_16x16x32_bf16(Bt[n][k], At[m][k], acc[ai][bj][m][n], 0, 0, 0); __builtin_amdgcn_s_setprio(0); } while (0)
#define PG8_WAIT_V(n) asm volatile("s_waitcnt vmcnt(" #n ")" ::: "memory")
#define PG8_WAIT_L(n) asm volatile("s_waitcnt lgkmcnt(" #n ")" ::: "memory")
#define PG8_BAR __builtin_amdgcn_s_barrier()
#define PG8_SCHED __builtin_amdgcn_sched_barrier(0)
    Unit cur, nxt; int ui = 0;
    if (!S.next(0, cur)) return;
    f32x4 acc[2][2][4][2];
#pragma unroll
    for (int a = 0; a < 2; ++a)
#pragma unroll
        for (int b = 0; b < 2; ++b)
#pragma unroll
            for (int m = 0; m < 4; ++m)
#pragma unroll
                for (int n = 0; n < 2; ++n) acc[a][b][m][n] = (f32x4){0.f, 0.f, 0.f, 0.f};
    bf16x8 At[4][2], B0[2][2], B1[2][2];
    unsigned gvc[2][2], gvn[2][2], gvs[2][2];
    const char* cA = S.a_base(cur); const char* cB = S.b_base(cur);
    long cJ = 0;
    if constexpr (BJUMP) cJ = S.b_jump(cur);
    if constexpr (GATHER) { S.a_voff(cur, Rr[0], Rr[1], Cc[0], Cc[1], gvc); }
    else { gvc[0][0] = gvc[0][1] = gvc[1][0] = gvc[1][1] = 0u; }
    PG8_STGB(PG8_SB(0, 0), cB); PG8_STGB(PG8_SB(0, 1), cB + hstepB); PG8_STGA_CUR(PG8_SA(0, 0), cA, 0); PG8_STGA_CUR(PG8_SA(0, 1), cA, 1);
    if (wr == 1) PG8_BAR;
    PG8_WAIT_V(2); PG8_BAR;
    PG8_STGB(PG8_SB(1, 0), cB + kstep); PG8_STGA_CUR(PG8_SA(1, 0), cA + kstep, 0); PG8_STGB(PG8_SB(1, 1), cB + hstepB + kstep);
    PG8_WAIT_V(6); PG8_BAR;
    for (;;) {
        const bool has_next = S.next(ui + 1, nxt);
        const char* nA = has_next ? S.a_base(nxt) : cA; const char* nB = has_next ? S.b_base(nxt) : cB;
        if constexpr (GATHER) { if (has_next) S.a_voff(nxt, Rr[0], Rr[1], Cc[0], Cc[1], gvn); else { gvn[0][0] = gvc[0][0]; gvn[0][1] = gvc[0][1]; gvn[1][0] = gvc[1][0]; gvn[1][1] = gvc[1][1]; } }
        for (int t = 0; t < nt; t += 2) {
            const bool last = (t == nt - 2);
            const char* a1 = cA + (size_t)(t + 1) * kstep;
            const char* a2 = last ? nA : cA + (size_t)(t + 2) * kstep;
            const char* b2 = last ? nB : cB + (size_t)(t + 2) * kstep + ((BJUMP && (t + 2) >= 8) ? cJ : 0);
            const char* a3 = a2 + kstep; const char* b3 = b2 + kstep;
            if constexpr (GATHER) {
#pragma unroll
                for (int h = 0; h < 2; ++h)
#pragma unroll
                    for (int i = 0; i < 2; ++i) gvs[h][i] = last ? gvn[h][i] : gvc[h][i];
            }
            PG8_LDB(B0, 0, 0); PG8_LDB(B1, 0, 1); PG8_SCHED; PG8_LDA(At, 0, 0); PG8_STGA_CUR(PG8_SA(1, 1), a1, 1);
            PG8_WAIT_V(8); PG8_WAIT_L(0); PG8_BAR; PG8_MMA(0, 0, At, B0); PG8_MMA(0, 1, At, B1); PG8_BAR; PG8_SCHED;
            PG8_LDA(At, 0, 1); PG8_STGB(PG8_SB(0, 0), b2); PG8_STGB(PG8_SB(0, 1), b2 + hstepB); PG8_STGA_SEL(PG8_SA(0, 0), a2, 0);
            PG8_WAIT_V(8); PG8_WAIT_L(0); PG8_BAR; PG8_MMA(1, 0, At, B0); PG8_MMA(1, 1, At, B1); PG8_BAR; PG8_SCHED;
            PG8_LDB(B0, 1, 0); PG8_LDB(B1, 1, 1); PG8_SCHED; PG8_LDA(At, 1, 0); PG8_STGA_SEL(PG8_SA(0, 1), a2, 1);
            PG8_WAIT_V(8); PG8_WAIT_L(0); PG8_BAR; PG8_MMA(0, 0, At, B0); PG8_MMA(0, 1, At, B1); PG8_BAR; PG8_SCHED;
            PG8_LDA(At, 1, 1); PG8_STGB(PG8_SB(1, 0), b3); PG8_STGB(PG8_SB(1, 1), b3 + hstepB); PG8_STGA_SEL(PG8_SA(1, 0), a3, 0);
            PG8_WAIT_V(8); PG8_WAIT_L(0); PG8_BAR; PG8_MMA(1, 0, At, B0); PG8_MMA(1, 1, At, B1); PG8_BAR; PG8_SCHED;
        }
        if constexpr (ALIGN_EPI) { if (wr == 0) PG8_BAR; }
        E(acc, cur, wr, wc, fr, fq);
        if (!has_next) break;
#pragma unroll
        for (int a = 0; a < 2; ++a)
#pragma unroll
            for (int b = 0; b < 2; ++b)
#pragma unroll
                for (int m = 0; m < 4; ++m)
#pragma unroll
                    for (int n = 0; n < 2; ++n) acc[a][b][m][n] = (f32x4){0.f, 0.f, 0.f, 0.f};
        cur = nxt; cA = nA; cB = nB; ++ui;
        if constexpr (BJUMP) cJ = S.b_jump(cur);
        if constexpr (GATHER) { gvc[0][0] = gvn[0][0]; gvc[0][1] = gvn[0][1]; gvc[1][0] = gvn[1][0]; gvc[1][1] = gvn[1][1]; }
        if constexpr (ALIGN_EPI) { if (wr == 1) PG8_BAR; }
    }
    PG8_WAIT_V(0);
    if constexpr (!ALIGN_EPI) { if (wr == 0) PG8_BAR; }
    PG8_BAR;
#undef PG8_SA
#undef PG8_SB
#undef PG8_STG
#undef PG8_STGB
#undef PG8_STGA_CUR
#undef PG8_STGA_SEL
#undef PG8_LDA
#undef PG8_LDB
#undef PG8_MMA
#undef PG8_WAIT_V
#undef PG8_WAIT_L
#undef PG8_BAR
#undef PG8_SCHED
}
}
constexpr int T = 16384, D = 1024, L = 4096, NB = 4;
constexpr int NWAVES = 8;
constexpr size_t MiB = 1u << 20;
constexpr int CW_BAR = 4096;
constexpr int CW_CLS0 = 8192, CW_CLS1 = 10240; constexpr int CW_CK = 14000;
constexpr size_t WS_SS1 = 64 * 1024;
constexpr size_t WS_SS0 = 128 * 1024;
constexpr size_t WS_SS2 = 192 * 1024;
constexpr size_t CTL_ZERO_BYTES = 1 * MiB;
constexpr size_t WS_TOK = 1 * MiB;
constexpr size_t WS_LIST = 2 * MiB;
constexpr size_t WS_TOKW = 3 * MiB + 512 * 1024;
constexpr size_t WS_TOKC = 3 * MiB + 640 * 1024;
constexpr size_t WS_RTW = 3 * MiB + 768 * 1024;
constexpr size_t WS_CNTWG = 3 * MiB + 704 * 1024;
constexpr size_t WS_ROPE = 4 * MiB;
constexpr size_t WS_S5T = 6 * MiB;
constexpr size_t WS_S5END = 1 * MiB;
constexpr size_t WS_LW = 7 * MiB;
constexpr size_t WS_SSP = 284 * MiB;
constexpr size_t WS_LSE = 11 * MiB;
constexpr size_t WS_WIN = 12 * MiB;
constexpr size_t WS_WOUT = 17 * MiB;
constexpr size_t WS_WGLU = 19 * MiB;
constexpr size_t WS_WQKV = 20 * MiB;
constexpr size_t WS_CWOUT = 26 * MiB;
constexpr size_t WS_WGU = 28 * MiB;
constexpr size_t WS_WD = 60 * MiB;
constexpr size_t WS_MOE_LAYER = 48 * MiB;
constexpr size_t WS_XB = 124 * MiB;
constexpr size_t WS_MG = 156 * MiB;
constexpr size_t WS_P = 188 * MiB;
constexpr size_t WS_END = 286 * MiB;

constexpr int RING_BYTES = 131072;
constexpr int LDSCTL_OFF = RING_BYTES, MISC_OFF = LDSCTL_OFF + 320;
constexpr int MOE_TB_OFF = LDSCTL_OFF + 512;
constexpr int LDS_BYTES = 147456;

#define RLX_AGENT __ATOMIC_RELAXED, __HIP_MEMORY_SCOPE_AGENT
#define LDS_WAIT() asm volatile("s_waitcnt lgkmcnt(0)" ::: "memory")
#define VM_WAIT() asm volatile("s_waitcnt vmcnt(0)" ::: "memory")

#define XB_TMO      128
#define XB_XCNT(j)  (256  + 64 * (j))
#define XB_XSUB(j)  (1280 + 64 * (j))
#define XB_XGEN(j)  (2304 + 64 * (j))
#define XB_TOP      3328
#define XB_TOPGEN   3392
#define XCD_BAR_WORDS 3456
#define XB_SPIN_CAP (1u << 18)
__device__ __forceinline__ unsigned xb_ld(unsigned* p)              { return __hip_atomic_load(p, __ATOMIC_RELAXED, __HIP_MEMORY_SCOPE_AGENT); }
__device__ __forceinline__ unsigned xb_add(unsigned* p, unsigned v) { return __hip_atomic_fetch_add(p, v, __ATOMIC_RELAXED, __HIP_MEMORY_SCOPE_AGENT); }
__device__ __forceinline__ unsigned xb_xcc_id() { return (unsigned)__builtin_amdgcn_s_getreg((3 << 11) | 20) & 0xFu; }
#define XB_SPIN(cond, bar) do { unsigned _sp = 0; while (cond) { __builtin_amdgcn_s_sleep(1); \
    if ((++_sp & 255u) == 0u) { if (xb_ld(&(bar)[XB_TMO])) break; if (_sp > XB_SPIN_CAP) { atomicAdd(&(bar)[XB_TMO], 1u); break; } } } } while (0)
struct XcdBarrier { unsigned* bar; unsigned x; volatile LAS unsigned* st; };
__device__ __forceinline__ XcdBarrier xcd_barrier_post(unsigned* bar, volatile LAS unsigned* st) {
    XcdBarrier b; b.bar = bar; b.x = xb_xcc_id(); b.st = st;
    if (threadIdx.x == 0) (void)xb_add(&bar[XB_XCNT(b.x)], 1u);
    return b;
}
__device__ __forceinline__ void xcd_barrier_complete(unsigned* bar, unsigned x, unsigned& nloc, unsigned& nx) {
    const unsigned G = gridDim.x * gridDim.y * gridDim.z;
    unsigned sum, cnt, mine, sp = 0u;
    for (;;) {
        sum = 0u; cnt = 0u; mine = 0u;
#pragma unroll
        for (unsigned j = 0; j < 16; ++j) { const unsigned c = xb_ld(&bar[XB_XCNT(j)]); sum += c; cnt += (c > 0u) ? 1u : 0u; mine = (j == x) ? c : mine; }
        if (sum == G) break;
        __builtin_amdgcn_s_sleep(1);
        if ((++sp & 255u) == 0u) { if (xb_ld(&bar[XB_TMO])) break; if (sp > XB_SPIN_CAP) { atomicAdd(&bar[XB_TMO], 1u); break; } }
    }
    nloc = mine > 0u ? mine : 1u; nx = cnt > 0u ? cnt : 1u;
}
__device__ __forceinline__ void xcd_barrier(const XcdBarrier& b) {
    asm volatile("s_waitcnt vmcnt(0)" ::: "memory");
    __syncthreads();
    if (threadIdx.x == 0) {
        unsigned* bar = b.bar;
        __builtin_amdgcn_s_waitcnt(0);
        unsigned nloc = b.st[0], nx = b.st[1];
        if (nloc == 0u) { xcd_barrier_complete(bar, b.x, nloc, nx); b.st[0] = nloc; b.st[1] = nx; }
        const unsigned old = xb_add(&bar[XB_XSUB(b.x)], 1u);
        const unsigned gen = old / nloc;
        if (old + 1u == (gen + 1u) * nloc) {
            __builtin_amdgcn_fence(__ATOMIC_RELEASE, "agent");
            asm volatile("s_waitcnt vmcnt(0)" ::: "memory");
            const unsigned og = xb_add(&bar[XB_TOP], 1u);
            const unsigned tg = og / nx;
            if (og + 1u == (tg + 1u) * nx) xb_add(&bar[XB_TOPGEN], 1u);
            else XB_SPIN(xb_ld(&bar[XB_TOPGEN]) == tg, bar);
            __builtin_amdgcn_fence(__ATOMIC_ACQUIRE, "agent");
            xb_add(&bar[XB_XGEN(b.x)], 1u);
            asm volatile("s_waitcnt vmcnt(0)" ::: "memory");
        } else {
            XB_SPIN(xb_ld(&bar[XB_XGEN(b.x)]) == gen, bar);
            __builtin_amdgcn_fence(__ATOMIC_ACQUIRE, "agent");
            asm volatile("s_waitcnt vmcnt(0)" ::: "memory");
        }
    }
    __syncthreads();
}

struct PlainOrder {
    const char* A; const char* Bt; int lda, ldb; int nM, nN, nwg, G, c;
    __device__ void init(const void* A_, const void* Bt_, int lda_, int ldb_, int M, int N, int G_, int c_) { A = (const char*)A_; Bt = (const char*)Bt_; lda = lda_; ldb = ldb_; nM = M / 256; nN = N / 256; nwg = nM * nN; G = G_; c = c_; }
    __device__ bool next(int i, pg8::Unit& u) const {
        const long Lx = (long)i * G + c; if (Lx >= nwg) return false;
        int wgid = (int)Lx; { const int q = nwg / 8, r = nwg % 8, xcd = wgid % 8, off = wgid / 8; wgid = (xcd < r ? xcd * (q + 1) : r * (q + 1) + (xcd - r) * q) + off; }
        const int nig = 8 * nN, gid = wgid / nig, fm = gid * 8, gsz = (nM - fm) < 8 ? (nM - fm) : 8;
        u.pm = fm + ((wgid % nig) % gsz); u.pn = (wgid % nig) / gsz; u.cls = 0; u.nvalid = 256; return true;
    }
    __device__ __forceinline__ const char* a_base(const pg8::Unit& u) const { return A + (size_t)u.pm * 256 * lda * 2; }
    __device__ __forceinline__ const char* b_base(const pg8::Unit& u) const { return Bt + (size_t)u.pn * 256 * ldb * 2; }
    __device__ __forceinline__ long b_jump(const pg8::Unit&) const { return 0; }
    __device__ __forceinline__ void a_voff(const pg8::Unit&, int, int, int, int, unsigned (&)[2][2]) const {}
};

using pg8::Unit; using pg8::cvt_pk_bf16; using pg8::cvt_pk_bf16_c;
constexpr float RMS_EPS = 1e-6f;
struct EpiInProj {
    static constexpr bool PERM = true;
    bf16_t* P; const float* ss; const float* rope;
    __device__ __forceinline__ void operator()(const f32x4 (&acc)[2][2][4][2], const Unit& u, int wr, int wc, int fr, int fq) const {
        const int row0 = u.pm * 256 + wr * 64 + fr; const int tile = u.pn;
        float ssv[8];
#pragma unroll
        for (int it = 0; it < 8; ++it) ssv[it] = ss[row0 + (it >> 2) * 128 + (it & 3) * 16];
#pragma unroll
        for (int ai = 0; ai < 2; ++ai)
#pragma unroll
            for (int m = 0; m < 4; ++m) {
                const int row = row0 + ai * 128 + m * 16;
                const float rstd = rsqrtf(ssv[ai * 4 + m] * (1.0f / D) + RMS_EPS);
                bf16_t* rowp = P + (size_t)row * 2560 + tile * 256;
#pragma unroll
                for (int bj = 0; bj < 2; ++bj) {
                    const int cb = bj * 128 + wc * 32 + 8 * fq;
                    f32x4 v0 = acc[ai][bj][m][0] * rstd, v1 = acc[ai][bj][m][1] * rstd;
                    if (tile < 4) {
                        const int i4 = (cb & 127) >> 1;
                        const int pos = row & (L - 1);
                        const f32x4 cs = *(const f32x4*)(rope + (size_t)pos * 64 + i4), sn = *(const f32x4*)(rope + (size_t)L * 64 + (size_t)pos * 64 + i4);
                        f32x4 o1 = v0 * cs - v1 * sn, o2 = v0 * sn + v1 * cs;
                        if (tile >= 2) { o1 = o1 * 0.08838834764831845f; o2 = o2 * 0.08838834764831845f; }
                        u32x2 w1, w2; w1.x = cvt_pk_bf16(o1[0], o1[1]); w1.y = cvt_pk_bf16(o1[2], o1[3]); w2.x = cvt_pk_bf16(o2[0], o2[1]); w2.y = cvt_pk_bf16(o2[2], o2[3]);
                        bf16_t* hp = rowp + (cb & 128) + i4;
                        *(u32x2*)hp = w1; *(u32x2*)(hp + 64) = w2;
                    } else {
                        if (tile == 6 || tile == 7) {
#pragma unroll
                            for (int e = 0; e < 4; ++e) { v0[e] = v0[e] * fast_sigmoid(v0[e]); v1[e] = v1[e] * fast_sigmoid(v1[e]); }
                        }
                        u32x4 w; w.x = cvt_pk_bf16(v0[0], v0[1]); w.y = cvt_pk_bf16(v0[2], v0[3]); w.z = cvt_pk_bf16(v1[0], v1[1]); w.w = cvt_pk_bf16(v1[2], v1[3]);
                        *(u32x4*)(rowp + cb) = w;
                    }
                }
            }
    }
};

struct EpiQKV {
    static constexpr bool PERM = true;
    bf16_t* P; const float* ss; float qscale;
    __device__ __forceinline__ void operator()(const f32x4 (&acc)[2][2][4][2], const Unit& u, int wr, int wc, int fr, int fq) const {
        const int row0 = u.pm * 256 + wr * 64 + fr;
        const float sc = (u.pn < 4) ? qscale : 1.0f;
#pragma unroll
        for (int ai = 0; ai < 2; ++ai)
#pragma unroll
            for (int m = 0; m < 4; ++m) {
                const int row = row0 + ai * 128 + m * 16;
                const f32x4* sp = (const f32x4*)(ss + (size_t)row * 32);
                const f32x4 s4 = (sp[0] + sp[1]) + (sp[2] + sp[3]);
                const float rstd = rsqrtf(((s4[0] + s4[1]) + (s4[2] + s4[3])) * (1.0f / D) + RMS_EPS) * sc;
                bf16_t* rowp = P + (size_t)row * 3072 + u.pn * 256 + wc * 32 + 8 * fq;
#pragma unroll
                for (int bj = 0; bj < 2; ++bj) {
                    const f32x4 v0 = acc[ai][bj][m][0] * rstd, v1 = acc[ai][bj][m][1] * rstd;
                    u32x4 w; w.x = cvt_pk_bf16(v0[0], v0[1]); w.y = cvt_pk_bf16(v0[2], v0[3]); w.z = cvt_pk_bf16(v1[0], v1[1]); w.w = cvt_pk_bf16(v1[2], v1[3]);
                    *(u32x4*)(rowp + bj * 128) = w;
                }
            }
    }
};
template <bool RF32>
struct EpiOutRes {
    static constexpr bool PERM = true;
    const float* residf; const bf16_t* residb; bf16_t* Hout;
    __device__ __forceinline__ void operator()(const f32x4 (&acc)[2][2][4][2], const Unit& u, int wr, int wc, int fr, int fq) const {
        const int row0 = u.pm * 256 + wr * 64 + fr;
#pragma unroll
        for (int ai = 0; ai < 2; ++ai)
#pragma unroll
            for (int m = 0; m < 4; ++m) {
                const size_t off = (size_t)(row0 + ai * 128 + m * 16) * D + u.pn * 256 + wc * 32 + 8 * fq;
#pragma unroll
                for (int bj = 0; bj < 2; ++bj) {
                    f32x4 r0, r1;
                    if (RF32) { r0 = *(const f32x4*)(residf + off + bj * 128); r1 = *(const f32x4*)(residf + off + bj * 128 + 4); }
                    else { const u32x4 q = *(const u32x4*)(residb + off + bj * 128); r0 = (f32x4){bflo(q.x), bfhi(q.x), bflo(q.y), bfhi(q.y)}; r1 = (f32x4){bflo(q.z), bfhi(q.z), bflo(q.w), bfhi(q.w)}; }
                    const f32x4 o0 = r0 + acc[ai][bj][m][0], o1 = r1 + acc[ai][bj][m][1];
                    u32x4 w; w.x = cvt_pk_bf16(o0[0], o0[1]); w.y = cvt_pk_bf16(o0[2], o0[3]); w.z = cvt_pk_bf16(o1[0], o1[1]); w.w = cvt_pk_bf16(o1[2], o1[3]);
                    *(u32x4*)(Hout + off + bj * 128) = w;
                }
            }
    }
};

__device__ __forceinline__ void cls_decode(int cls, int& g, int& lo, int& hi) { g = cls / 6; const int p = cls - 6 * g; lo = p < 3 ? 0 : (p < 5 ? 1 : 2); hi = p < 3 ? p + 1 : (p < 5 ? p - 1 : 3); }
struct MoeOrder {
    const char* A; const char* Bt; const int* list; const LAS int* tb; const LAS int* cc; int NPN, G, c, down, lo, hi;
    __device__ bool next(int i, pg8::Unit& u) const {
        const int idx = lo + i * G + c; if (c < 0 || idx >= hi) return false;
        const int ct = idx / NPN; int k = 0;
#pragma unroll 1
        for (int j = 1; j < 24; ++j) if (ct >= tb[j]) k = j;
        u.pm = ct; u.pn = idx - ct * NPN; u.cls = k; const int rem = cc[k] - (ct - tb[k]) * 256; u.nvalid = rem < 256 ? rem : 256; return true;
    }
    __device__ __forceinline__ const char* a_base(const pg8::Unit& u) const { return down ? A + (size_t)u.pm * 256 * 1024 * 2 : A; }
    __device__ __forceinline__ const char* b_base(const pg8::Unit& u) const {
        int g, lo, hi; cls_decode(u.cls, g, lo, hi);
        if (down) return Bt + ((size_t)(g * 1024 + u.pn * 256) * 2048 + lo * 512) * 2;
        const int e = u.pn < 4 ? lo : hi; return Bt + ((size_t)((g * 4 + e) * 1024 + (u.pn & 3) * 256) * 1024) * 2;
    }
    __device__ __forceinline__ long b_jump(const pg8::Unit& u) const { int g, lo, hi; cls_decode(u.cls, g, lo, hi); return (long)(hi - lo - 1) * 1024; }
    __device__ __forceinline__ void a_voff(const pg8::Unit& u, int R0, int R1, int C0, int C1, unsigned (&v)[2][2]) const {
        const int* lp = list + u.cls * 16384 + (u.pm - tb[u.cls]) * 256;
#pragma unroll
        for (int h = 0; h < 2; ++h) {
            const int r0 = h * 128 + R0, r1 = h * 128 + R1;
            const int t0 = lp[r0 < u.nvalid ? r0 : 0], t1 = lp[r1 < u.nvalid ? r1 : 0];
            v[h][0] = (unsigned)t0 * 2048u + (unsigned)C0 * 2u; v[h][1] = (unsigned)t1 * 2048u + (unsigned)C1 * 2u;
        }
    }
};
struct EpiGateUp {
    static constexpr bool PERM = true;
    bf16_t* HC; const f32x2* lw; const LAS int* tb;
    __device__ __forceinline__ void operator()(const f32x4 (&acc)[2][2][4][2], const Unit& u, int wr, int wc, int fr, int fq) const {
        const int slot = u.pn >> 2;
        const f32x2* lwp = lw + u.cls * 16384 + (u.pm - tb[u.cls]) * 256;
        f32x2 w2v[8];
#pragma unroll
        for (int it = 0; it < 8; ++it) { const int rl = wr * 64 + fr + (it >> 2) * 128 + (it & 3) * 16; w2v[it] = lwp[rl < u.nvalid ? rl : 0]; }
#pragma unroll
        for (int ai = 0; ai < 2; ++ai)
#pragma unroll
            for (int m = 0; m < 4; ++m) {
                const int rl = wr * 64 + fr + ai * 128 + m * 16;
                const f32x2 w2 = w2v[ai * 4 + m]; const unsigned wb = __float_as_uint(w2.x); const float w = slot ? bfhi(wb) : bflo(wb), rs = w2.y;
                u32x2 o[2];
#pragma unroll
                for (int bj = 0; bj < 2; ++bj) {
                    const f32x4 v0 = acc[ai][bj][m][0] * rs, v1 = acc[ai][bj][m][1] * rs;
                    const float h0 = v0[0] * fast_sigmoid(v0[0]) * v0[1] * w, h1 = v0[2] * fast_sigmoid(v0[2]) * v0[3] * w;
                    const float h2 = v1[0] * fast_sigmoid(v1[0]) * v1[1] * w, h3 = v1[2] * fast_sigmoid(v1[2]) * v1[3] * w;
                    o[bj].x = cvt_pk_bf16(h0, h1); o[bj].y = cvt_pk_bf16(h2, h3);
                }
                const auto sx = __builtin_amdgcn_permlane16_swap(o[0].x, o[1].x, false, false);
                const auto sy = __builtin_amdgcn_permlane16_swap(o[0].y, o[1].y, false, false);
                u32x4 wv; wv.x = sx[0]; wv.y = sy[0]; wv.z = sx[1]; wv.w = sy[1];
                bf16_t* rowp = HC + (size_t)(u.pm * 256 + rl) * 1024 + slot * 512 + (u.pn & 3) * 128 + wc * 16 + 4 * (fq & 2) + (fq & 1) * 64;
                if (rl < u.nvalid) *(u32x4*)rowp = wv;
            }
    }
};

struct EpiDown {
    static constexpr bool PERM = true;
    const bf16_t* Hin; bf16_t* Hout; float* ss; const int* list; const LAS int* tb;
    __device__ __forceinline__ void operator()(const f32x4 (&acc)[2][2][4][2], const Unit& u, int wr, int wc, int fr, int fq) const {
        const int* lp = list + u.cls * 16384 + (u.pm - tb[u.cls]) * 256;
        int tokv[8];
#pragma unroll
        for (int it = 0; it < 8; ++it) { const int rl = wr * 64 + fr + (it >> 2) * 128 + (it & 3) * 16; tokv[it] = lp[rl < u.nvalid ? rl : 0]; }
#pragma unroll
        for (int ai = 0; ai < 2; ++ai) {
            u32x4 q[4][2];
#pragma unroll
            for (int m = 0; m < 4; ++m) { const size_t off = (size_t)tokv[ai * 4 + m] * D + u.pn * 256 + wc * 32 + 8 * fq;
                q[m][0] = *(const u32x4*)(Hin + off); q[m][1] = *(const u32x4*)(Hin + off + 128); }
#pragma unroll
            for (int m = 0; m < 4; ++m) {
                const int rl = wr * 64 + fr + ai * 128 + m * 16;
                const bool ok = rl < u.nvalid;
                const int tok = tokv[ai * 4 + m];
                const size_t off = (size_t)tok * D + u.pn * 256 + wc * 32 + 8 * fq;
                float sq = 0.f;
#pragma unroll
                for (int bj = 0; bj < 2; ++bj) {
                    const u32x4 qq = q[m][bj];
                    const f32x4 o0 = (f32x4){bflo(qq.x), bfhi(qq.x), bflo(qq.y), bfhi(qq.y)} + acc[ai][bj][m][0], o1 = (f32x4){bflo(qq.z), bfhi(qq.z), bflo(qq.w), bfhi(qq.w)} + acc[ai][bj][m][1];
                    sq += (o0[0] * o0[0] + o0[1] * o0[1]) + (o0[2] * o0[2] + o0[3] * o0[3]) + (o1[0] * o1[0] + o1[1] * o1[1]) + (o1[2] * o1[2] + o1[3] * o1[3]);
                    u32x4 w; w.x = cvt_pk_bf16(o0[0], o0[1]); w.y = cvt_pk_bf16(o0[2], o0[3]); w.z = cvt_pk_bf16(o1[0], o1[1]); w.w = cvt_pk_bf16(o1[2], o1[3]);
                    if (ok) *(u32x4*)(Hout + off + bj * 128) = w;
                }
                sq += __shfl_xor(sq, 16); sq += __shfl_xor(sq, 32);
                if (ok && fq == 0) __hip_atomic_store(ss + (size_t)tok * 32 + u.pn * 4 + wc, sq, RLX_AGENT);
            }
        }
    }
};

struct Frame {
    LAS unsigned char* lds;
    volatile LAS unsigned* MISC;
    unsigned* ctl;
    int tid, lane, wave, vcu, G;
};

template <int ROWMODE>
__device__ __forceinline__ int tr_rowmap(int n, int row_off) {
    if (ROWMODE == 0) return row_off + n;
    if (ROWMODE == 1) { if (n >= 1024) return n; const int hb = n >> 7, jj = n & 127; return (hb << 7) + (jj < 64 ? 8 * (jj >> 2) + (jj & 3) : 8 * ((jj - 64) >> 2) + 4 + (jj & 3)); }
    if (ROWMODE == 2) return row_off + 2 * n;
    return row_off + 2 * n + 1;
}
template <int ROWMODE>
__device__ __forceinline__ void tr_item(const float* W, int N, bf16_t* WT, int ldt, int koff, int row_off, const float* gain, LAS float* scr, int item, int lane) {
    const int nblk = N / 32, kb = item / nblk, nb = item % nblk, k0 = 64 * kb, n0 = 32 * nb;
    float tv[32];
#pragma unroll
    for (int i = 0; i < 32; ++i) tv[i] = W[(size_t)(k0 + 2 * i + (lane >> 5)) * N + n0 + (lane & 31)];
#pragma unroll
    for (int i = 0; i < 32; ++i) { const int kk = 2 * i + (lane >> 5); float v = tv[i]; if (gain) v *= gain[k0 + kk]; scr[kk * 33 + (lane & 31)] = v; }
    LDS_WAIT(); asm volatile("" ::: "memory");
    const int c = lane & 7;
#pragma unroll
    for (int j = 0; j < 4; ++j) { const int n = (lane >> 3) + 8 * j; const LAS float* s = scr + (8 * c) * 33 + n;
        u32x4 o; o.x = pk2(s[0 * 33], s[1 * 33]); o.y = pk2(s[2 * 33], s[3 * 33]); o.z = pk2(s[4 * 33], s[5 * 33]); o.w = pk2(s[6 * 33], s[7 * 33]);
        *(u32x4*)(WT + (size_t)tr_rowmap<ROWMODE>(n0 + n, row_off) * ldt + koff + k0 + 8 * c) = o; }
    LDS_WAIT(); asm volatile("" ::: "memory");
}
typedef short v4i16_t __attribute__((ext_vector_type(4)));
__device__ __forceinline__ s16x4 ds_tr16(unsigned addr) { return __builtin_bit_cast(s16x4, __builtin_amdgcn_ds_read_tr16_b64_v4i16((LAS v4i16_t*)(uintptr_t)addr)); }

__device__ __forceinline__ void attn_load_half(const bf16_t* __restrict__ P, int b, int h, int r, int blk, int dil, int tid, u32x4* kreg, u32x4* vreg) {
#pragma unroll
    for (int i = 0; i < 4; ++i) {
        const int id = tid + 512 * i, row = id >> 4, ch = id & 15;
        const size_t grow = (size_t)b * L + r + (size_t)dil * (128 * blk + row);
        const bf16_t* src = P + grow * 3072 + 1024 + h * 128 + ch * 8;
        kreg[i] = *(const u32x4*)src; vreg[i] = *(const u32x4*)(src + 1024);
    }
}
__device__ __forceinline__ void attn_store_half(LAS unsigned char* lds, int tid, int slot, const u32x4* kreg, const u32x4* vreg) {
#pragma unroll
    for (int i = 0; i < 4; ++i) {
        const int id = tid + 512 * i, row = slot * 128 + (id >> 4), ch = id & 15;
        const int off = row * 256 + ((ch ^ (row & 15)) << 4);
        *(LAS u32x4*)(lds + off) = kreg[i]; *(LAS u32x4*)(lds + 65536 + off) = vreg[i];
    }
}
__device__ __forceinline__ void attn_load(const bf16_t* __restrict__ P, int b, int h, int r, int n, int dil, int tid, bool full, u32x4 (&kreg)[8], u32x4 (&vreg)[8]) {
    if (full) attn_load_half(P, b, h, r, n > 0 ? n - 1 : 0, dil, tid, kreg, vreg);
    attn_load_half(P, b, h, r, n, dil, tid, kreg + 4, vreg + 4);
}
__device__ __forceinline__ void attn_store(LAS unsigned char* lds, int tid, int n, bool full, const u32x4 (&kreg)[8], const u32x4 (&vreg)[8]) {
    if (full) attn_store_half(lds, tid, (n - 1) & 1, kreg, vreg);
    attn_store_half(lds, tid, n & 1, kreg + 4, vreg + 4);
}
__device__ __forceinline__ void attn_loadq(const bf16_t* __restrict__ P, int b, int h, int r, int n, int dil, int tid, bf16x8 (&qf)[4]) {
    const int lane = tid & 63, w = __builtin_amdgcn_readfirstlane(tid >> 6), fr = lane & 15, fq = lane >> 4;
    const size_t qrow = (size_t)b * L + r + (size_t)dil * (128 * n + 16 * w + fr);
#pragma unroll
    for (int ks = 0; ks < 4; ++ks) qf[ks] = *(const bf16x8*)(P + qrow * 3072 + h * 128 + 32 * ks + 8 * fq);
}
template <bool MERGE>
__device__ __forceinline__ void attn_compute(LAS unsigned char* lds, const bf16_t* __restrict__ P, bf16_t* O, float* lse_out, const bf16_t* OA, const bf16_t* OB, const float* lseA, const float* lseB,
                                             int b, int h, int r, int n, int dil, int tid, const bf16x8 (&qf)[4]) {
    const int lane = tid & 63, w = __builtin_amdgcn_readfirstlane(tid >> 6), fr = lane & 15, fq = lane >> 4;
    const size_t qrow = (size_t)b * L + r + (size_t)dil * (128 * n + 16 * w + fr);
    float m = -1e30f, lsum = 0.f;
    f32x4 ot[8];
#pragma unroll
    for (int dt = 0; dt < 8; ++dt) ot[dt] = (f32x4){0.f, 0.f, 0.f, 0.f};
    const float NEG = -__builtin_inff();
    const int pxor = ((n - 1) & 1) << 7;
    const unsigned ldsb = (unsigned)(uintptr_t)lds;
#pragma unroll
    for (int g = 0; g < 5; ++g) {
        const int tixA = w + 2 * g, tixB = tixA + 1;
        f32x4 sA = (f32x4){0.f, 0.f, 0.f, 0.f}, sB = (f32x4){0.f, 0.f, 0.f, 0.f};
        {
            const int rowA = (16 * tixA + fr) ^ pxor;
#pragma unroll
            for (int ks = 0; ks < 4; ++ks) {
                const bf16x8 kf = *(const LAS bf16x8*)(lds + rowA * 256 + (((4 * ks + fq) ^ (rowA & 15)) << 4));
                sA = __builtin_amdgcn_mfma_f32_16x16x32_bf16(kf, qf[ks], sA, 0, 0, 0);
            }
        }
        if (g < 4) {
            const int rowB = (16 * tixB + fr) ^ pxor;
#pragma unroll
            for (int ks = 0; ks < 4; ++ks) {
                const bf16x8 kf = *(const LAS bf16x8*)(lds + rowB * 256 + (((4 * ks + fq) ^ (rowB & 15)) << 4));
                sB = __builtin_amdgcn_mfma_f32_16x16x32_bf16(kf, qf[ks], sB, 0, 0, 0);
            }
        }
        const bool invA = (n == 0 && tixA < 8), invB = (g == 4) || (n == 0 && tixB < 8);
#pragma unroll
        for (int e = 0; e < 4; ++e) {
            bool okA = !invA, okB = !invB;
            if (g == 0) okA = okA && (4 * fq + e >= fr);
            if (g == 4) okA = okA && (4 * fq + e <= fr);
            if (!okA) sA[e] = NEG;
            if (!okB) sB[e] = NEG;
        }
        float mx = fmaxf(fmaxf(fmaxf(sA[0], sA[1]), fmaxf(sA[2], sA[3])), fmaxf(fmaxf(sB[0], sB[1]), fmaxf(sB[2], sB[3])));
        mx = fmaxf(mx, __shfl_xor(mx, 16)); mx = fmaxf(mx, __shfl_xor(mx, 32));
        const float mn = fmaxf(m, mx);
        const float alpha = __builtin_amdgcn_exp2f(m - mn);
        m = mn;
        float ps = 0.f;
#pragma unroll
        for (int e = 0; e < 4; ++e) { sA[e] = __builtin_amdgcn_exp2f(sA[e] - mn); sB[e] = __builtin_amdgcn_exp2f(sB[e] - mn); ps += sA[e] + sB[e]; }
        lsum = lsum * alpha + ps;
        u32x4 pw; pw.x = cvt_pk_bf16_c(sA[0], sA[1]); pw.y = cvt_pk_bf16_c(sA[2], sA[3]); pw.z = cvt_pk_bf16_c(sB[0], sB[1]); pw.w = cvt_pk_bf16_c(sB[2], sB[3]);
        const bf16x8 pf = __builtin_bit_cast(bf16x8, pw);
        const int qp = fr >> 2, pp = fr & 3;
        const int vrowA = (16 * tixA + 4 * fq + qp) ^ pxor, vrowB = (g < 4) ? ((16 * tixB + 4 * fq + qp) ^ pxor) : vrowA;
#pragma unroll
        for (int dt = 0; dt < 8; ++dt) {
            const unsigned aA = ldsb + 65536u + (unsigned)(vrowA * 256 + (((2 * dt + (pp >> 1)) ^ (vrowA & 15)) << 4) + (pp & 1) * 8);
            const unsigned aB = ldsb + 65536u + (unsigned)(vrowB * 256 + (((2 * dt + (pp >> 1)) ^ (vrowB & 15)) << 4) + (pp & 1) * 8);
            const s16x4 lo = ds_tr16(aA), hi = ds_tr16(aB);
            const bf16x8 vf = (bf16x8){lo[0], lo[1], lo[2], lo[3], hi[0], hi[1], hi[2], hi[3]};
            ot[dt] = ot[dt] * alpha;
            ot[dt] = __builtin_amdgcn_mfma_f32_16x16x32_bf16(vf, pf, ot[dt], 0, 0, 0);
        }
    }
    float lt = lsum; lt += __shfl_xor(lt, 16); lt += __shfl_xor(lt, 32);
    const float inv = 1.0f / lt;
    const float lse2 = m + __builtin_amdgcn_logf(lt);
    if (!MERGE) {
        if (fq == 0) lse_out[(size_t)((b * 8 + h) * dil + r) * (L / dil) + 128 * n + 16 * w + fr] = lse2;
#pragma unroll
        for (int dt = 0; dt < 8; ++dt) { u32x2 o; o.x = cvt_pk_bf16(ot[dt][0] * inv, ot[dt][1] * inv); o.y = cvt_pk_bf16(ot[dt][2] * inv, ot[dt][3] * inv);
            *(u32x2*)(O + qrow * D + h * 128 + 16 * dt + 4 * fq) = o; }
    } else {
        const int pos = r + dil * (128 * n + 16 * w + fr);
        const float la = lseA[(size_t)(b * 8 + h) * L + pos], lb = lseB[(size_t)((b * 8 + h) * 4 + (pos & 3)) * (L / 4) + (pos >> 2)];
        const float M = fmaxf(fmaxf(la, lb), lse2);
        float wa = __builtin_amdgcn_exp2f(la - M), wb = __builtin_amdgcn_exp2f(lb - M), wc = __builtin_amdgcn_exp2f(lse2 - M);
        const float iw = 1.0f / (wa + wb + wc); wa *= iw; wb *= iw; wc *= iw * inv;
#pragma unroll
        for (int dt = 0; dt < 8; ++dt) {
            const size_t off = qrow * D + h * 128 + 16 * dt + 4 * fq;
            const u32x2 a = *(const u32x2*)(OA + off), bb = *(const u32x2*)(OB + off);
            const float r0 = wa * bflo(a.x) + wb * bflo(bb.x) + wc * ot[dt][0], r1 = wa * bfhi(a.x) + wb * bfhi(bb.x) + wc * ot[dt][1];
            const float r2 = wa * bflo(a.y) + wb * bflo(bb.y) + wc * ot[dt][2], r3 = wa * bfhi(a.y) + wb * bfhi(bb.y) + wc * ot[dt][3];
            u32x2 o; o.x = cvt_pk_bf16(r0, r1); o.y = cvt_pk_bf16(r2, r3);
            *(u32x2*)(O + off) = o;
        }
    }
}
__device__ __forceinline__ u32x4 scale_bf16x8(u32x4 v, float z) {
    u32x4 o; o.x = cvt_pk_bf16(bflo(v.x) * z, bfhi(v.x) * z); o.y = cvt_pk_bf16(bflo(v.y) * z, bfhi(v.y) * z);
    o.z = cvt_pk_bf16(bflo(v.z) * z, bfhi(v.z) * z); o.w = cvt_pk_bf16(bflo(v.w) * z, bfhi(v.w) * z); return o;
}
__device__ __forceinline__ int swz_tr(int row, int ch) { return row * 256 + ((ch ^ ((row & 3) << 2)) << 4); }
__device__ __forceinline__ int swz_row(int row, int ch) { return row * 256 + ((ch ^ (row & 15)) << 4); }

__device__ __forceinline__ void ret_kv_unit(LAS unsigned char* lds, const bf16_t* __restrict__ P, bf16_t* KVT, int b, int h, int N, int tid) {
    const int lane = tid & 63, w = __builtin_amdgcn_readfirstlane(tid >> 6);
    const float lg2 = log2f(1.0f - exp2f(-5.0f - (float)h));
    {
        u32x4 kreg[8], vreg[8];
#pragma unroll
        for (int i = 0; i < 8; ++i) {
            const int id = tid + 512 * i, row = id >> 4, ch = id & 15;
            const bf16_t* src = P + ((size_t)b * L + 256 * N + row) * 2560 + 512 + h * 128 + ch * 8;
            kreg[i] = *(const u32x4*)src; vreg[i] = *(const u32x4*)(src + 512);
        }
#pragma unroll
        for (int i = 0; i < 8; ++i) {
            const int id = tid + 512 * i, row = id >> 4, ch = id & 15;
            const int off = swz_tr(row, ch);
            *(LAS u32x4*)(lds + off) = kreg[i];
            *(LAS u32x4*)(lds + 65536 + off) = scale_bf16x8(vreg[i], exp2f((float)(255 - row) * lg2));
        }
    }
    __syncthreads();
    const int dkt = w >> 1, dvt0 = 2 * (w & 1);
    const int gq = lane >> 4, hi = gq >> 1, qp = (lane & 15) >> 2, pp = lane & 3;
    const unsigned ldsb = (unsigned)(uintptr_t)lds;
    f32x16 acc[2];
#pragma unroll
    for (int t = 0; t < 2; ++t)
#pragma unroll
        for (int r = 0; r < 16; ++r) acc[t][r] = 0.f;
    const int chA = 4 * dkt + 2 * (gq & 1) + (pp >> 1);
#pragma unroll 4
    for (int ks = 0; ks < 16; ++ks) {
        const int r1 = 16 * ks + 8 * hi + qp, r2 = r1 + 4;
        const s16x4 alo = ds_tr16(ldsb + swz_tr(r1, chA) + (pp & 1) * 8), ahi = ds_tr16(ldsb + swz_tr(r2, chA) + (pp & 1) * 8);
        const bf16x8 af = (bf16x8){alo[0], alo[1], alo[2], alo[3], ahi[0], ahi[1], ahi[2], ahi[3]};
#pragma unroll
        for (int t = 0; t < 2; ++t) {
            const int chB = 4 * (dvt0 + t) + 2 * (gq & 1) + (pp >> 1);
            const s16x4 blo = ds_tr16(ldsb + 65536u + swz_tr(r1, chB) + (pp & 1) * 8), bhi = ds_tr16(ldsb + 65536u + swz_tr(r2, chB) + (pp & 1) * 8);
            const bf16x8 bf = (bf16x8){blo[0], blo[1], blo[2], blo[3], bhi[0], bhi[1], bhi[2], bhi[3]};
            acc[t] = __builtin_amdgcn_mfma_f32_32x32x16_bf16(af, bf, acc[t], 0, 0, 0);
        }
    }
    bf16_t* out = KVT + ((size_t)((b * 4 + h) * 16 + N)) * 16384;
#pragma unroll
    for (int t = 0; t < 2; ++t) {
        const int dv = 32 * (dvt0 + t) + (lane & 31);
#pragma unroll
        for (int rg = 0; rg < 4; ++rg) {
            u32x2 o; o.x = cvt_pk_bf16_c(acc[t][4 * rg], acc[t][4 * rg + 1]); o.y = cvt_pk_bf16_c(acc[t][4 * rg + 2], acc[t][4 * rg + 3]);
            *(u32x2*)(out + dv * 128 + 32 * dkt + 8 * rg + 4 * (lane >> 5)) = o;
        }
    }
    __syncthreads();
}

__device__ __forceinline__ void ret_out_unit(LAS unsigned char* lds, const bf16_t* __restrict__ P, const bf16_t* __restrict__ KVT, bf16_t* MG, int b, int h, int N, int tid) {
    const int lane = tid & 63, w = __builtin_amdgcn_readfirstlane(tid >> 6), l31 = lane & 31, hi = lane >> 5;
    const float lg2 = log2f(1.0f - exp2f(-5.0f - (float)h));
    const size_t rowbase = (size_t)b * L + 256 * N;
    {
        const bf16_t* kvb = KVT + ((size_t)((b * 4 + h) * 16)) * 16384;
        float a8[4][8];
#pragma unroll
        for (int i = 0; i < 4; ++i)
#pragma unroll
            for (int e = 0; e < 8; ++e) a8[i][e] = 0.f;
#pragma unroll 1
        for (int m = 0; m < N; ++m) {
            const float wgt = exp2f((float)(256 * (N - 1 - m)) * lg2);
            u32x4 v[4];
#pragma unroll
            for (int i = 0; i < 4; ++i) { const int cid = tid + 512 * i, dv = cid >> 4, ch = cid & 15; v[i] = *(const u32x4*)(kvb + (size_t)m * 16384 + dv * 128 + ch * 8); }
#pragma unroll
            for (int i = 0; i < 4; ++i) {
                a8[i][0] += wgt * bflo(v[i].x); a8[i][1] += wgt * bfhi(v[i].x); a8[i][2] += wgt * bflo(v[i].y); a8[i][3] += wgt * bfhi(v[i].y);
                a8[i][4] += wgt * bflo(v[i].z); a8[i][5] += wgt * bfhi(v[i].z); a8[i][6] += wgt * bflo(v[i].w); a8[i][7] += wgt * bfhi(v[i].w); }
        }
#pragma unroll
        for (int i = 0; i < 4; ++i) {
            const int cid = tid + 512 * i, dv = cid >> 4, ch = cid & 15;
            u32x4 o; o.x = cvt_pk_bf16(a8[i][0], a8[i][1]); o.y = cvt_pk_bf16(a8[i][2], a8[i][3]); o.z = cvt_pk_bf16(a8[i][4], a8[i][5]); o.w = cvt_pk_bf16(a8[i][6], a8[i][7]);
            *(LAS u32x4*)(lds + swz_row(dv, ch)) = o;
        }
    }
    const size_t qrow = rowbase + 32 * w + l31;
    bf16x8 qf[8];
#pragma unroll
    for (int ks = 0; ks < 8; ++ks) qf[ks] = *(const bf16x8*)(P + qrow * 2560 + h * 128 + 16 * ks + 8 * hi);
    __syncthreads();
    f32x16 acc[4];
#pragma unroll
    for (int dvt = 0; dvt < 4; ++dvt) {
#pragma unroll
        for (int r = 0; r < 16; ++r) acc[dvt][r] = 0.f;
        const int dv = 32 * dvt + l31;
#pragma unroll
        for (int ks = 0; ks < 8; ++ks) {
            const bf16x8 pf = *(const LAS bf16x8*)(lds + swz_row(dv, 2 * ks + hi));
            acc[dvt] = __builtin_amdgcn_mfma_f32_32x32x16_bf16(pf, qf[ks], acc[dvt], 0, 0, 0);
        }
    }
    {
        const float xi = exp2f((float)(32 * w + l31 + 1) * lg2);
#pragma unroll
        for (int dvt = 0; dvt < 4; ++dvt)
#pragma unroll
            for (int r = 0; r < 16; ++r) acc[dvt][r] *= xi;
    }
    __syncthreads();
    {
        u32x4 kreg[8], vreg[8];
#pragma unroll
        for (int i = 0; i < 8; ++i) {
            const int id = tid + 512 * i, row = id >> 4, ch = id & 15;
            const bf16_t* src = P + (rowbase + row) * 2560 + 512 + h * 128 + ch * 8;
            kreg[i] = *(const u32x4*)src; vreg[i] = *(const u32x4*)(src + 512);
        }
#pragma unroll
        for (int i = 0; i < 8; ++i) {
            const int id = tid + 512 * i, row = id >> 4, ch = id & 15;
            *(LAS u32x4*)(lds + swz_row(row, ch)) = kreg[i];
            *(LAS u32x4*)(lds + 65536 + swz_tr(row, ch)) = vreg[i];
        }
    }
    __syncthreads();
    float dvec[16];
#pragma unroll
    for (int r = 0; r < 16; ++r) dvec[r] = exp2f((float)(l31 - ((r & 3) + 8 * (r >> 2) + 4 * hi)) * lg2);
    const int gq = lane >> 4, qp = (lane & 15) >> 2, pp = lane & 3;
    const unsigned ldsb = (unsigned)(uintptr_t)lds;
#pragma unroll 1
    for (int kt = 0; kt <= w; ++kt) {
        f32x16 st;
#pragma unroll
        for (int r = 0; r < 16; ++r) st[r] = 0.f;
        const int key = 32 * kt + l31;
#pragma unroll
        for (int ks = 0; ks < 8; ++ks) {
            const bf16x8 kf = *(const LAS bf16x8*)(lds + swz_row(key, 2 * ks + hi));
            st = __builtin_amdgcn_mfma_f32_32x32x16_bf16(kf, qf[ks], st, 0, 0, 0);
        }
        const float tsc = exp2f((float)(32 * (w - kt)) * lg2);
        const bool diag = (kt == w);
#pragma unroll
        for (int r = 0; r < 16; ++r) {
            const int krow = (r & 3) + 8 * (r >> 2) + 4 * hi;
            float pv = st[r] * dvec[r] * tsc;
            if (diag && krow > l31) pv = 0.f;
            st[r] = pv;
        }
        bf16x8 pf[2];
#pragma unroll
        for (int s = 0; s < 2; ++s) { u32x4 pw; pw.x = cvt_pk_bf16(st[8 * s], st[8 * s + 1]); pw.y = cvt_pk_bf16(st[8 * s + 2], st[8 * s + 3]);
            pw.z = cvt_pk_bf16(st[8 * s + 4], st[8 * s + 5]); pw.w = cvt_pk_bf16(st[8 * s + 6], st[8 * s + 7]); pf[s] = __builtin_bit_cast(bf16x8, pw); }
#pragma unroll
        for (int dvt = 0; dvt < 4; ++dvt) {
            const int chV = 4 * dvt + 2 * (gq & 1) + (pp >> 1);
#pragma unroll
            for (int s = 0; s < 2; ++s) {
                const int r1 = 32 * kt + 16 * s + 4 * hi + qp, r2 = r1 + 8;
                const s16x4 vlo = ds_tr16(ldsb + 65536u + swz_tr(r1, chV) + (pp & 1) * 8), vhi = ds_tr16(ldsb + 65536u + swz_tr(r2, chV) + (pp & 1) * 8);
                const bf16x8 vf = (bf16x8){vlo[0], vlo[1], vlo[2], vlo[3], vhi[0], vhi[1], vhi[2], vhi[3]};
                acc[dvt] = __builtin_amdgcn_mfma_f32_32x32x16_bf16(vf, pf[s], acc[dvt], 0, 0, 0);
            }
        }
    }
    float s1 = 0.f;
#pragma unroll
    for (int dvt = 0; dvt < 4; ++dvt)
#pragma unroll
        for (int r = 0; r < 16; ++r) s1 += acc[dvt][r];
    s1 += __shfl_xor(s1, 32);
    const float mu = s1 * (1.0f / 128.0f);
    float s2 = 0.f;
#pragma unroll
    for (int dvt = 0; dvt < 4; ++dvt)
#pragma unroll
        for (int r = 0; r < 16; ++r) { const float d = acc[dvt][r] - mu; s2 += d * d; }
    s2 += __shfl_xor(s2, 32);
    const float rs = rsqrtf(s2 * (1.0f / 128.0f) + 1e-6f);
#pragma unroll
    for (int dvt = 0; dvt < 4; ++dvt)
#pragma unroll
        for (int rg = 0; rg < 4; ++rg) {
            const int col = h * 128 + 32 * dvt + 8 * rg + 4 * hi;
            const u32x2 g = *(const u32x2*)(P + qrow * 2560 + 1536 + col);
            u32x2 o; o.x = cvt_pk_bf16(bflo(g.x) * (acc[dvt][4 * rg] - mu) * rs, bfhi(g.x) * (acc[dvt][4 * rg + 1] - mu) * rs);
            o.y = cvt_pk_bf16(bflo(g.y) * (acc[dvt][4 * rg + 2] - mu) * rs, bfhi(g.y) * (acc[dvt][4 * rg + 3] - mu) * rs);
            *(u32x2*)(MG + qrow * D + col) = o;
        }
    __syncthreads();
}
constexpr size_t S5_BB_OFF = 0, S5_CM_OFF = 128 * 1024, S5_LAM_OFF = 448 * 1024;
struct S5P { float lr, li; };
__device__ __forceinline__ void cmul(float ar, float ai, float br, float bi, float& cr, float& ci) { float r_ = ar * br - ai * bi; asm volatile("" : "+v"(r_)); float i_ = ar * bi + ai * br; asm volatile("" : "+v"(i_)); cr = r_; ci = i_; }
__device__ __forceinline__ void s5_coefs(const float* a_re, const float* a_im, const float* log_dt, int g, int st, float& lr, float& li, float& cr, float& ci) {
    const float dt = expf(log_dt[g]); const float are = a_re[g * 64 + st], aim = a_im[g * 64 + st];
    const float zr = are * dt, zi = aim * dt, mag = expf(zr);
    lr = mag * cosf(zi); li = mag * sinf(zi);
    const float nr = lr - 1.0f, ni = li, den = are * are + aim * aim;
    cr = (nr * are + ni * aim) / den; ci = (ni * are - nr * aim) / den;
}
__device__ __forceinline__ void s5_tables(unsigned char* tab, const float* a_re, const float* a_im, const float* b_re, const float* b_im, const float* c_re, const float* c_im,
                                          const float* dsk, const float* log_dt, int gtid, int gthreads) {
    for (int i = gtid; i < 32 * 64; i += gthreads) {
        const int g = i >> 6, st = i & 63;
        const float dt = expf(log_dt[g]); const float zr = a_re[g * 64 + st] * dt, zi = a_im[g * 64 + st] * dt;
        float* o = (float*)(tab + S5_LAM_OFF) + (size_t)i * 16;
        const float kk[7] = {1.f, 2.f, 3.f, 4.f, 32.f, 64.f, 256.f};
#pragma unroll
        for (int q = 0; q < 7; ++q) { const float mag = expf(kk[q] * zr); o[2 * q] = mag * cosf(kk[q] * zi); o[2 * q + 1] = mag * sinf(kk[q] * zi); }
        o[14] = 0.f; o[15] = 0.f;
    }
    for (int i = gtid; i < 32 * 4 * 64; i += gthreads) {
        const int lane = i & 63, tt = (i >> 6) & 3, g = i >> 8;
        const int st = 32 * (tt >> 1) + (lane & 31); float lr, li, cr, ci; s5_coefs(a_re, a_im, log_dt, g, st, lr, li, cr, ci);
        float v[8];
#pragma unroll
        for (int j = 0; j < 8; ++j) { const int h = 8 * (lane >> 5) + j; const float br = b_re[(g * 64 + st) * 16 + h], bi = b_im[(g * 64 + st) * 16 + h];
            v[j] = (tt & 1) ? (cr * bi + ci * br) : (cr * br - ci * bi); }
        u32x4 o; o.x = pk2(v[0], v[1]); o.y = pk2(v[2], v[3]); o.z = pk2(v[4], v[5]); o.w = pk2(v[6], v[7]);
        *((u32x4*)(tab + S5_BB_OFF) + i) = o;
    }
    for (int i = gtid; i < 32 * 9 * 64; i += gthreads) {
        const int lane = i & 63, s9 = (i >> 6) % 9, g = i / (9 * 64);
        const int h = lane & 31; float v[8];
#pragma unroll
        for (int j = 0; j < 8; ++j) {
            float x = 0.f;
            if (h < 16) {
                if (s9 < 8) { const int st = 8 * s9 + 4 * (lane >> 5) + (j >> 1); x = (j & 1) ? -c_im[(g * 16 + h) * 64 + st] : c_re[(g * 16 + h) * 64 + st]; }
                else { const int hp = 8 * (lane >> 5) + j; x = (hp == h) ? dsk[g * 16 + h] : 0.f; }
            }
            v[j] = x;
        }
        u32x4 o; o.x = pk2(v[0], v[1]); o.y = pk2(v[2], v[3]); o.z = pk2(v[4], v[5]); o.w = pk2(v[6], v[7]);
        *((u32x4*)(tab + S5_CM_OFF) + i) = o;
    }
}

template <bool OUT>
__device__ __forceinline__ void s5_task(const bf16_t* __restrict__ P, const unsigned char* __restrict__ tab, float* END, bf16_t* G, LAS unsigned char* xl, int b, int g, int c, int lane) {
    const int l31 = lane & 31, hi = lane >> 5;
    bf16x8 bbt[4];
#pragma unroll
    for (int tt = 0; tt < 4; ++tt) bbt[tt] = *((const bf16x8*)(tab + S5_BB_OFF) + (g * 4 + tt) * 64 + lane);
    float l1r[2], l1i[2], l2r[2], l2i[2], l3r[2], l3i[2], l4r[2], l4i[2], cr[2], ci[2];
#pragma unroll
    for (int cc = 0; cc < 2; ++cc) {
        const float* lp = (const float*)(tab + S5_LAM_OFF) + (size_t)(g * 64 + 32 * cc + l31) * 16;
        const f32x4 a = *(const f32x4*)lp, bq = *(const f32x4*)(lp + 4);
        l1r[cc] = a[0]; l1i[cc] = a[1]; l2r[cc] = a[2]; l2i[cc] = a[3]; l3r[cc] = bq[0]; l3i[cc] = bq[1]; l4r[cc] = bq[2]; l4i[cc] = bq[3];
        cr[cc] = 0.f; ci[cc] = 0.f;
        if (OUT) {
            const float p256r = lp[12], p256i = lp[13];
            const float* ep = END + ((size_t)((b * 32 + g) * 16) * 64 + 32 * cc + l31) * 2;
#pragma unroll
            for (int m = 0; m < 15; ++m) { const int mm = m < c ? m : 0; f32x2 e = *(const f32x2*)(ep + (size_t)mm * 128); float tr_, ti_; cmul(p256r, p256i, cr[cc], ci[cc], tr_, ti_);
                if (m < c) { cr[cc] = tr_ + e.x; ci[cc] = ti_ + e.y; } }
        }
    }
    bf16x8 cm[9];
    if (OUT) {
#pragma unroll
        for (int s = 0; s < 9; ++s) cm[s] = *((const bf16x8*)(tab + S5_CM_OFF) + (g * 9 + s) * 64 + lane);
    }
    const size_t row0 = (size_t)b * L + 256 * c;
    bf16x8 ufn = *(const bf16x8*)(P + (row0 + l31) * 2560 + 2048 + g * 16 + 8 * hi);
#pragma unroll 1
    for (int step = 0; step < 8; ++step) {
        const bf16x8 uf = ufn;
        if (step < 7) ufn = *(const bf16x8*)(P + (row0 + 32 * (step + 1) + l31) * 2560 + 2048 + g * 16 + 8 * hi);
        f32x16 acc[4];
#pragma unroll
        for (int tt = 0; tt < 4; ++tt) {
#pragma unroll
            for (int r = 0; r < 16; ++r) acc[tt][r] = 0.f;
            acc[tt] = __builtin_amdgcn_mfma_f32_32x32x16_bf16(uf, bbt[tt], acc[tt], 0, 0, 0);
        }
#pragma unroll
        for (int cc = 0; cc < 2; ++cc) {
            f32x16& xr = acc[2 * cc]; f32x16& xi = acc[2 * cc + 1];
#pragma unroll
            for (int k = 0; k < 4; ++k)
#pragma unroll
                for (int i = 1; i < 4; ++i) { const int r = 4 * k + i;
                    const float nr = l1r[cc] * xr[r - 1] - l1i[cc] * xi[r - 1] + xr[r], ni = l1r[cc] * xi[r - 1] + l1i[cc] * xr[r - 1] + xi[r];
                    xr[r] = nr; xi[r] = ni; }
            float C0r = cr[cc], C0i = ci[cc];
            float mr[4], mi[4];
#pragma unroll
            for (int k = 0; k < 4; ++k) {
                const float er = xr[4 * k + 3], ei = xi[4 * k + 3];
                const float pr = __shfl_xor(er, 32), pi = __shfl_xor(ei, 32);
                const float e0r = hi ? pr : er, e0i = hi ? pi : ei, e1r = hi ? er : pr, e1i = hi ? ei : pi;
                float t1r, t1i; cmul(l4r[cc], l4i[cc], C0r, C0i, t1r, t1i); float C1r = t1r + e0r, C1i = t1i + e0i;
                asm volatile("s_nop 3" : "+v"(C1r), "+v"(C1i));
                mr[k] = hi ? C1r : C0r; mi[k] = hi ? C1i : C0i;
                float t2r, t2i; cmul(l4r[cc], l4i[cc], C1r, C1i, t2r, t2i); C0r = t2r + e1r; C0i = t2i + e1i;
                asm volatile("s_nop 3" : "+v"(C0r), "+v"(C0i), "+v"(mr[k]), "+v"(mi[k]));
            }
            cr[cc] = C0r; ci[cc] = C0i;
            if (OUT) {
#pragma unroll
                for (int k = 0; k < 4; ++k) {
                    float tr_, ti_;
                    cmul(l1r[cc], l1i[cc], mr[k], mi[k], tr_, ti_); xr[4 * k] += tr_; xi[4 * k] += ti_;
                    cmul(l2r[cc], l2i[cc], mr[k], mi[k], tr_, ti_); xr[4 * k + 1] += tr_; xi[4 * k + 1] += ti_;
                    cmul(l3r[cc], l3i[cc], mr[k], mi[k], tr_, ti_); xr[4 * k + 2] += tr_; xi[4 * k + 2] += ti_;
                    cmul(l4r[cc], l4i[cc], mr[k], mi[k], tr_, ti_); xr[4 * k + 3] += tr_; xi[4 * k + 3] += ti_;
                }
#pragma unroll
                for (int r = 0; r < 16; ++r) { const int tk = (r & 3) + 8 * (r >> 2) + 4 * hi;
                    *(LAS unsigned*)(xl + tk * 272 + (32 * cc + l31) * 4) = cvt_pk_bf16(xr[r], xi[r]); }
            }
        }
        if (!OUT) {
            if (step == 7 && hi == 0) {
                float* ep = END + ((size_t)((b * 32 + g) * 16 + c) * 64) * 2;
                f32x2 e0; e0.x = cr[0]; e0.y = ci[0]; f32x2 e1; e1.x = cr[1]; e1.y = ci[1];
                *(f32x2*)(ep + l31 * 2) = e0; *(f32x2*)(ep + (32 + l31) * 2) = e1;
            }
        } else {
            LDS_WAIT(); asm volatile("" ::: "memory");
            f32x16 y;
#pragma unroll
            for (int r = 0; r < 16; ++r) y[r] = 0.f;
#pragma unroll
            for (int s = 0; s < 8; ++s) { const bf16x8 xf = *(const LAS bf16x8*)(xl + l31 * 272 + 32 * s + 16 * hi);
                y = __builtin_amdgcn_mfma_f32_32x32x16_bf16(cm[s], xf, y, 0, 0, 0); }
            y = __builtin_amdgcn_mfma_f32_32x32x16_bf16(cm[8], uf, y, 0, 0, 0);
            bf16_t* gp = G + (row0 + 32 * step + l31) * 512 + g * 16 + 4 * hi;
#pragma unroll
            for (int rg = 0; rg < 2; ++rg) {
                float gv[4];
#pragma unroll
                for (int e = 0; e < 4; ++e) { const float v = y[4 * rg + e]; gv[e] = v * fast_sigmoid(1.5957691216057308f * (v + 0.044715f * v * v * v)); }
                u32x2 o; o.x = cvt_pk_bf16(gv[0], gv[1]); o.y = cvt_pk_bf16(gv[2], gv[3]);
                *(u32x2*)(gp + 8 * rg) = o;
            }
            LDS_WAIT(); asm volatile("" ::: "memory");
        }
    }
}

struct EpiGlu {
    static constexpr bool PERM = true;
    const bf16_t* G; const float* bias; bf16_t* MG;
    __device__ __forceinline__ void operator()(const f32x4 (&acc)[2][2][4][2], const Unit& u, int wr, int wc, int fr, int fq) const {
        const int row0 = u.pm * 256 + wr * 64 + fr;
#pragma unroll
        for (int ai = 0; ai < 2; ++ai)
#pragma unroll
            for (int m = 0; m < 4; ++m) {
                const int row = row0 + ai * 128 + m * 16;
#pragma unroll
                for (int bj = 0; bj < 2; ++bj) {
                    const int col = u.pn * 256 + bj * 128 + wc * 32 + 8 * fq;
                    const u32x4 gq = *(const u32x4*)(G + (size_t)row * 512 + col);
                    const f32x4 b0 = *(const f32x4*)(bias + col), b1 = *(const f32x4*)(bias + col + 4);
                    const f32x4 z0 = acc[ai][bj][m][0] + b0, z1 = acc[ai][bj][m][1] + b1;
                    u32x4 o;
                    o.x = cvt_pk_bf16(bflo(gq.x) * fast_sigmoid(z0[0]), bfhi(gq.x) * fast_sigmoid(z0[1]));
                    o.y = cvt_pk_bf16(bflo(gq.y) * fast_sigmoid(z0[2]), bfhi(gq.y) * fast_sigmoid(z0[3]));
                    o.z = cvt_pk_bf16(bflo(gq.z) * fast_sigmoid(z1[0]), bfhi(gq.z) * fast_sigmoid(z1[1]));
                    o.w = cvt_pk_bf16(bflo(gq.w) * fast_sigmoid(z1[2]), bfhi(gq.w) * fast_sigmoid(z1[3]));
                    *(u32x4*)(MG + (size_t)row * D + 512 + col) = o;
                }
            }
    }
};
struct Args {
    const float* in[25]; float* out; unsigned char* ws; int ph_lo, ph_hi;
};
enum { PH_PROLOGUE = 0, PH_INPROJ = 1, PH_MIX_A = 2, PH_MIX_B = 3, PH_GLU = 4, PH_OUTPROJ0 = 5, PH_ROUTER0 = 6, PH_GATEUP0 = 7, PH_DOWN0 = 8, PH_QKV = 9, PH_ATTN_AB = 10, PH_ATTN_C = 11, PH_OUTPROJ1 = 12, PH_ROUTER1 = 13, PH_MOE1X = 14, PH_MOE1Y = 15, PH_MOE1Z = 16, PH_FINAL = 17, PH_COUNT = 18 };

enum { CF_IN = 0, CF_OUT = 1, CF_GLU = 2, CF_QKV = 3, CF_CO = 4, CF_G = 5, CF_U = 6, CF_D = 7 };
struct ConvSeg { int fam, lo, n; };
template <int FAM>
__device__ __forceinline__ void conv_item(const Args& a, LAS float* scr, int r, int lane) {
    unsigned char* ws = a.ws;
    if (FAM == CF_IN) tr_item<1>(a.in[4], 2560, (bf16_t*)(ws + WS_WIN), 1024, 0, 0, a.in[1], scr, r, lane);
    else if (FAM == CF_OUT) tr_item<0>(a.in[5], 1024, (bf16_t*)(ws + WS_WOUT), 1024, 0, 0, nullptr, scr, r, lane);
    else if (FAM == CF_GLU) tr_item<0>(a.in[14], 512, (bf16_t*)(ws + WS_WGLU), 512, 0, 0, nullptr, scr, r, lane);
    else if (FAM == CF_QKV) tr_item<0>(a.in[16], 3072, (bf16_t*)(ws + WS_WQKV), 1024, 0, 0, a.in[1] + D, scr, r, lane);
    else if (FAM == CF_CO) tr_item<0>(a.in[17], 1024, (bf16_t*)(ws + WS_CWOUT), 1024, 0, 0, nullptr, scr, r, lane);
    else if (FAM == CF_G) { const int le = r >> 8, layer = le >> 4, ge = le & 15;
        tr_item<2>(a.in[22] + (size_t)le * 1024 * 512, 512, (bf16_t*)(ws + WS_WGU + layer * WS_MOE_LAYER) + (size_t)ge * 1024 * 1024, 1024, 0, 0, a.in[2] + layer * D, scr, r & 255, lane); }
    else if (FAM == CF_U) { const int le = r >> 8, layer = le >> 4, ge = le & 15;
        tr_item<3>(a.in[23] + (size_t)le * 1024 * 512, 512, (bf16_t*)(ws + WS_WGU + layer * WS_MOE_LAYER) + (size_t)ge * 1024 * 1024, 1024, 0, 0, a.in[2] + layer * D, scr, r & 255, lane); }
    else { const int le = r >> 8, layer = le >> 4, g = (le >> 2) & 3, e = le & 3;
        tr_item<0>(a.in[24] + (size_t)le * 512 * 1024, 1024, (bf16_t*)(ws + WS_WD + layer * WS_MOE_LAYER) + (size_t)g * 1024 * 2048, 2048, e * 512, 0, nullptr, scr, r & 255, lane); }
}
template <int SLOT>
__device__ __forceinline__ void conv_run(Frame& F, const Args& a, int widx, int wcount) {
    LAS float* scr = (LAS float*)(F.lds + F.wave * 16384);
    if (SLOT == 0) {
        constexpr int N0 = 16 * 80, N1 = 16 * 32, N2 = 8 * 16;
        for (int it = widx; it < N0 + N1 + N2; it += wcount) { int r = it;
            if (r < N0) { conv_item<CF_IN>(a, scr, r, F.lane); continue; } r -= N0;
            if (r < N1) { conv_item<CF_OUT>(a, scr, r, F.lane); continue; } r -= N1;
            conv_item<CF_GLU>(a, scr, r, F.lane); }
    } else if (SLOT == 1) {
        constexpr int N0 = 4096, N1 = 2048;
        for (int it = widx; it < N0 + N1; it += wcount) { int r = it;
            if (r < N0) { conv_item<CF_U>(a, scr, r, F.lane); continue; } r -= N0;
            conv_item<CF_G>(a, scr, r, F.lane); }
    } else if (SLOT == 4) {
        constexpr int N0 = 16 * 32, N1 = 4096, N2 = 16 * 96;
        for (int it = widx; it < N0 + N1 + N2; it += wcount) { int r = it;
            if (r < N0) { conv_item<CF_CO>(a, scr, r, F.lane); continue; } r -= N0;
            if (r < N1) { conv_item<CF_G>(a, scr, 4096 + r, F.lane); continue; } r -= N1;
            conv_item<CF_QKV>(a, scr, r, F.lane); }
    } else if (SLOT == 3) {
        for (int it = widx; it < 6144; it += wcount) { if (it < 4096) conv_item<CF_D>(a, scr, it, F.lane); else conv_item<CF_G>(a, scr, it - 2048, F.lane); }
    } else {
        for (int it = widx; it < 8192; it += wcount) {
            if (it < 4096) conv_item<CF_U>(a, scr, 4096 + it, F.lane); else conv_item<CF_D>(a, scr, it, F.lane); }
    }
}
__device__ __forceinline__ void p0_prologue(Frame& F, const Args& a) {
    unsigned char* ws = a.ws;
    const int gw = F.vcu * NWAVES + F.wave, NGW = F.G * NWAVES;
    conv_run<0>(F, a, gw, NGW);
    const float* x = a.in[0]; bf16_t* XB = (bf16_t*)(ws + WS_XB); float* ss0 = (float*)(ws + WS_SS0);
    for (int m = gw; m < T; m += NGW) {
        const f32x4* xr = (const f32x4*)(x + (size_t)m * D) + F.lane;
        f32x4 v[4]; float s = 0.f;
#pragma unroll
        for (int j = 0; j < 4; ++j) { v[j] = xr[64 * j]; s += (v[j].x * v[j].x + v[j].y * v[j].y) + (v[j].z * v[j].z + v[j].w * v[j].w); }
        s = wave_sum(s);
        u32x2* o8 = (u32x2*)(XB + (size_t)m * D) + F.lane;
#pragma unroll
        for (int j = 0; j < 4; ++j) { u32x2 w; w.x = pk2(v[j].x, v[j].y); w.y = pk2(v[j].z, v[j].w); o8[64 * j] = w; }
        if (F.lane == 0) __hip_atomic_store(ss0 + m, s, RLX_AGENT);
    }
    s5_tables(ws + WS_S5T, a.in[6], a.in[7], a.in[8], a.in[9], a.in[10], a.in[11], a.in[12], a.in[13], F.vcu * NWAVES * 64 + F.tid, F.G * NWAVES * 64);
    {   float* rtw = (float*)(ws + WS_RTW);
        for (int i = (F.vcu * NWAVES * 64) + F.tid; i < 2 * 20 * 1024; i += F.G * NWAVES * 64) {
            const int layer = i / 20480, r = i - layer * 20480, j = r >> 10, k = r & 1023;
            const float wv = j < 4 ? a.in[18][(size_t)layer * 4096 + k * 4 + j] : a.in[20][(size_t)layer * 16384 + k * 16 + (j - 4)];
            rtw[i] = wv * a.in[2][layer * D + k]; } }
    float* rope = (float*)(ws + WS_ROPE);
    for (int i = (F.vcu * NWAVES * 64) + F.tid; i < L * 64; i += F.G * NWAVES * 64) {
        const int j = i & 63, pos = i >> 6;
        const float inv = powf(10000.0f, -(float)j / 64.0f);
        const float ang = (float)pos * inv;
        rope[i] = cosf(ang); rope[L * 64 + i] = sinf(ang);
    }
}

__device__ __forceinline__ void router_phase(Frame& F, const Args& a, int layer) {
    unsigned char* ws = a.ws;
    LAS float* wT = (LAS float*)F.lds;
    LAS float* gn = wT + 20 * 1024;
    LAS float* bias = gn + 1024;
    LAS int* rcls = (LAS int*)(bias + 32);
    LAS float* rwl = (LAS float*)(rcls + 64);
    LAS float* rwh = rwl + 64;
    LAS int* cbase = (LAS int*)(rwh + 64);
    const float* wg = a.in[18] + (size_t)layer * 4096; const float* bg = a.in[19] + layer * 4;
    const float* wrr = a.in[20] + (size_t)layer * 16384; const float* brr = a.in[21] + layer * 16;
    const float* gain = a.in[2] + layer * D;
    unsigned* cnt = F.ctl + (layer ? CW_CLS1 : CW_CLS0);
    const bf16_t* H = layer ? (const bf16_t*)(ws + WS_XB) : (const bf16_t*)a.out;
    int* list = (int*)(ws + WS_LIST); f32x2* lw = (f32x2*)(ws + WS_LW);
    {   const f32x4* rt = (const f32x4*)(ws + WS_RTW) + (size_t)layer * 5120;
#pragma unroll
        for (int i = 0; i < 10; ++i) ((LAS f32x4*)wT)[F.tid + 512 * i] = rt[F.tid + 512 * i]; }
    if (F.tid < 4) bias[F.tid] = bg[F.tid]; else if (F.tid < 20) bias[F.tid] = brr[F.tid - 4];
    __syncthreads();
    for (int rb = F.vcu; rb < T / 64; rb += F.G) {
        constexpr int RB = 4;
        u32x2 nv[RB][4];
#pragma unroll
        for (int r = 0; r < RB; ++r) { const u32x2* hr0 = (const u32x2*)(H + (size_t)(rb * 64 + F.wave * 8 + r) * D) + F.lane;
#pragma unroll
            for (int j = 0; j < 4; ++j) nv[r][j] = hr0[64 * j]; }
#pragma unroll 1
        for (int rg = 0; rg < 8 / RB; ++rg) {
            const int rloc0 = F.wave * 8 + rg * RB, row0 = rb * 64 + rloc0;
            f32x4 v[RB][4]; float rstd[RB];
#pragma unroll
            for (int r = 0; r < RB; ++r)
#pragma unroll
                for (int j = 0; j < 4; ++j) v[r][j] = (f32x4){bflo(nv[r][j].x), bfhi(nv[r][j].x), bflo(nv[r][j].y), bfhi(nv[r][j].y)};
            if (rg + 1 < 8 / RB) {
#pragma unroll
                for (int r = 0; r < RB; ++r) { const u32x2* hr = (const u32x2*)(H + (size_t)(row0 + RB + r) * D) + F.lane;
#pragma unroll
                    for (int j = 0; j < 4; ++j) nv[r][j] = hr[64 * j]; } }
#pragma unroll
            for (int r = 0; r < RB; ++r) { float s = 0.f;
#pragma unroll
                for (int j = 0; j < 4; ++j) s += (v[r][j].x * v[r][j].x + v[r][j].y * v[r][j].y) + (v[r][j].z * v[r][j].z + v[r][j].w * v[r][j].w);
                rstd[r] = rsqrtf(wave_allsum(s) * (1.0f / D) + RMS_EPS); }
            float lgg[RB][4];
#pragma unroll
            for (int i = 0; i < 4; ++i) { float acc[RB];
#pragma unroll
                for (int r = 0; r < RB; ++r) acc[r] = 0.f;
#pragma unroll
                for (int j = 0; j < 4; ++j) { const f32x4 w4 = *(const LAS f32x4*)(wT + i * 1024 + 256 * j + 4 * F.lane);
#pragma unroll
                    for (int r = 0; r < RB; ++r) acc[r] += (v[r][j].x * w4.x + v[r][j].y * w4.y) + (v[r][j].z * w4.z + v[r][j].w * w4.w); }
                const float bi = bias[i];
#pragma unroll
                for (int r = 0; r < RB; ++r) lgg[r][i] = wave_allsum(acc[r]) * rstd[r] + bi; }
#pragma unroll
            for (int r = 0; r < RB; ++r) {
                const float* lg = lgg[r]; const int rloc = rloc0 + r;
                int gs = 0; float gm = lg[0];
#pragma unroll
                for (int i = 1; i < 4; ++i) if (lg[i] > gm) { gm = lg[i]; gs = i; }
                float se = 0.f;
#pragma unroll
                for (int i = 0; i < 4; ++i) se += expf(lg[i] - gm);
                const float gval = 1.0f / se;
                float ev[4];
#pragma unroll
                for (int i = 0; i < 4; ++i) { const LAS float* wrow = wT + (4 + gs * 4 + i) * 1024; float acc = 0.f;
#pragma unroll
                    for (int j = 0; j < 4; ++j) { const f32x4 w4 = *(const LAS f32x4*)(wrow + 256 * j + 4 * F.lane); acc += (v[r][j].x * w4.x + v[r][j].y * w4.y) + (v[r][j].z * w4.z + v[r][j].w * w4.w); }
                    ev[i] = wave_allsum(acc) * rstd[r] + bias[4 + gs * 4 + i]; }
                int i1 = 0; float v1 = ev[0];
#pragma unroll
                for (int i = 1; i < 4; ++i) if (ev[i] > v1) { v1 = ev[i]; i1 = i; }
                int i2 = -1; float v2 = -3.0e38f;
#pragma unroll
                for (int i = 0; i < 4; ++i) if (i != i1 && ev[i] > v2) { v2 = ev[i]; i2 = i; }
                const float e2 = expf(v2 - v1);
                const float w1 = gval / (1.0f + e2), w2 = gval * e2 / (1.0f + e2);
                const int lo = i1 < i2 ? i1 : i2, hi = i1 < i2 ? i2 : i1;
                const int pidx = lo == 0 ? hi - 1 : (lo == 1 ? hi + 1 : 5);
                if (F.lane == 0) { rcls[rloc] = gs * 6 + pidx; rwl[rloc] = __uint_as_float(pk2(i1 < i2 ? w1 : w2, i1 < i2 ? w2 : w1)); rwh[rloc] = rstd[r]; }
            }
        }
        __syncthreads();
        if (F.tid < 24) { int tot = 0; for (int r = 0; r < 64; ++r) tot += (rcls[r] == F.tid) ? 1 : 0;
            cbase[F.tid] = tot ? (int)__hip_atomic_fetch_add(cnt + 64 * F.tid, (unsigned)tot, RLX_AGENT) : 0; }
        __syncthreads();
        if (F.tid < 64) { const int myc = rcls[F.tid]; int rank = 0; for (int r = 0; r < F.tid; ++r) rank += (rcls[r] == myc) ? 1 : 0;
            const int pos = cbase[myc] + rank; __hip_atomic_store(list + myc * 16384 + pos, rb * 64 + F.tid, RLX_AGENT);
            __hip_atomic_store((unsigned long long*)(lw + myc * 16384 + pos), ((unsigned long long)__float_as_uint(rwh[F.tid]) << 32) | __float_as_uint(rwl[F.tid]), RLX_AGENT); }
        __syncthreads();
    }
}
__device__ __forceinline__ void moe_setup(Frame& F, int layer) {
    LAS int* tb = (LAS int*)(F.lds + MOE_TB_OFF); LAS int* cc = tb + 25;
    if (F.tid == 0) { const unsigned* cnt = F.ctl + (layer ? CW_CLS1 : CW_CLS0); int run = 0;
        for (int c = 0; c < 24; ++c) { const int n = (int)__hip_atomic_load(cnt + 64 * c, RLX_AGENT); cc[c] = n; tb[c] = run; run += (n + 255) >> 8; }
        tb[24] = run; }
    __syncthreads();
}
template <bool LAST>
__device__ __forceinline__ void moe_phases(Frame& F, const Args& a, int layer, int which) {
    unsigned char* ws = a.ws;
    moe_setup(F, layer);
    const LAS int* tb = (const LAS int*)(F.lds + MOE_TB_OFF); const LAS int* cc = tb + 25;
    if (which == 0) {
        MoeOrder S{layer ? (const char*)(ws + WS_XB) : (const char*)a.out, (const char*)(ws + WS_WGU + layer * WS_MOE_LAYER), (const int*)(ws + WS_LIST), tb, cc, 8, F.G, F.vcu, 0, 0, tb[24] * 8};
        EpiGateUp E{(bf16_t*)(ws + WS_P), (const f32x2*)(ws + WS_LW), tb};
        pg8::gemm_phase<EpiGateUp, MoeOrder, true, true, false>(F.lds, 1024, 1024, 1024, S, E);
        if (layer == 0) {
            __syncthreads();
            const int nGU = tb[24] * 8, start = nGU % F.G;
            if (F.vcu >= start) conv_run<4>(F, a, (F.vcu - start) * NWAVES + F.wave, (F.G - start) * NWAVES);
        }
    } else {
        MoeOrder S{(const char*)(ws + WS_P), (const char*)(ws + WS_WD + layer * WS_MOE_LAYER), (const int*)(ws + WS_LIST), tb, cc, 4, F.G, F.vcu, 1, 0, tb[24] * 4};
        EpiDown E{layer ? (const bf16_t*)(ws + WS_XB) : (const bf16_t*)a.out, (bf16_t*)(ws + WS_XB), (float*)(ws + WS_SSP), (const int*)(ws + WS_LIST), tb};
        pg8::gemm_phase<EpiDown, MoeOrder, true, false, true>(F.lds, 1024, 2048, 1024, S, E);
        if (layer == 0) {
            __syncthreads();
            const int nD = tb[24] * 4, start = nD % F.G;
            if (F.vcu >= start) conv_run<2>(F, a, (F.vcu - start) * NWAVES + F.wave, (F.G - start) * NWAVES);
        }
    }
    __syncthreads();
}
template <int SUB>
__device__ __forceinline__ void moe_sub(Frame& F, const Args& a) {
    unsigned char* ws = a.ws; constexpr int layer = 1;
    moe_setup(F, layer);
    const LAS int* tb = (const LAS int*)(F.lds + MOE_TB_OFF); const LAS int* cc = tb + 25;
    const int nt = tb[24], nGU = nt * 8, nD = nt * 4, full = (nGU / F.G) * F.G, rest = nGU - full;
    int dY = F.G - rest; { const int cap = (full >> 3) * 4; dY = dY < cap ? dY : cap; dY = dY < nD ? dY : nD; }
    if (SUB < 2) {
        MoeOrder S{(const char*)(ws + WS_XB), (const char*)(ws + WS_WGU + layer * WS_MOE_LAYER), (const int*)(ws + WS_LIST), tb, cc, 8, F.G, F.vcu, 0, SUB == 0 ? 0 : full, SUB == 0 ? full : nGU};
        EpiGateUp E{(bf16_t*)(ws + WS_P), (const f32x2*)(ws + WS_LW), tb};
        pg8::gemm_phase<EpiGateUp, MoeOrder, true, true, false>(F.lds, 1024, 1024, 1024, S, E);
    }
    if (SUB > 0) {
        MoeOrder S{(const char*)(ws + WS_P), (const char*)(ws + WS_WD + layer * WS_MOE_LAYER), (const int*)(ws + WS_LIST), tb, cc, 4, SUB == 1 ? F.G - rest : F.G, SUB == 1 ? F.vcu - rest : F.vcu, 1, SUB == 1 ? 0 : dY, SUB == 1 ? dY : nD};
        EpiDown E{(const bf16_t*)(ws + WS_XB), (bf16_t*)(ws + WS_XB), (float*)(ws + WS_SSP), (const int*)(ws + WS_LIST), tb};
        pg8::gemm_phase<EpiDown, MoeOrder, true, false, true>(F.lds, 1024, 2048, 1024, S, E);
    }
    __syncthreads();
}
__device__ __forceinline__ void final_phase(Frame& F, const Args& a) {
    const float* ss = (const float*)(a.ws + WS_SSP); const float* gain = a.in[3]; const bf16_t* H = (const bf16_t*)(a.ws + WS_XB);
    const int gw = F.vcu * NWAVES + F.wave, NGW = F.G * NWAVES;
    f32x4 g4[4];
#pragma unroll
    for (int j = 0; j < 4; ++j) g4[j] = *((const f32x4*)gain + F.lane + 64 * j);
    for (int m = gw; m < T; m += NGW) {
        f32x4* hr = (f32x4*)(a.out + (size_t)m * D) + F.lane;
        const u32x2* hs = (const u32x2*)(H + (size_t)m * D) + F.lane;
        const f32x4* sp = (const f32x4*)(ss + (size_t)m * 32);
        const f32x4 s4 = (sp[0] + sp[1]) + (sp[2] + sp[3]);
        const float rstd = rsqrtf(((s4[0] + s4[1]) + (s4[2] + s4[3])) * (1.0f / D) + RMS_EPS);
#pragma unroll
        for (int j = 0; j < 4; ++j) { const u32x2 q = hs[64 * j]; hr[64 * j] = (f32x4){bflo(q.x), bfhi(q.x), bflo(q.y), bfhi(q.y)} * rstd * g4[j]; }
    }
}

__global__ void __launch_bounds__(NWAVES * 64, 2) mega(Args args) {
    extern __shared__ __attribute__((aligned(16))) unsigned char lds[];
    Frame F;
    F.lds = (LAS unsigned char*)lds;
    F.MISC = (volatile LAS unsigned*)(F.lds + MISC_OFF);
    F.tid = threadIdx.x; F.lane = F.tid & 63; F.wave = __builtin_amdgcn_readfirstlane(F.tid >> 6);
    F.G = gridDim.x; { const int bx = blockIdx.x; F.vcu = (F.G % 8 == 0) ? (bx % 8) * (F.G / 8) + bx / 8 : bx; }
    unsigned char* ws = args.ws;
    F.ctl = (unsigned*)ws;
    for (int u = F.tid; u < (LDS_BYTES - LDSCTL_OFF) / 4; u += NWAVES * 64) ((LAS unsigned*)(F.lds + LDSCTL_OFF))[u] = 0u;
    __syncthreads();
    const int lo = args.ph_lo, hi = args.ph_hi;
    XcdBarrier bar; bar.bar = F.ctl + CW_BAR; bar.x = 0; bar.st = nullptr;
    if (hi - lo > 1) bar = xcd_barrier_post(F.ctl + CW_BAR, F.MISC + 8);
#define IN(k) (lo <= (k) && (k) < hi)
#define SEAM(k) do { if (IN(k) && IN((k) + 1)) xcd_barrier(bar); } while (0)

    if (IN(PH_PROLOGUE)) {
        p0_prologue(F, args); SEAM(PH_PROLOGUE); }
    if (IN(PH_INPROJ)) {
        PlainOrder S; S.init(ws + WS_XB, ws + WS_WIN, 1024, 1024, T, 2560, F.G, (int)blockIdx.x);
        EpiInProj E{(bf16_t*)(ws + WS_P), (const float*)(ws + WS_SS0), (const float*)(ws + WS_ROPE)};
        pg8::gemm_phase<EpiInProj, PlainOrder, true, false, false>(F.lds, 1024, 1024, 1024, S, E);
        { const int nun = (T / 256) * 10, start = nun % F.G, bx = (int)blockIdx.x;
          __syncthreads();
          if (bx >= start) conv_run<3>(F, args, (bx - start) * NWAVES + F.wave, (F.G - start) * NWAVES); }
        SEAM(PH_INPROJ);
    }
    if (IN(PH_MIX_A)) {
        for (int u = F.vcu; u < 256; u += F.G) ret_kv_unit(F.lds, (const bf16_t*)(ws + WS_P), (bf16_t*)(ws + WS_XB), u >> 6, (u >> 4) & 3, u & 15, F.tid);
        for (int t = F.vcu * NWAVES + F.wave; t < 2048; t += F.G * NWAVES)
            s5_task<false>((const bf16_t*)(ws + WS_P), ws + WS_S5T, (float*)(ws + WS_S5END), nullptr, F.lds + F.wave * 8704, t >> 9, (t >> 4) & 31, t & 15, F.lane);
        SEAM(PH_MIX_A);
    }
    if (IN(PH_MIX_B)) {
        for (int u = F.vcu; u < 256; u += F.G) ret_out_unit(F.lds, (const bf16_t*)(ws + WS_P), (const bf16_t*)(ws + WS_XB), (bf16_t*)(ws + WS_MG), u >> 6, (u >> 4) & 3, u & 15, F.tid);
        for (int t = F.vcu * NWAVES + F.wave; t < 2048; t += F.G * NWAVES)
        {   const int v_ = t >> 3, wv_ = t & 7;
            s5_task<true>((const bf16_t*)(ws + WS_P), ws + WS_S5T, (float*)(ws + WS_S5END), (bf16_t*)(ws + WS_XB + 8 * MiB), F.lds + F.wave * 8704, v_ >> 6, (v_ & 3) * 8 + wv_, (v_ >> 2) & 15, F.lane); }
        SEAM(PH_MIX_B);
    }
    if (IN(PH_GLU)) {
        PlainOrder S; S.init(ws + WS_XB + 8 * MiB, ws + WS_WGLU, 512, 512, T, 512, F.G, (int)blockIdx.x);
        EpiGlu E{(const bf16_t*)(ws + WS_XB + 8 * MiB), args.in[15], (bf16_t*)(ws + WS_MG)};
        pg8::gemm_phase<EpiGlu, PlainOrder, true, false, false>(F.lds, 512, 512, 512, S, E);
        { const int nun = (T / 256) * 2, bx = (int)blockIdx.x;
          if (bx >= nun && F.G > nun) conv_run<1>(F, args, (bx - nun) * NWAVES + F.wave, (F.G - nun) * NWAVES);
          else if (F.G <= nun) conv_run<1>(F, args, bx * NWAVES + F.wave, F.G * NWAVES); }
        SEAM(PH_GLU);
    }
    if (IN(PH_OUTPROJ0)) {
        PlainOrder S; S.init(ws + WS_MG, ws + WS_WOUT, 1024, 1024, T, 1024, F.G, (int)blockIdx.x);
        EpiOutRes<true> E{args.in[0], nullptr, (bf16_t*)args.out};
        pg8::gemm_phase<EpiOutRes<true>, PlainOrder, true, false, false>(F.lds, 1024, 1024, 1024, S, E);
        SEAM(PH_OUTPROJ0);
    }
    if (IN(PH_ROUTER0)) { router_phase(F, args, 0); SEAM(PH_ROUTER0); }
    if (IN(PH_GATEUP0)) { moe_phases<false>(F, args, 0, 0); SEAM(PH_GATEUP0); }
    if (IN(PH_DOWN0)) { moe_phases<false>(F, args, 0, 1); SEAM(PH_DOWN0); }
    if (IN(PH_QKV)) {
        PlainOrder S; S.init(ws + WS_XB, ws + WS_WQKV, 1024, 1024, T, 3072, F.G, (int)blockIdx.x);
        EpiQKV E{(bf16_t*)(ws + WS_P), (const float*)(ws + WS_SSP), 0.08838834764831845f * 1.4426950408889634f};
        pg8::gemm_phase<EpiQKV, PlainOrder, true, false, false>(F.lds, 1024, 1024, 1024, S, E);
        SEAM(PH_QKV);
    }
    if (IN(PH_ATTN_AB)) {
        const bf16_t* P = (const bf16_t*)(ws + WS_P); float* lse = (float*)(ws + WS_LSE);
        const int per = (2048 + F.G - 1) / F.G; const int u0 = F.vcu * per, u1 = (u0 + per < 2048) ? u0 + per : 2048;
        u32x4 kreg[8], vreg[8];
#define ATT_DEC_AB(u, b_, h_, r_, n_, d_) const int b_ = (u) < 1024 ? (u) >> 8 : ((u) - 1024) >> 8, h_ = (u) < 1024 ? ((u) >> 5) & 7 : (((u) - 1024) >> 5) & 7, r_ = (u) < 1024 ? 0 : (((u) - 1024) >> 3) & 3, n_ = (u) < 1024 ? (u) & 31 : ((u) - 1024) & 7, d_ = (u) < 1024 ? 1 : 4
        bool full = true;
        if (u0 < u1) { ATT_DEC_AB(u0, b0, h0, r0, n0, d0); attn_load(P, b0, h0, r0, n0, d0, F.tid, true, kreg, vreg); }
#pragma unroll 1
        for (int u = u0; u < u1; ++u) {
            ATT_DEC_AB(u, bc, hc, rc, nc, dc);
            attn_store(F.lds, F.tid, nc, full, kreg, vreg);
            __syncthreads();
            bf16x8 qf[4]; attn_loadq(P, bc, hc, rc, nc, dc, F.tid, qf);
            if (u + 1 < u1) { ATT_DEC_AB(u + 1, b1, h1, r1, n1, d1);
                full = !(b1 == bc && h1 == hc && r1 == rc && d1 == dc && n1 == nc + 1);
                attn_load(P, b1, h1, r1, n1, d1, F.tid, full, kreg, vreg); }
            attn_compute<false>(F.lds, P, (u < 1024 ? (bf16_t*)args.out + (size_t)T * D : (bf16_t*)(ws + WS_MG)), lse + (u < 1024 ? 0 : (size_t)T * 8), nullptr, nullptr, nullptr, nullptr, bc, hc, rc, nc, dc, F.tid, qf);
            __syncthreads();
        }
        SEAM(PH_ATTN_AB);
    }
    if (IN(PH_ATTN_C)) {
        const bf16_t* P = (const bf16_t*)(ws + WS_P); float* lse = (float*)(ws + WS_LSE);
        const int per = (1024 + F.G - 1) / F.G; const int u0 = F.vcu * per, u1 = (u0 + per < 1024) ? u0 + per : 1024;
        u32x4 kreg[8], vreg[8];
        bool full = true;
        if (u0 < u1) attn_load(P, u0 >> 8, (u0 >> 5) & 7, (u0 >> 1) & 15, u0 & 1, 16, F.tid, true, kreg, vreg);
#pragma unroll 1
        for (int u = u0; u < u1; ++u) {
            attn_store(F.lds, F.tid, u & 1, full, kreg, vreg);
            __syncthreads();
            bf16x8 qf[4]; attn_loadq(P, u >> 8, (u >> 5) & 7, (u >> 1) & 15, u & 1, 16, F.tid, qf);
            if (u + 1 < u1) { full = !(((u + 1) >> 1) == (u >> 1) && ((u + 1) & 1) == (u & 1) + 1);
                attn_load(P, (u + 1) >> 8, ((u + 1) >> 5) & 7, ((u + 1) >> 1) & 15, (u + 1) & 1, 16, F.tid, full, kreg, vreg); }
            attn_compute<true>(F.lds, P, (bf16_t*)(ws + WS_MG), nullptr, (const bf16_t*)args.out + (size_t)T * D, (const bf16_t*)(ws + WS_MG), lse, lse + (size_t)T * 8, u >> 8, (u >> 5) & 7, (u >> 1) & 15, u & 1, 16, F.tid, qf);
            __syncthreads();
        }
        SEAM(PH_ATTN_C);
    }
    if (IN(PH_OUTPROJ1)) {
        PlainOrder S; S.init(ws + WS_MG, ws + WS_CWOUT, 1024, 1024, T, 1024, F.G, (int)blockIdx.x);
        EpiOutRes<false> E{nullptr, (const bf16_t*)(ws + WS_XB), (bf16_t*)(ws + WS_XB)};
        pg8::gemm_phase<EpiOutRes<false>, PlainOrder, true, false, false>(F.lds, 1024, 1024, 1024, S, E);
        SEAM(PH_OUTPROJ1);
    }
    if (IN(PH_ROUTER1)) { router_phase(F, args, 1); SEAM(PH_ROUTER1); }
    if (IN(PH_MOE1X)) { moe_sub<0>(F, args); SEAM(PH_MOE1X); }
    if (IN(PH_MOE1Y)) { moe_sub<1>(F, args); SEAM(PH_MOE1Y); }
    if (IN(PH_MOE1Z)) { moe_sub<2>(F, args); SEAM(PH_MOE1Z); }
    if (IN(PH_FINAL)) { final_phase(F, args); }
#undef IN
#undef SEAM
}

extern "C" void kernel_launch(void* const* d_in, const int* in_sizes, int n_in, void* d_out, int out_size, void* d_ws, size_t ws_size, hipStream_t stream) {
    static int grid = 0;
    if (grid == 0) {
        if (ws_size < WS_END || n_in != 25) { fprintf(stderr, "kernel_launch: ws %zu < %zu or n_in %d\n", ws_size, (size_t)WS_END, n_in); grid = -1; return; }
        int dev = 0, cus = 0;
        if (hipGetDevice(&dev) != hipSuccess || hipDeviceGetAttribute(&cus, hipDeviceAttributeMultiprocessorCount, dev) != hipSuccess) { grid = -1; return; }
        if (hipFuncSetAttribute((const void*)mega, hipFuncAttributeMaxDynamicSharedMemorySize, LDS_BYTES) != hipSuccess) { fprintf(stderr, "hipFuncSetAttribute failed\n"); grid = -1; return; }
        int per_cu = 0;
        if (hipOccupancyMaxActiveBlocksPerMultiprocessor(&per_cu, (const void*)mega, NWAVES * 64, LDS_BYTES) != hipSuccess || per_cu < 1) fprintf(stderr, "occupancy query says %d\n", per_cu);
        (void)hipGetLastError();
        grid = cus;
    }
    if (grid < 0) return;
    unsigned char* ws = (unsigned char*)d_ws;
    (void)hipMemsetAsync(ws, 0, CTL_ZERO_BYTES, stream);
    Args a{};
    for (int i = 0; i < 25; ++i) a.in[i] = (const float*)d_in[i];
    a.out = (float*)d_out; a.ws = ws;
    a.ph_lo = 0; a.ph_hi = PH_COUNT;
    hipLaunchKernelGGL(mega, dim3(grid), dim3(NWAVES * 64), LDS_BYTES, stream, a);
}
```

```cpp
#include <hip/hip_runtime.h>
#include <stdint.h>
#include <stdio.h>

#define LAS __attribute__((address_space(3)))
#define GAS __attribute__((address_space(1)))
typedef unsigned short bf16_t;
typedef short bf16x8 __attribute__((ext_vector_type(8)));
typedef short s16x4 __attribute__((ext_vector_type(4)));
typedef float f32x4 __attribute__((ext_vector_type(4)));
typedef float f32x2 __attribute__((ext_vector_type(2)));
typedef float f32x16 __attribute__((ext_vector_type(16)));
typedef unsigned u32x4 __attribute__((ext_vector_type(4)));
typedef unsigned u32x2 __attribute__((ext_vector_type(2)));

__device__ __forceinline__ float bf2f(bf16_t v) { return __uint_as_float(((unsigned)v) << 16); }
__device__ __forceinline__ unsigned f2bf(float f) { unsigned u = __float_as_uint(f); return (u + 0x7fffu + ((u >> 16) & 1u)) >> 16; }
__device__ __forceinline__ unsigned pk2(float lo, float hi) { return f2bf(lo) | (f2bf(hi) << 16); }
__device__ __forceinline__ float bflo(unsigned w) { return __uint_as_float(w << 16); }
__device__ __forceinline__ float bfhi(unsigned w) { return __uint_as_float(w & 0xffff0000u); }
__device__ __forceinline__ float wave_sum(float v) {
#pragma unroll
    for (int o = 1; o < 64; o <<= 1) v += __shfl_xor(v, o);
    return v;
}
__device__ __forceinline__ float dpp_add(float v, int ctrl_sel) {
    const int x = __float_as_int(v); int y;
    if (ctrl_sel == 0) y = __builtin_amdgcn_update_dpp(0, x, 0xB1, 0xF, 0xF, false);
    else if (ctrl_sel == 1) y = __builtin_amdgcn_update_dpp(0, x, 0x4E, 0xF, 0xF, false);
    else if (ctrl_sel == 2) y = __builtin_amdgcn_update_dpp(0, x, 0x124, 0xF, 0xF, false);
    else y = __builtin_amdgcn_update_dpp(0, x, 0x128, 0xF, 0xF, false);
    return v + __int_as_float(y);
}
__device__ __forceinline__ float wave_allsum(float v) {
    v = dpp_add(v, 0); v = dpp_add(v, 1); v = dpp_add(v, 2); v = dpp_add(v, 3);
    {   const auto r = __builtin_amdgcn_permlane16_swap(__float_as_uint(v), __float_as_uint(v), false, false);
        v = __uint_as_float(r[0]) + __uint_as_float(r[1]);
        const auto q = __builtin_amdgcn_permlane32_swap(__float_as_uint(v), __float_as_uint(v), false, false);
        v = __uint_as_float(q[0]) + __uint_as_float(q[1]); }
    return v;
}
__device__ __forceinline__ float fast_sigmoid(float x) { return __builtin_amdgcn_rcpf(1.0f + __builtin_amdgcn_exp2f(-1.4426950408889634f * x)); }

namespace pg8 {
constexpr int BM = 256, BK = 64, HALF = 128, HTB = HALF * BK * 2, STAGE_BYTES = 8 * HTB;
__host__ __device__ __forceinline__ int lds_byte(int r, int c) { const int st = (r >> 4) * 2 + (c >> 5), rr = r & 15, cc = c & 31, ob = rr * 64 + cc * 2; return st * 1024 + (ob ^ (((ob >> 9) & 1) << 5)); }
__host__ __device__ __forceinline__ void stage_rc(int b, int& R, int& C) { const int st = b / 1024, sb = b % 1024, swz = sb ^ (((sb >> 9) & 1) << 5); R = (st >> 1) * 16 + swz / 64; C = (st & 1) * 32 + (swz % 64) / 2; }
__host__ __device__ __forceinline__ int perm32(int rho) { const int n = rho >> 4, i = rho & 15; return 8 * (i >> 2) + 4 * n + (i & 3); }

struct Unit { int pm, pn, cls, nvalid; };

__device__ __forceinline__ unsigned cvt_pk_bf16(float lo, float hi) { unsigned r; asm volatile("s_nop 1\n\tv_cvt_pk_bf16_f32 %0, %1, %2" : "=v"(r) : "v"(lo), "v"(hi)); return r; }
typedef __bf16 bf16x2_t __attribute__((ext_vector_type(2)));
__device__ __forceinline__ unsigned cvt_pk_bf16_c(float lo, float hi) { f32x2 v = {lo, hi}; bf16x2_t b = __builtin_convertvector(v, bf16x2_t); return __builtin_bit_cast(unsigned, b); }

template <class Epi, class Sched, bool ALIGN_EPI, bool GATHER, bool BJUMP>
__device__ __forceinline__ void gemm_phase(LAS unsigned char* lds, const int lda, const int ldb, const int K, const Sched& S, const Epi& E) {
    const int tid = threadIdx.x, wid = __builtin_amdgcn_readfirstlane(tid >> 6), lane = tid & 63, wr = wid >> 2, wc = wid & 3, fr = lane & 15, fq = lane >> 4;
    const int nt = K / BK;
    int Rr[2], Cc[2];
    unsigned voffA[2], voffB[2];
#pragma unroll
    for (int i = 0; i < 2; ++i) { int R, C; stage_rc(tid * 16 + i * 8192, R, C); const int Rb = Epi::PERM ? ((R & ~31) + perm32(R & 31)) : R;
        Rr[i] = R; Cc[i] = C;
        voffA[i] = (unsigned)(R * lda + C) * 2u; voffB[i] = (unsigned)(Rb * ldb + C) * 2u; }
    const size_t kstep = (size_t)(BK * 2);
    const size_t hstepA = GATHER ? 0 : (size_t)HALF * lda * 2, hstepB = (size_t)HALF * ldb * 2;
    const unsigned ldsw = (unsigned)wid * 1024u;
    const int aoff = lds_byte(wr * 64 + fr, fq * 8), boff = lds_byte(wc * 32 + fr, fq * 8);
#define PG8_SA(b, h) (((b) * 2 + (h)) * HTB)
#define PG8_SB(b, h) ((4 + (b) * 2 + (h)) * HTB)
#define PG8_STG(bufoff, gbase, o0, o1) do { \
        __builtin_amdgcn_global_load_lds((const unsigned*)((const char*)(gbase) + (o0)), (LAS unsigned*)(lds + (bufoff) + ldsw), 16, 0, 0); \
        __builtin_amdgcn_global_load_lds((const unsigned*)((const char*)(gbase) + (o1)), (LAS unsigned*)(lds + (bufoff) + ldsw + 8192), 16, 0, 0); } while (0)
#define PG8_STGB(bufoff, gbase) PG8_STG(bufoff, gbase, voffB[0], voffB[1])
#define PG8_STGA_CUR(bufoff, gbase, h) PG8_STG(bufoff, (gbase) + (h) * hstepA, GATHER ? gvc[h][0] : voffA[0], GATHER ? gvc[h][1] : voffA[1])
#define PG8_STGA_SEL(bufoff, gbase, h) PG8_STG(bufoff, (gbase) + (h) * hstepA, GATHER ? gvs[h][0] : voffA[0], GATHER ? gvs[h][1] : voffA[1])
#define PG8_LDA(dst, b, h) do { _Pragma("unroll") for (int m = 0; m < 4; ++m) _Pragma("unroll") for (int k = 0; k < 2; ++k) dst[m][k] = *(const LAS bf16x8*)(lds + PG8_SA(b, h) + aoff + m * 2048 + k * 1024); } while (0)
#define PG8_LDB(dst, b, h) do { _Pragma("unroll") for (int n = 0; n < 2; ++n) _Pragma("unroll") for (int k = 0; k < 2; ++k) dst[n][k] = *(const LAS bf16x8*)(lds + PG8_SB(b, h) + boff + n * 2048 + k * 1024); } while (0)
#define PG8_MMA(ai, bj, At, Bt) do { __builtin_amdgcn_s_setprio(1); _Pragma("unroll") for (int m = 0; m < 4; ++m) _Pragma("unroll") for (int n = 0; n < 2; ++n) _Pragma("unroll") for (int k = 0; k < 2; ++k) \
        acc[ai][bj][m][n] = __builtin_amdgcn_mfma_f32_16x16x32_bf16(Bt[n][k], At[m][k], acc[ai][bj][m][n], 0, 0, 0); __builtin_amdgcn_s_setprio(0); } while (0)
#define PG8_WAIT_V(n) asm volatile("s_waitcnt vmcnt(" #n ")" ::: "memory")
#define PG8_WAIT_L(n) asm volatile("s_waitcnt lgkmcnt(" #n ")" ::: "memory")
#define PG8_BAR __builtin_amdgcn_s_barrier()
#define PG8_SCHED __builtin_amdgcn_sched_barrier(0)
    Unit cur, nxt; int ui = 0;
    if (!S.next(0, cur)) return;
    f32x4 acc[2][2][4][2];
#pragma unroll
    for (int a = 0; a < 2; ++a)
#pragma unroll
        for (int b = 0; b < 2; ++b)
#pragma unroll
            for (int m = 0; m < 4; ++m)
#pragma unroll
                for (int n = 0; n < 2; ++n) acc[a][b][m][n] = (f32x4){0.f, 0.f, 0.f, 0.f};
    bf16x8 At[4][2], B0[2][2], B1[2][2];
    unsigned gvc[2][2], gvn[2][2], gvs[2][2];
    const char* cA = S.a_base(cur); const char* cB = S.b_base(cur);
    long cJ = 0;
    if constexpr (BJUMP) cJ = S.b_jump(cur);
    if constexpr (GATHER) { S.a_voff(cur, Rr[0], Rr[1], Cc[0], Cc[1], gvc); }
    else { gvc[0][0] = gvc[0][1] = gvc[1][0] = gvc[1][1] = 0u; }
    PG8_STGB(PG8_SB(0, 0), cB); PG8_STGB(PG8_SB(0, 1), cB + hstepB); PG8_STGA_CUR(PG8_SA(0, 0), cA, 0); PG8_STGA_CUR(PG8_SA(0, 1), cA, 1);
    if (wr == 1) PG8_BAR;
    PG8_WAIT_V(2); PG8_BAR;
    PG8_STGB(PG8_SB(1, 0), cB + kstep); PG8_STGA_CUR(PG8_SA(1, 0), cA + kstep, 0); PG8_STGB(PG8_SB(1, 1), cB + hstepB + kstep);
    PG8_WAIT_V(6); PG8_BAR;
    for (;;) {
        const bool has_next = S.next(ui + 1, nxt);
        const char* nA = has_next ? S.a_base(nxt) : cA; const char* nB = has_next ? S.b_base(nxt) : cB;
        if constexpr (GATHER) { if (has_next) S.a_voff(nxt, Rr[0], Rr[1], Cc[0], Cc[1], gvn); else { gvn[0][0] = gvc[0][0]; gvn[0][1] = gvc[0][1]; gvn[1][0] = gvc[1][0]; gvn[1][1] = gvc[1][1]; } }
        for (int t = 0; t < nt; t += 2) {
            const bool last = (t == nt - 2);
            const char* a1 = cA + (size_t)(t + 1) * kstep;
            const char* a2 = last ? nA : cA + (size_t)(t + 2) * kstep;
            const char* b2 = last ? nB : cB + (size_t)(t + 2) * kstep + ((BJUMP && (t + 2) >= 8) ? cJ : 0);
            const char* a3 = a2 + kstep; const char* b3 = b2 + kstep;
            if constexpr (GATHER) {
#pragma unroll
                for (int h = 0; h < 2; ++h)
#pragma unroll
                    for (int i = 0; i < 2; ++i) gvs[h][i] = last ? gvn[h][i] : gvc[h][i];
            }
            PG8_LDB(B0, 0, 0); PG8_LDB(B1, 0, 1); PG8_SCHED; PG8_LDA(At, 0, 0); PG8_STGA_CUR(PG8_SA(1, 1), a1, 1);
            PG8_WAIT_V(8); PG8_WAIT_L(0); PG8_BAR; PG8_MMA(0, 0, At, B0); PG8_MMA(0, 1, At, B1); PG8_BAR; PG8_SCHED;
            PG8_LDA(At, 0, 1); PG8_STGB(PG8_SB(0, 0), b2); PG8_STGB(PG8_SB(0, 1), b2 + hstepB); PG8_STGA_SEL(PG8_SA(0, 0), a2, 0);
            PG8_WAIT_V(8); PG8_WAIT_L(0); PG8_BAR; PG8_MMA(1, 0, At, B0); PG8_MMA(1, 1, At, B1); PG8_BAR; PG8_SCHED;
            PG8_LDB(B0, 1, 0); PG8_LDB(B1, 1, 1); PG8_SCHED; PG8_LDA(At, 1, 0); PG8_STGA_SEL(PG8_SA(0, 1), a2, 1);
            PG8_WAIT_V(8); PG8_WAIT_L(0); PG8_BAR; PG8_MMA(0, 0, At, B0); PG8_MMA(0, 1, At, B1); PG8_BAR; PG8_SCHED;
            PG8_LDA(At, 1, 1); PG8_STGB(PG8_SB(1, 0), b3); PG8_STGB(PG8_SB(1, 1), b3 + hstepB); PG8_STGA_SEL(PG8_SA(1, 0), a3, 0);
            PG8_WAIT_V(8); PG8_WAIT_L(0); PG8_BAR; PG8_MMA(1, 0, At, B0); PG8_MMA(1, 1, At, B1); PG8_BAR; PG8_SCHED;
        }
        if constexpr (ALIGN_EPI) { if (wr == 0) PG8_BAR; }
        E(acc, cur, wr, wc, fr, fq);
        if (!has_next) break;
#pragma unroll
        for (int a = 0; a < 2; ++a)
#pragma unroll
            for (int b = 0; b < 2; ++b)
#pragma unroll
                for (int m = 0; m < 4; ++m)
#pragma unroll
                    for (int n = 0; n < 2; ++n) acc[a][b][m][n] = (f32x4){0.f, 0.f, 0.f, 0.f};
        cur = nxt; cA = nA; cB = nB; ++ui;
        if constexpr (BJUMP) cJ = S.b_jump(cur);
        if constexpr (GATHER) { gvc[0][0] = gvn[0][0]; gvc[0][1] = gvn[0][1]; gvc[1][0] = gvn[1][0]; gvc[1][1] = gvn[1][1]; }
        if constexpr (ALIGN_EPI) { if (wr == 1) PG8_BAR; }
    }
    PG8_WAIT_V(0);
    if constexpr (!ALIGN_EPI) { if (wr == 0) PG8_BAR; }
    PG8_BAR;
#undef PG8_SA
#undef PG8_SB
#undef PG8_STG
#undef PG8_STGB
#undef PG8_STGA_CUR
#undef PG8_STGA_SEL
#undef PG8_LDA
#undef PG8_LDB
#undef PG8_MMA
#undef PG8_WAIT_V
#undef PG8_WAIT_L
#undef PG8_BAR
#undef PG8_SCHED
}
}
constexpr int T = 16384, D = 1024, L = 4096, NB = 4;
constexpr int NWAVES = 8;
constexpr size_t MiB = 1u << 20;
constexpr int CW_BAR = 4096;
constexpr int CW_CLS0 = 8192, CW_CLS1 = 10240; constexpr int CW_CK = 14000;
constexpr size_t WS_SS1 = 64 * 1024;
constexpr size_t WS_SS0 = 128 * 1024;
constexpr size_t WS_SS2 = 192 * 1024;
constexpr size_t CTL_ZERO_BYTES = 1 * MiB;
constexpr size_t WS_TOK = 1 * MiB;
constexpr size_t WS_LIST = 2 * MiB;
constexpr size_t WS_TOKW = 3 * MiB + 512 * 1024;
constexpr size_t WS_TOKC = 3 * MiB + 640 * 1024;
constexpr size_t WS_RTW = 3 * MiB + 768 * 1024;
constexpr size_t WS_CNTWG = 3 * MiB + 704 * 1024;
constexpr size_t WS_ROPE = 4 * MiB;
constexpr size_t WS_S5T = 6 * MiB;
constexpr size_t WS_S5END = 1 * MiB;
constexpr size_t WS_LW = 7 * MiB;
constexpr size_t WS_SSP = 284 * MiB;
constexpr size_t WS_LSE = 11 * MiB;
constexpr size_t WS_WIN = 12 * MiB;
constexpr size_t WS_WOUT = 17 * MiB;
constexpr size_t WS_WGLU = 19 * MiB;
constexpr size_t WS_WQKV = 20 * MiB;
constexpr size_t WS_CWOUT = 26 * MiB;
constexpr size_t WS_WGU = 28 * MiB;
constexpr size_t WS_WD = 60 * MiB;
constexpr size_t WS_MOE_LAYER = 48 * MiB;
constexpr size_t WS_XB = 124 * MiB;
constexpr size_t WS_MG = 156 * MiB;
constexpr size_t WS_P = 188 * MiB;
constexpr size_t WS_END = 286 * MiB;

constexpr int RING_BYTES = 131072;
constexpr int LDSCTL_OFF = RING_BYTES, MISC_OFF = LDSCTL_OFF + 320;
constexpr int MOE_TB_OFF = LDSCTL_OFF + 512;
constexpr int LDS_BYTES = 147456;

#define RLX_AGENT __ATOMIC_RELAXED, __HIP_MEMORY_SCOPE_AGENT
#define LDS_WAIT() asm volatile("s_waitcnt lgkmcnt(0)" ::: "memory")
#define VM_WAIT() asm volatile("s_waitcnt vmcnt(0)" ::: "memory")

#define XB_TMO      128
#define XB_XCNT(j)  (256  + 64 * (j))
#define XB_XSUB(j)  (1280 + 64 * (j))
#define XB_XGEN(j)  (2304 + 64 * (j))
#define XB_TOP      3328
#define XB_TOPGEN   3392
#define XCD_BAR_WORDS 3456
#define XB_SPIN_CAP (1u << 18)
__device__ __forceinline__ unsigned xb_ld(unsigned* p)              { return __hip_atomic_load(p, __ATOMIC_RELAXED, __HIP_MEMORY_SCOPE_AGENT); }
__device__ __forceinline__ unsigned xb_add(unsigned* p, unsigned v) { return __hip_atomic_fetch_add(p, v, __ATOMIC_RELAXED, __HIP_MEMORY_SCOPE_AGENT); }
__device__ __forceinline__ unsigned xb_xcc_id() { return (unsigned)__builtin_amdgcn_s_getreg((3 << 11) | 20) & 0xFu; }
#define XB_SPIN(cond, bar) do { unsigned _sp = 0; while (cond) { __builtin_amdgcn_s_sleep(1); \
    if ((++_sp & 255u) == 0u) { if (xb_ld(&(bar)[XB_TMO])) break; if (_sp > XB_SPIN_CAP) { atomicAdd(&(bar)[XB_TMO], 1u); break; } } } } while (0)
struct XcdBarrier { unsigned* bar; unsigned x; volatile LAS unsigned* st; };
__device__ __forceinline__ XcdBarrier xcd_barrier_post(unsigned* bar, volatile LAS unsigned* st) {
    XcdBarrier b; b.bar = bar; b.x = xb_xcc_id(); b.st = st;
    if (threadIdx.x == 0) (void)xb_add(&bar[XB_XCNT(b.x)], 1u);
    return b;
}
__device__ __forceinline__ void xcd_barrier_complete(unsigned* bar, unsigned x, unsigned& nloc, unsigned& nx) {
    const unsigned G = gridDim.x * gridDim.y * gridDim.z;
    unsigned sum, cnt, mine, sp = 0u;
    for (;;) {
        sum = 0u; cnt = 0u; mine = 0u;
#pragma unroll
        for (unsigned j = 0; j < 16; ++j) { const unsigned c = xb_ld(&bar[XB_XCNT(j)]); sum += c; cnt += (c > 0u) ? 1u : 0u; mine = (j == x) ? c : mine; }
        if (sum == G) break;
        __builtin_amdgcn_s_sleep(1);
        if ((++sp & 255u) == 0u) { if (xb_ld(&bar[XB_TMO])) break; if (sp > XB_SPIN_CAP) { atomicAdd(&bar[XB_TMO], 1u); break; } }
    }
    nloc = mine > 0u ? mine : 1u; nx = cnt > 0u ? cnt : 1u;
}
__device__ __forceinline__ void xcd_barrier(const XcdBarrier& b) {
    asm volatile("s_waitcnt vmcnt(0)" ::: "memory");
    __syncthreads();
    if (threadIdx.x == 0) {
        unsigned* bar = b.bar;
        __builtin_amdgcn_s_waitcnt(0);
        unsigned nloc = b.st[0], nx = b.st[1];
        if (nloc == 0u) { xcd_barrier_complete(bar, b.x, nloc, nx); b.st[0] = nloc; b.st[1] = nx; }
        const unsigned old = xb_add(&bar[XB_XSUB(b.x)], 1u);
        const unsigned gen = old / nloc;
        if (old + 1u == (gen + 1u) * nloc) {
            __builtin_amdgcn_fence(__ATOMIC_RELEASE, "agent");
            asm volatile("s_waitcnt vmcnt(0)" ::: "memory");
            const unsigned og = xb_add(&bar[XB_TOP], 1u);
            const unsigned tg = og / nx;
            if (og + 1u == (tg + 1u) * nx) xb_add(&bar[XB_TOPGEN], 1u);
            else XB_SPIN(xb_ld(&bar[XB_TOPGEN]) == tg, bar);
            __builtin_amdgcn_fence(__ATOMIC_ACQUIRE, "agent");
            xb_add(&bar[XB_XGEN(b.x)], 1u);
            asm volatile("s_waitcnt vmcnt(0)" ::: "memory");
        } else {
            XB_SPIN(xb_ld(&bar[XB_XGEN(b.x)]) == gen, bar);
            __builtin_amdgcn_fence(__ATOMIC_ACQUIRE, "agent");
            asm volatile("s_waitcnt vmcnt(0)" ::: "memory");
        }
    }
    __syncthreads();
}

struct PlainOrder {
    const char* A; const char* Bt; int lda, ldb; int nM, nN, nwg, G, c;
    __device__ void init(const void* A_, const void* Bt_, int lda_, int ldb_, int M, int N, int G_, int c_) { A = (const char*)A_; Bt = (const char*)Bt_; lda = lda_; ldb = ldb_; nM = M / 256; nN = N / 256; nwg = nM * nN; G = G_; c = c_; }
    __device__ bool next(int i, pg8::Unit& u) const {
        const long Lx = (long)i * G + c; if (Lx >= nwg) return false;
        int wgid = (int)Lx; { const int q = nwg / 8, r = nwg % 8, xcd = wgid % 8, off = wgid / 8; wgid = (xcd < r ? xcd * (q + 1) : r * (q + 1) + (xcd - r) * q) + off; }
        const int nig = 8 * nN, gid = wgid / nig, fm = gid * 8, gsz = (nM - fm) < 8 ? (nM - fm) : 8;
        u.pm = fm + ((wgid % nig) % gsz); u.pn = (wgid % nig) / gsz; u.cls = 0; u.nvalid = 256; return true;
    }
    __device__ __forceinline__ const char* a_base(const pg8::Unit& u) const { return A + (size_t)u.pm * 256 * lda * 2; }
    __device__ __forceinline__ const char* b_base(const pg8::Unit& u) const { return Bt + (size_t)u.pn * 256 * ldb * 2; }
    __device__ __forceinline__ long b_jump(const pg8::Unit&) const { return 0; }
    __device__ __forceinline__ void a_voff(const pg8::Unit&, int, int, int, int, unsigned (&)[2][2]) const {}
};

using pg8::Unit; using pg8::cvt_pk_bf16; using pg8::cvt_pk_bf16_c;
constexpr float RMS_EPS = 1e-6f;
struct EpiInProj {
    static constexpr bool PERM = true;
    bf16_t* P; const float* ss; const float* rope;
    __device__ __forceinline__ void operator()(const f32x4 (&acc)[2][2][4][2], const Unit& u, int wr, int wc, int fr, int fq) const {
        const int row0 = u.pm * 256 + wr * 64 + fr; const int tile = u.pn;
        float ssv[8];
#pragma unroll
        for (int it = 0; it < 8; ++it) ssv[it] = ss[row0 + (it >> 2) * 128 + (it & 3) * 16];
#pragma unroll
        for (int ai = 0; ai < 2; ++ai)
#pragma unroll
            for (int m = 0; m < 4; ++m) {
                const int row = row0 + ai * 128 + m * 16;
                const float rstd = rsqrtf(ssv[ai * 4 + m] * (1.0f / D) + RMS_EPS);
                bf16_t* rowp = P + (size_t)row * 2560 + tile * 256;
#pragma unroll
                for (int bj = 0; bj < 2; ++bj) {
                    const int cb = bj * 128 + wc * 32 + 8 * fq;
                    f32x4 v0 = acc[ai][bj][m][0] * rstd, v1 = acc[ai][bj][m][1] * rstd;
                    if (tile < 4) {
                        const int i4 = (cb & 127) >> 1;
                        const int pos = row & (L - 1);
                        const f32x4 cs = *(const f32x4*)(rope + (size_t)pos * 64 + i4), sn = *(const f32x4*)(rope + (size_t)L * 64 + (size_t)pos * 64 + i4);
                        f32x4 o1 = v0 * cs - v1 * sn, o2 = v0 * sn + v1 * cs;
                        if (tile >= 2) { o1 = o1 * 0.08838834764831845f; o2 = o2 * 0.08838834764831845f; }
                        u32x2 w1, w2; w1.x = cvt_pk_bf16(o1[0], o1[1]); w1.y = cvt_pk_bf16(o1[2], o1[3]); w2.x = cvt_pk_bf16(o2[0], o2[1]); w2.y = cvt_pk_bf16(o2[2], o2[3]);
                        bf16_t* hp = rowp + (cb & 128) + i4;
                        *(u32x2*)hp = w1; *(u32x2*)(hp + 64) = w2;
                    } else {
                        if (tile == 6 || tile == 7) {
#pragma unroll
                            for (int e = 0; e < 4; ++e) { v0[e] = v0[e] * fast_sigmoid(v0[e]); v1[e] = v1[e] * fast_sigmoid(v1[e]); }
                        }
                        u32x4 w; w.x = cvt_pk_bf16(v0[0], v0[1]); w.y = cvt_pk_bf16(v0[2], v0[3]); w.z = cvt_pk_bf16(v1[0], v1[1]); w.w = cvt_pk_bf16(v1[2], v1[3]);
                        *(u32x4*)(rowp + cb) = w;
                    }
                }
            }
    }
};

struct EpiQKV {
    static constexpr bool PERM = true;
    bf16_t* P; const float* ss; float qscale;
    __device__ __forceinline__ void operator()(const f32x4 (&acc)[2][2][4][2], const Unit& u, int wr, int wc, int fr, int fq) const {
        const int row0 = u.pm * 256 + wr * 64 + fr;
        const float sc = (u.pn < 4) ? qscale : 1.0f;
#pragma unroll
        for (int ai = 0; ai < 2; ++ai)
#pragma unroll
            for (int m = 0; m < 4; ++m) {
                const int row = row0 + ai * 128 + m * 16;
                const f32x4* sp = (const f32x4*)(ss + (size_t)row * 32);
                const f32x4 s4 = (sp[0] + sp[1]) + (sp[2] + sp[3]);
                const float rstd = rsqrtf(((s4[0] + s4[1]) + (s4[2] + s4[3])) * (1.0f / D) + RMS_EPS) * sc;
                bf16_t* rowp = P + (size_t)row * 3072 + u.pn * 256 + wc * 32 + 8 * fq;
#pragma unroll
                for (int bj = 0; bj < 2; ++bj) {
                    const f32x4 v0 = acc[ai][bj][m][0] * rstd, v1 = acc[ai][bj][m][1] * rstd;
                    u32x4 w; w.x = cvt_pk_bf16(v0[0], v0[1]); w.y = cvt_pk_bf16(v0[2], v0[3]); w.z = cvt_pk_bf16(v1[0], v1[1]); w.w = cvt_pk_bf16(v1[2], v1[3]);
                    *(u32x4*)(rowp + bj * 128) = w;
                }
            }
    }
};
template <bool RF32>
struct EpiOutRes {
    static constexpr bool PERM = true;
    const float* residf; const bf16_t* residb; bf16_t* Hout;
    __device__ __forceinline__ void operator()(const f32x4 (&acc)[2][2][4][2], const Unit& u, int wr, int wc, int fr, int fq) const {
        const int row0 = u.pm * 256 + wr * 64 + fr;
#pragma unroll
        for (int ai = 0; ai < 2; ++ai)
#pragma unroll
            for (int m = 0; m < 4; ++m) {
                const size_t off = (size_t)(row0 + ai * 128 + m * 16) * D + u.pn * 256 + wc * 32 + 8 * fq;
#pragma unroll
                for (int bj = 0; bj < 2; ++bj) {
                    f32x4 r0, r1;
                    if (RF32) { r0 = *(const f32x4*)(residf + off + bj * 128); r1 = *(const f32x4*)(residf + off + bj * 128 + 4); }
                    else { const u32x4 q = *(const u32x4*)(residb + off + bj * 128); r0 = (f32x4){bflo(q.x), bfhi(q.x), bflo(q.y), bfhi(q.y)}; r1 = (f32x4){bflo(q.z), bfhi(q.z), bflo(q.w), bfhi(q.w)}; }
                    const f32x4 o0 = r0 + acc[ai][bj][m][0], o1 = r1 + acc[ai][bj][m][1];
                    u32x4 w; w.x = cvt_pk_bf16(o0[0], o0[1]); w.y = cvt_pk_bf16(o0[2], o0[3]); w.z = cvt_pk_bf16(o1[0], o1[1]); w.w = cvt_pk_bf16(o1[2], o1[3]);
                    *(u32x4*)(Hout + off + bj * 128) = w;
                }
            }
    }
};

__device__ __forceinline__ void cls_decode(int cls, int& g, int& lo, int& hi) { g = cls / 6; const int p = cls - 6 * g; lo = p < 3 ? 0 : (p < 5 ? 1 : 2); hi = p < 3 ? p + 1 : (p < 5 ? p - 1 : 3); }
struct MoeOrder {
    const char* A; const char* Bt; const int* list; const LAS int* tb; const LAS int* cc; int NPN, G, c, down, lo, hi;
    __device__ bool next(int i, pg8::Unit& u) const {
        const int idx = lo + i * G + c; if (c < 0 || idx >= hi) return false;
        const int ct = idx / NPN; int k = 0;
#pragma unroll 1
        for (int j = 1; j < 24; ++j) if (ct >= tb[j]) k = j;
        u.pm = ct; u.pn = idx - ct * NPN; u.cls = k; const int rem = cc[k] - (ct - tb[k]) * 256; u.nvalid = rem < 256 ? rem : 256; return true;
    }
    __device__ __forceinline__ const char* a_base(const pg8::Unit& u) const { return down ? A + (size_t)u.pm * 256 * 1024 * 2 : A; }
    __device__ __forceinline__ const char* b_base(const pg8::Unit& u) const {
        int g, lo, hi; cls_decode(u.cls, g, lo, hi);
        if (down) return Bt + ((size_t)(g * 1024 + u.pn * 256) * 2048 + lo * 512) * 2;
        const int e = u.pn < 4 ? lo : hi; return Bt + ((size_t)((g * 4 + e) * 1024 + (u.pn & 3) * 256) * 1024) * 2;
    }
    __device__ __forceinline__ long b_jump(const pg8::Unit& u) const { int g, lo, hi; cls_decode(u.cls, g, lo, hi); return (long)(hi - lo - 1) * 1024; }
    __device__ __forceinline__ void a_voff(const pg8::Unit& u, int R0, int R1, int C0, int C1, unsigned (&v)[2][2]) const {
        const int* lp = list + u.cls * 16384 + (u.pm - tb[u.cls]) * 256;
#pragma unroll
        for (int h = 0; h < 2; ++h) {
            const int r0 = h * 128 + R0, r1 = h * 128 + R1;
            const int t0 = lp[r0 < u.nvalid ? r0 : 0], t1 = lp[r1 < u.nvalid ? r1 : 0];
            v[h][0] = (unsigned)t0 * 2048u + (unsigned)C0 * 2u; v[h][1] = (unsigned)t1 * 2048u + (unsigned)C1 * 2u;
        }
    }
};
struct EpiGateUp {
    static constexpr bool PERM = true;
    bf16_t* HC; const f32x2* lw; const LAS int* tb;
    __device__ __forceinline__ void operator()(const f32x4 (&acc)[2][2][4][2], const Unit& u, int wr, int wc, int fr, int fq) const {
        const int slot = u.pn >> 2;
        const f32x2* lwp = lw + u.cls * 16384 + (u.pm - tb[u.cls]) * 256;
        f32x2 w2v[8];
#pragma unroll
        for (int it = 0; it < 8; ++it) { const int rl = wr * 64 + fr + (it >> 2) * 128 + (it & 3) * 16; w2v[it] = lwp[rl < u.nvalid ? rl : 0]; }
#pragma unroll
        for (int ai = 0; ai < 2; ++ai)
#pragma unroll
            for (int m = 0; m < 4; ++m) {
                const int rl = wr * 64 + fr + ai * 128 + m * 16;
                const f32x2 w2 = w2v[ai * 4 + m]; const unsigned wb = __float_as_uint(w2.x); const float w = slot ? bfhi(wb) : bflo(wb), rs = w2.y;
                u32x2 o[2];
#pragma unroll
                for (int bj = 0; bj < 2; ++bj) {
                    const f32x4 v0 = acc[ai][bj][m][0] * rs, v1 = acc[ai][bj][m][1] * rs;
                    const float h0 = v0[0] * fast_sigmoid(v0[0]) * v0[1] * w, h1 = v0[2] * fast_sigmoid(v0[2]) * v0[3] * w;
                    const float h2 = v1[0] * fast_sigmoid(v1[0]) * v1[1] * w, h3 = v1[2] * fast_sigmoid(v1[2]) * v1[3] * w;
                    o[bj].x = cvt_pk_bf16(h0, h1); o[bj].y = cvt_pk_bf16(h2, h3);
                }
                const auto sx = __builtin_amdgcn_permlane16_swap(o[0].x, o[1].x, false, false);
                const auto sy = __builtin_amdgcn_permlane16_swap(o[0].y, o[1].y, false, false);
                u32x4 wv; wv.x = sx[0]; wv.y = sy[0]; wv.z = sx[1]; wv.w = sy[1];
                bf16_t* rowp = HC + (size_t)(u.pm * 256 + rl) * 1024 + slot * 512 + (u.pn & 3) * 128 + wc * 16 + 4 * (fq & 2) + (fq & 1) * 64;
                if (rl < u.nvalid) *(u32x4*)rowp = wv;
            }
    }
};

struct EpiDown {
    static constexpr bool PERM = true;
    const bf16_t* Hin; bf16_t* Hout; float* ss; const int* list; const LAS int* tb;
    __device__ __forceinline__ void operator()(const f32x4 (&acc)[2][2][4][2], const Unit& u, int wr, int wc, int fr, int fq) const {
        const int* lp = list + u.cls * 16384 + (u.pm - tb[u.cls]) * 256;
        int tokv[8];
#pragma unroll
        for (int it = 0; it < 8; ++it) { const int rl = wr * 64 + fr + (it >> 2) * 128 + (it & 3) * 16; tokv[it] = lp[rl < u.nvalid ? rl : 0]; }
#pragma unroll
        for (int ai = 0; ai < 2; ++ai) {
            u32x4 q[4][2];
#pragma unroll
            for (int m = 0; m < 4; ++m) { const size_t off = (size_t)tokv[ai * 4 + m] * D + u.pn * 256 + wc * 32 + 8 * fq;
                q[m][0] = *(const u32x4*)(Hin + off); q[m][1] = *(const u32x4*)(Hin + off + 128); }
#pragma unroll
            for (int m = 0; m < 4; ++m) {
                const int rl = wr * 64 + fr + ai * 128 + m * 16;
                const bool ok = rl < u.nvalid;
                const int tok = tokv[ai * 4 + m];
                const size_t off = (size_t)tok * D + u.pn * 256 + wc * 32 + 8 * fq;
                float sq = 0.f;
#pragma unroll
                for (int bj = 0; bj < 2; ++bj) {
                    const u32x4 qq = q[m][bj];
                    const f32x4 o0 = (f32x4){bflo(qq.x), bfhi(qq.x), bflo(qq.y), bfhi(qq.y)} + acc[ai][bj][m][0], o1 = (f32x4){bflo(qq.z), bfhi(qq.z), bflo(qq.w), bfhi(qq.w)} + acc[ai][bj][m][1];
                    sq += (o0[0] * o0[0] + o0[1] * o0[1]) + (o0[2] * o0[2] + o0[3] * o0[3]) + (o1[0] * o1[0] + o1[1] * o1[1]) + (o1[2] * o1[2] + o1[3] * o1[3]);
                    u32x4 w; w.x = cvt_pk_bf16(o0[0], o0[1]); w.y = cvt_pk_bf16(o0[2], o0[3]); w.z = cvt_pk_bf16(o1[0], o1[1]); w.w = cvt_pk_bf16(o1[2], o1[3]);
                    if (ok) *(u32x4*)(Hout + off + bj * 128) = w;
                }
                sq += __shfl_xor(sq, 16); sq += __shfl_xor(sq, 32);
                if (ok && fq == 0) __hip_atomic_store(ss + (size_t)tok * 32 + u.pn * 4 + wc, sq, RLX_AGENT);
            }
        }
    }
};

struct Frame {
    LAS unsigned char* lds;
    volatile LAS unsigned* MISC;
    unsigned* ctl;
    int tid, lane, wave, vcu, G;
};

template <int ROWMODE>
__device__ __forceinline__ int tr_rowmap(int n, int row_off) {
    if (ROWMODE == 0) return row_off + n;
    if (ROWMODE == 1) { if (n >= 1024) return n; const int hb = n >> 7, jj = n & 127; return (hb << 7) + (jj < 64 ? 8 * (jj >> 2) + (jj & 3) : 8 * ((jj - 64) >> 2) + 4 + (jj & 3)); }
    if (ROWMODE == 2) return row_off + 2 * n;
    return row_off + 2 * n + 1;
}
template <int ROWMODE>
__device__ __forceinline__ void tr_item(const float* W, int N, bf16_t* WT, int ldt, int koff, int row_off, const float* gain, LAS float* scr, int item, int lane) {
    const int nblk = N / 32, kb = item / nblk, nb = item % nblk, k0 = 64 * kb, n0 = 32 * nb;
    float tv[32];
#pragma unroll
    for (int i = 0; i < 32; ++i) tv[i] = W[(size_t)(k0 + 2 * i + (lane >> 5)) * N + n0 + (lane & 31)];
#pragma unroll
    for (int i = 0; i < 32; ++i) { const int kk = 2 * i + (lane >> 5); float v = tv[i]; if (gain) v *= gain[k0 + kk]; scr[kk * 33 + (lane & 31)] = v; }
    LDS_WAIT(); asm volatile("" ::: "memory");
    const int c = lane & 7;
#pragma unroll
    for (int j = 0; j < 4; ++j) { const int n = (lane >> 3) + 8 * j; const LAS float* s = scr + (8 * c) * 33 + n;
        u32x4 o; o.x = pk2(s[0 * 33], s[1 * 33]); o.y = pk2(s[2 * 33], s[3 * 33]); o.z = pk2(s[4 * 33], s[5 * 33]); o.w = pk2(s[6 * 33], s[7 * 33]);
        *(u32x4*)(WT + (size_t)tr_rowmap<ROWMODE>(n0 + n, row_off) * ldt + koff + k0 + 8 * c) = o; }
    LDS_WAIT(); asm volatile("" ::: "memory");
}
typedef short v4i16_t __attribute__((ext_vector_type(4)));
__device__ __forceinline__ s16x4 ds_tr16(unsigned addr) { return __builtin_bit_cast(s16x4, __builtin_amdgcn_ds_read_tr16_b64_v4i16((LAS v4i16_t*)(uintptr_t)addr)); }

__device__ __forceinline__ void attn_load_half(const bf16_t* __restrict__ P, int b, int h, int r, int blk, int dil, int tid, u32x4* kreg, u32x4* vreg) {
#pragma unroll
    for (int i = 0; i < 4; ++i) {
        const int id = tid + 512 * i, row = id >> 4, ch = id & 15;
        const size_t grow = (size_t)b * L + r + (size_t)dil * (128 * blk + row);
        const bf16_t* src = P + grow * 3072 + 1024 + h * 128 + ch * 8;
        kreg[i] = *(const u32x4*)src; vreg[i] = *(const u32x4*)(src + 1024);
    }
}
__device__ __forceinline__ void attn_store_half(LAS unsigned char* lds, int tid, int slot, const u32x4* kreg, const u32x4* vreg) {
#pragma unroll
    for (int i = 0; i < 4; ++i) {
        const int id = tid + 512 * i, row = slot * 128 + (id >> 4), ch = id & 15;
        const int off = row * 256 + ((ch ^ (row & 15)) << 4);
        *(LAS u32x4*)(lds + off) = kreg[i]; *(LAS u32x4*)(lds + 65536 + off) = vreg[i];
    }
}
__device__ __forceinline__ void attn_load(const bf16_t* __restrict__ P, int b, int h, int r, int n, int dil, int tid, bool full, u32x4 (&kreg)[8], u32x4 (&vreg)[8]) {
    if (full) attn_load_half(P, b, h, r, n > 0 ? n - 1 : 0, dil, tid, kreg, vreg);
    attn_load_half(P, b, h, r, n, dil, tid, kreg + 4, vreg + 4);
}
__device__ __forceinline__ void attn_store(LAS unsigned char* lds, int tid, int n, bool full, const u32x4 (&kreg)[8], const u32x4 (&vreg)[8]) {
    if (full) attn_store_half(lds, tid, (n - 1) & 1, kreg, vreg);
    attn_store_half(lds, tid, n & 1, kreg + 4, vreg + 4);
}
__device__ __forceinline__ void attn_loadq(const bf16_t* __restrict__ P, int b, int h, int r, int n, int dil, int tid, bf16x8 (&qf)[4]) {
    const int lane = tid & 63, w = __builtin_amdgcn_readfirstlane(tid >> 6), fr = lane & 15, fq = lane >> 4;
    const size_t qrow = (size_t)b * L + r + (size_t)dil * (128 * n + 16 * w + fr);
#pragma unroll
    for (int ks = 0; ks < 4; ++ks) qf[ks] = *(const bf16x8*)(P + qrow * 3072 + h * 128 + 32 * ks + 8 * fq);
}
template <bool MERGE>
__device__ __forceinline__ void attn_compute(LAS unsigned char* lds, const bf16_t* __restrict__ P, bf16_t* O, float* lse_out, const bf16_t* OA, const bf16_t* OB, const float* lseA, const float* lseB,
                                             int b, int h, int r, int n, int dil, int tid, const bf16x8 (&qf)[4]) {
    const int lane = tid & 63, w = __builtin_amdgcn_readfirstlane(tid >> 6), fr = lane & 15, fq = lane >> 4;
    const size_t qrow = (size_t)b * L + r + (size_t)dil * (128 * n + 16 * w + fr);
    float m = -1e30f, lsum = 0.f;
    f32x4 ot[8];
#pragma unroll
    for (int dt = 0; dt < 8; ++dt) ot[dt] = (f32x4){0.f, 0.f, 0.f, 0.f};
    const float NEG = -__builtin_inff();
    const int pxor = ((n - 1) & 1) << 7;
    const unsigned ldsb = (unsigned)(uintptr_t)lds;
#pragma unroll
    for (int g = 0; g < 5; ++g) {
        const int tixA = w + 2 * g, tixB = tixA + 1;
        f32x4 sA = (f32x4){0.f, 0.f, 0.f, 0.f}, sB = (f32x4){0.f, 0.f, 0.f, 0.f};
        {
            const int rowA = (16 * tixA + fr) ^ pxor;
#pragma unroll
            for (int ks = 0; ks < 4; ++ks) {
                const bf16x8 kf = *(const LAS bf16x8*)(lds + rowA * 256 + (((4 * ks + fq) ^ (rowA & 15)) << 4));
                sA = __builtin_amdgcn_mfma_f32_16x16x32_bf16(kf, qf[ks], sA, 0, 0, 0);
            }
        }
        if (g < 4) {
            const int rowB = (16 * tixB + fr) ^ pxor;
#pragma unroll
            for (int ks = 0; ks < 4; ++ks) {
                const bf16x8 kf = *(const LAS bf16x8*)(lds + rowB * 256 + (((4 * ks + fq) ^ (rowB & 15)) << 4));
                sB = __builtin_amdgcn_mfma_f32_16x16x32_bf16(kf, qf[ks], sB, 0, 0, 0);
            }
        }
        const bool invA = (n == 0 && tixA < 8), invB = (g == 4) || (n == 0 && tixB < 8);
#pragma unroll
        for (int e = 0; e < 4; ++e) {
            bool okA = !invA, okB = !invB;
            if (g == 0) okA = okA && (4 * fq + e >= fr);
            if (g == 4) okA = okA && (4 * fq + e <= fr);
            if (!okA) sA[e] = NEG;
            if (!okB) sB[e] = NEG;
        }
        float mx = fmaxf(fmaxf(fmaxf(sA[0], sA[1]), fmaxf(sA[2], sA[3])), fmaxf(fmaxf(sB[0], sB[1]), fmaxf(sB[2], sB[3])));
        mx = fmaxf(mx, __shfl_xor(mx, 16)); mx = fmaxf(mx, __shfl_xor(mx, 32));
        const float mn = fmaxf(m, mx);
        const float alpha = __builtin_amdgcn_exp2f(m - mn);
        m = mn;
        float ps = 0.f;
#pragma unroll
        for (int e = 0; e < 4; ++e) { sA[e] = __builtin_amdgcn_exp2f(sA[e] - mn); sB[e] = __builtin_amdgcn_exp2f(sB[e] - mn); ps += sA[e] + sB[e]; }
        lsum = lsum * alpha + ps;
        u32x4 pw; pw.x = cvt_pk_bf16_c(sA[0], sA[1]); pw.y = cvt_pk_bf16_c(sA[2], sA[3]); pw.z = cvt_pk_bf16_c(sB[0], sB[1]); pw.w = cvt_pk_bf16_c(sB[2], sB[3]);
        const bf16x8 pf = __builtin_bit_cast(bf16x8, pw);
        const int qp = fr >> 2, pp = fr & 3;
        const int vrowA = (16 * tixA + 4 * fq + qp) ^ pxor, vrowB = (g < 4) ? ((16 * tixB + 4 * fq + qp) ^ pxor) : vrowA;
#pragma unroll
        for (int dt = 0; dt < 8; ++dt) {
            const unsigned aA = ldsb + 65536u + (unsigned)(vrowA * 256 + (((2 * dt + (pp >> 1)) ^ (vrowA & 15)) << 4) + (pp & 1) * 8);
            const unsigned aB = ldsb + 65536u + (unsigned)(vrowB * 256 + (((2 * dt + (pp >> 1)) ^ (vrowB & 15)) << 4) + (pp & 1) * 8);
            const s16x4 lo = ds_tr16(aA), hi = ds_tr16(aB);
            const bf16x8 vf = (bf16x8){lo[0], lo[1], lo[2], lo[3], hi[0], hi[1], hi[2], hi[3]};
            ot[dt] = ot[dt] * alpha;
            ot[dt] = __builtin_amdgcn_mfma_f32_16x16x32_bf16(vf, pf, ot[dt], 0, 0, 0);
        }
    }
    float lt = lsum; lt += __shfl_xor(lt, 16); lt += __shfl_xor(lt, 32);
    const float inv = 1.0f / lt;
    const float lse2 = m + __builtin_amdgcn_logf(lt);
    if (!MERGE) {
        if (fq == 0) lse_out[(size_t)((b * 8 + h) * dil + r) * (L / dil) + 128 * n + 16 * w + fr] = lse2;
#pragma unroll
        for (int dp = 0; dp < 4; ++dp) {
            u32x2 o[2];
#pragma unroll
            for (int q = 0; q < 2; ++q) { const int dt = 2 * dp + q; o[q].x = cvt_pk_bf16(ot[dt][0] * inv, ot[dt][1] * inv); o[q].y = cvt_pk_bf16(ot[dt][2] * inv, ot[dt][3] * inv); }
            const auto sx = __builtin_amdgcn_permlane16_swap(o[0].x, o[1].x, false, false);
            const auto sy = __builtin_amdgcn_permlane16_swap(o[0].y, o[1].y, false, false);
            u32x4 wv; wv.x = sx[0]; wv.y = sy[0]; wv.z = sx[1]; wv.w = sy[1];
            *(u32x4*)(O + qrow * D + h * 128 + 16 * (2 * dp + (fq & 1)) + 4 * (fq & 2)) = wv; }
    } else {
        const int pos = r + dil * (128 * n + 16 * w + fr);
        const float la = lseA[(size_t)(b * 8 + h) * L + pos], lb = lseB[(size_t)((b * 8 + h) * 4 + (pos & 3)) * (L / 4) + (pos >> 2)];
        const float M = fmaxf(fmaxf(la, lb), lse2);
        float wa = __builtin_amdgcn_exp2f(la - M), wb = __builtin_amdgcn_exp2f(lb - M), wc = __builtin_amdgcn_exp2f(lse2 - M);
        const float iw = 1.0f / (wa + wb + wc); wa *= iw; wb *= iw; wc *= iw * inv;
#pragma unroll
        for (int dt = 0; dt < 8; ++dt) {
            const size_t off = qrow * D + h * 128 + 16 * dt + 4 * fq;
            const u32x2 a = *(const u32x2*)(OA + off), bb = *(const u32x2*)(OB + off);
            const float r0 = wa * bflo(a.x) + wb * bflo(bb.x) + wc * ot[dt][0], r1 = wa * bfhi(a.x) + wb * bfhi(bb.x) + wc * ot[dt][1];
            const float r2 = wa * bflo(a.y) + wb * bflo(bb.y) + wc * ot[dt][2], r3 = wa * bfhi(a.y) + wb * bfhi(bb.y) + wc * ot[dt][3];
            u32x2 o; o.x = cvt_pk_bf16(r0, r1); o.y = cvt_pk_bf16(r2, r3);
            *(u32x2*)(O + off) = o;
        }
    }
}
__device__ __forceinline__ u32x4 scale_bf16x8(u32x4 v, float z) {
    u32x4 o; o.x = cvt_pk_bf16(bflo(v.x) * z, bfhi(v.x) * z); o.y = cvt_pk_bf16(bflo(v.y) * z, bfhi(v.y) * z);
    o.z = cvt_pk_bf16(bflo(v.z) * z, bfhi(v.z) * z); o.w = cvt_pk_bf16(bflo(v.w) * z, bfhi(v.w) * z); return o;
}
__device__ __forceinline__ int swz_tr(int row, int ch) { return row * 256 + ((ch ^ ((row & 3) << 2)) << 4); }
__device__ __forceinline__ int swz_row(int row, int ch) { return row * 256 + ((ch ^ (row & 15)) << 4); }

__device__ __forceinline__ void ret_kv_unit(LAS unsigned char* lds, const bf16_t* __restrict__ P, bf16_t* KVT, int b, int h, int N, int tid) {
    const int lane = tid & 63, w = __builtin_amdgcn_readfirstlane(tid >> 6);
    const float lg2 = log2f(1.0f - exp2f(-5.0f - (float)h));
    {
        u32x4 kreg[8], vreg[8];
#pragma unroll
        for (int i = 0; i < 8; ++i) {
            const int id = tid + 512 * i, row = id >> 4, ch = id & 15;
            const bf16_t* src = P + ((size_t)b * L + 256 * N + row) * 2560 + 512 + h * 128 + ch * 8;
            kreg[i] = *(const u32x4*)src; vreg[i] = *(const u32x4*)(src + 512);
        }
#pragma unroll
        for (int i = 0; i < 8; ++i) {
            const int id = tid + 512 * i, row = id >> 4, ch = id & 15;
            const int off = swz_tr(row, ch);
            *(LAS u32x4*)(lds + off) = kreg[i];
            *(LAS u32x4*)(lds + 65536 + off) = scale_bf16x8(vreg[i], exp2f((float)(255 - row) * lg2));
        }
    }
    __syncthreads();
    const int dkt = w >> 1, dvt0 = 2 * (w & 1);
    const int gq = lane >> 4, hi = gq >> 1, qp = (lane & 15) >> 2, pp = lane & 3;
    const unsigned ldsb = (unsigned)(uintptr_t)lds;
    f32x16 acc[2];
#pragma unroll
    for (int t = 0; t < 2; ++t)
#pragma unroll
        for (int r = 0; r < 16; ++r) acc[t][r] = 0.f;
    const int chA = 4 * dkt + 2 * (gq & 1) + (pp >> 1);
#pragma unroll 4
    for (int ks = 0; ks < 16; ++ks) {
        const int r1 = 16 * ks + 8 * hi + qp, r2 = r1 + 4;
        const s16x4 alo = ds_tr16(ldsb + swz_tr(r1, chA) + (pp & 1) * 8), ahi = ds_tr16(ldsb + swz_tr(r2, chA) + (pp & 1) * 8);
        const bf16x8 af = (bf16x8){alo[0], alo[1], alo[2], alo[3], ahi[0], ahi[1], ahi[2], ahi[3]};
#pragma unroll
        for (int t = 0; t < 2; ++t) {
            const int chB = 4 * (dvt0 + t) + 2 * (gq & 1) + (pp >> 1);
            const s16x4 blo = ds_tr16(ldsb + 65536u + swz_tr(r1, chB) + (pp & 1) * 8), bhi = ds_tr16(ldsb + 65536u + swz_tr(r2, chB) + (pp & 1) * 8);
            const bf16x8 bf = (bf16x8){blo[0], blo[1], blo[2], blo[3], bhi[0], bhi[1], bhi[2], bhi[3]};
            acc[t] = __builtin_amdgcn_mfma_f32_32x32x16_bf16(af, bf, acc[t], 0, 0, 0);
        }
    }
    bf16_t* out = KVT + ((size_t)((b * 4 + h) * 16 + N)) * 16384;
#pragma unroll
    for (int t = 0; t < 2; ++t) {
        const int dv = 32 * (dvt0 + t) + (lane & 31);
#pragma unroll
        for (int rg = 0; rg < 4; ++rg) {
            u32x2 o; o.x = cvt_pk_bf16_c(acc[t][4 * rg], acc[t][4 * rg + 1]); o.y = cvt_pk_bf16_c(acc[t][4 * rg + 2], acc[t][4 * rg + 3]);
            *(u32x2*)(out + dv * 128 + 32 * dkt + 8 * rg + 4 * (lane >> 5)) = o;
        }
    }
    __syncthreads();
}

__device__ __forceinline__ void ret_out_unit(LAS unsigned char* lds, const bf16_t* __restrict__ P, const bf16_t* __restrict__ KVT, bf16_t* MG, int b, int h, int N, int tid) {
    const int lane = tid & 63, w = __builtin_amdgcn_readfirstlane(tid >> 6), l31 = lane & 31, hi = lane >> 5;
    const float lg2 = log2f(1.0f - exp2f(-5.0f - (float)h));
    const size_t rowbase = (size_t)b * L + 256 * N;
    {
        const bf16_t* kvb = KVT + ((size_t)((b * 4 + h) * 16)) * 16384;
        float a8[4][8];
#pragma unroll
        for (int i = 0; i < 4; ++i)
#pragma unroll
            for (int e = 0; e < 8; ++e) a8[i][e] = 0.f;
#pragma unroll 1
        for (int m = 0; m < N; ++m) {
            const float wgt = exp2f((float)(256 * (N - 1 - m)) * lg2);
            u32x4 v[4];
#pragma unroll
            for (int i = 0; i < 4; ++i) { const int cid = tid + 512 * i, dv = cid >> 4, ch = cid & 15; v[i] = *(const u32x4*)(kvb + (size_t)m * 16384 + dv * 128 + ch * 8); }
#pragma unroll
            for (int i = 0; i < 4; ++i) {
                a8[i][0] += wgt * bflo(v[i].x); a8[i][1] += wgt * bfhi(v[i].x); a8[i][2] += wgt * bflo(v[i].y); a8[i][3] += wgt * bfhi(v[i].y);
                a8[i][4] += wgt * bflo(v[i].z); a8[i][5] += wgt * bfhi(v[i].z); a8[i][6] += wgt * bflo(v[i].w); a8[i][7] += wgt * bfhi(v[i].w); }
        }
#pragma unroll
        for (int i = 0; i < 4; ++i) {
            const int cid = tid + 512 * i, dv = cid >> 4, ch = cid & 15;
            u32x4 o; o.x = cvt_pk_bf16(a8[i][0], a8[i][1]); o.y = cvt_pk_bf16(a8[i][2], a8[i][3]); o.z = cvt_pk_bf16(a8[i][4], a8[i][5]); o.w = cvt_pk_bf16(a8[i][6], a8[i][7]);
            *(LAS u32x4*)(lds + swz_row(dv, ch)) = o;
        }
    }
    const size_t qrow = rowbase + 32 * w + l31;
    bf16x8 qf[8];
#pragma unroll
    for (int ks = 0; ks < 8; ++ks) qf[ks] = *(const bf16x8*)(P + qrow * 2560 + h * 128 + 16 * ks + 8 * hi);
    __syncthreads();
    f32x16 acc[4];
#pragma unroll
    for (int dvt = 0; dvt < 4; ++dvt) {
#pragma unroll
        for (int r = 0; r < 16; ++r) acc[dvt][r] = 0.f;
        const int dv = 32 * dvt + l31;
#pragma unroll
        for (int ks = 0; ks < 8; ++ks) {
            const bf16x8 pf = *(const LAS bf16x8*)(lds + swz_row(dv, 2 * ks + hi));
            acc[dvt] = __builtin_amdgcn_mfma_f32_32x32x16_bf16(pf, qf[ks], acc[dvt], 0, 0, 0);
        }
    }
    {
        const float xi = exp2f((float)(32 * w + l31 + 1) * lg2);
#pragma unroll
        for (int dvt = 0; dvt < 4; ++dvt)
#pragma unroll
            for (int r = 0; r < 16; ++r) acc[dvt][r] *= xi;
    }
    __syncthreads();
    {
        u32x4 kreg[8], vreg[8];
#pragma unroll
        for (int i = 0; i < 8; ++i) {
            const int id = tid + 512 * i, row = id >> 4, ch = id & 15;
            const bf16_t* src = P + (rowbase + row) * 2560 + 512 + h * 128 + ch * 8;
            kreg[i] = *(const u32x4*)src; vreg[i] = *(const u32x4*)(src + 512);
        }
#pragma unroll
        for (int i = 0; i < 8; ++i) {
            const int id = tid + 512 * i, row = id >> 4, ch = id & 15;
            *(LAS u32x4*)(lds + swz_row(row, ch)) = kreg[i];
            *(LAS u32x4*)(lds + 65536 + swz_tr(row, ch)) = vreg[i];
        }
    }
    __syncthreads();
    float dvec[16];
#pragma unroll
    for (int r = 0; r < 16; ++r) dvec[r] = exp2f((float)(l31 - ((r & 3) + 8 * (r >> 2) + 4 * hi)) * lg2);
    const int gq = lane >> 4, qp = (lane & 15) >> 2, pp = lane & 3;
    const unsigned ldsb = (unsigned)(uintptr_t)lds;
#pragma unroll 1
    for (int kt = 0; kt <= w; ++kt) {
        f32x16 st;
#pragma unroll
        for (int r = 0; r < 16; ++r) st[r] = 0.f;
        const int key = 32 * kt + l31;
#pragma unroll
        for (int ks = 0; ks < 8; ++ks) {
            const bf16x8 kf = *(const LAS bf16x8*)(lds + swz_row(key, 2 * ks + hi));
            st = __builtin_amdgcn_mfma_f32_32x32x16_bf16(kf, qf[ks], st, 0, 0, 0);
        }
        const float tsc = exp2f((float)(32 * (w - kt)) * lg2);
        const bool diag = (kt == w);
#pragma unroll
        for (int r = 0; r < 16; ++r) {
            const int krow = (r & 3) + 8 * (r >> 2) + 4 * hi;
            float pv = st[r] * dvec[r] * tsc;
            if (diag && krow > l31) pv = 0.f;
            st[r] = pv;
        }
        bf16x8 pf[2];
#pragma unroll
        for (int s = 0; s < 2; ++s) { u32x4 pw; pw.x = cvt_pk_bf16(st[8 * s], st[8 * s + 1]); pw.y = cvt_pk_bf16(st[8 * s + 2], st[8 * s + 3]);
            pw.z = cvt_pk_bf16(st[8 * s + 4], st[8 * s + 5]); pw.w = cvt_pk_bf16(st[8 * s + 6], st[8 * s + 7]); pf[s] = __builtin_bit_cast(bf16x8, pw); }
#pragma unroll
        for (int dvt = 0; dvt < 4; ++dvt) {
            const int chV = 4 * dvt + 2 * (gq & 1) + (pp >> 1);
#pragma unroll
            for (int s = 0; s < 2; ++s) {
                const int r1 = 32 * kt + 16 * s + 4 * hi + qp, r2 = r1 + 8;
                const s16x4 vlo = ds_tr16(ldsb + 65536u + swz_tr(r1, chV) + (pp & 1) * 8), vhi = ds_tr16(ldsb + 65536u + swz_tr(r2, chV) + (pp & 1) * 8);
                const bf16x8 vf = (bf16x8){vlo[0], vlo[1], vlo[2], vlo[3], vhi[0], vhi[1], vhi[2], vhi[3]};
                acc[dvt] = __builtin_amdgcn_mfma_f32_32x32x16_bf16(vf, pf[s], acc[dvt], 0, 0, 0);
            }
        }
    }
    float s1 = 0.f;
#pragma unroll
    for (int dvt = 0; dvt < 4; ++dvt)
#pragma unroll
        for (int r = 0; r < 16; ++r) s1 += acc[dvt][r];
    s1 += __shfl_xor(s1, 32);
    const float mu = s1 * (1.0f / 128.0f);
    float s2 = 0.f;
#pragma unroll
    for (int dvt = 0; dvt < 4; ++dvt)
#pragma unroll
        for (int r = 0; r < 16; ++r) { const float d = acc[dvt][r] - mu; s2 += d * d; }
    s2 += __shfl_xor(s2, 32);
    const float rs = rsqrtf(s2 * (1.0f / 128.0f) + 1e-6f);
#pragma unroll
    for (int dvt = 0; dvt < 4; ++dvt)
#pragma unroll
        for (int rg = 0; rg < 4; ++rg) {
            const int col = h * 128 + 32 * dvt + 8 * rg + 4 * hi;
            const u32x2 g = *(const u32x2*)(P + qrow * 2560 + 1536 + col);
            u32x2 o; o.x = cvt_pk_bf16(bflo(g.x) * (acc[dvt][4 * rg] - mu) * rs, bfhi(g.x) * (acc[dvt][4 * rg + 1] - mu) * rs);
            o.y = cvt_pk_bf16(bflo(g.y) * (acc[dvt][4 * rg + 2] - mu) * rs, bfhi(g.y) * (acc[dvt][4 * rg + 3] - mu) * rs);
            *(u32x2*)(MG + qrow * D + col) = o;
        }
    __syncthreads();
}
constexpr size_t S5_BB_OFF = 0, S5_CM_OFF = 128 * 1024, S5_LAM_OFF = 448 * 1024;
struct S5P { float lr, li; };
__device__ __forceinline__ void cmul(float ar, float ai, float br, float bi, float& cr, float& ci) { float r_ = ar * br - ai * bi; asm volatile("" : "+v"(r_)); float i_ = ar * bi + ai * br; asm volatile("" : "+v"(i_)); cr = r_; ci = i_; }
__device__ __forceinline__ void s5_coefs(const float* a_re, const float* a_im, const float* log_dt, int g, int st, float& lr, float& li, float& cr, float& ci) {
    const float dt = expf(log_dt[g]); const float are = a_re[g * 64 + st], aim = a_im[g * 64 + st];
    const float zr = are * dt, zi = aim * dt, mag = expf(zr);
    lr = mag * cosf(zi); li = mag * sinf(zi);
    const float nr = lr - 1.0f, ni = li, den = are * are + aim * aim;
    cr = (nr * are + ni * aim) / den; ci = (ni * are - nr * aim) / den;
}
__device__ __forceinline__ void s5_tables(unsigned char* tab, const float* a_re, const float* a_im, const float* b_re, const float* b_im, const float* c_re, const float* c_im,
                                          const float* dsk, const float* log_dt, int gtid, int gthreads) {
    for (int i = gtid; i < 32 * 64; i += gthreads) {
        const int g = i >> 6, st = i & 63;
        const float dt = expf(log_dt[g]); const float zr = a_re[g * 64 + st] * dt, zi = a_im[g * 64 + st] * dt;
        float* o = (float*)(tab + S5_LAM_OFF) + (size_t)i * 16;
        const float kk[7] = {1.f, 2.f, 3.f, 4.f, 32.f, 64.f, 256.f};
#pragma unroll
        for (int q = 0; q < 7; ++q) { const float mag = expf(kk[q] * zr); o[2 * q] = mag * cosf(kk[q] * zi); o[2 * q + 1] = mag * sinf(kk[q] * zi); }
        o[14] = 0.f; o[15] = 0.f;
    }
    for (int i = gtid; i < 32 * 4 * 64; i += gthreads) {
        const int lane = i & 63, tt = (i >> 6) & 3, g = i >> 8;
        const int st = 32 * (tt >> 1) + (lane & 31); float lr, li, cr, ci; s5_coefs(a_re, a_im, log_dt, g, st, lr, li, cr, ci);
        float v[8];
#pragma unroll
        for (int j = 0; j < 8; ++j) { const int h = 8 * (lane >> 5) + j; const float br = b_re[(g * 64 + st) * 16 + h], bi = b_im[(g * 64 + st) * 16 + h];
            v[j] = (tt & 1) ? (cr * bi + ci * br) : (cr * br - ci * bi); }
        u32x4 o; o.x = pk2(v[0], v[1]); o.y = pk2(v[2], v[3]); o.z = pk2(v[4], v[5]); o.w = pk2(v[6], v[7]);
        *((u32x4*)(tab + S5_BB_OFF) + i) = o;
    }
    for (int i = gtid; i < 32 * 9 * 64; i += gthreads) {
        const int lane = i & 63, s9 = (i >> 6) % 9, g = i / (9 * 64);
        const int h = lane & 31; float v[8];
#pragma unroll
        for (int j = 0; j < 8; ++j) {
            float x = 0.f;
            if (h < 16) {
                if (s9 < 8) { const int st = 8 * s9 + 4 * (lane >> 5) + (j >> 1); x = (j & 1) ? -c_im[(g * 16 + h) * 64 + st] : c_re[(g * 16 + h) * 64 + st]; }
                else { const int hp = 8 * (lane >> 5) + j; x = (hp == h) ? dsk[g * 16 + h] : 0.f; }
            }
            v[j] = x;
        }
        u32x4 o; o.x = pk2(v[0], v[1]); o.y = pk2(v[2], v[3]); o.z = pk2(v[4], v[5]); o.w = pk2(v[6], v[7]);
        *((u32x4*)(tab + S5_CM_OFF) + i) = o;
    }
}

template <bool OUT>
__device__ __forceinline__ void s5_task(const bf16_t* __restrict__ P, const unsigned char* __restrict__ tab, float* END, bf16_t* G, LAS unsigned char* xl, int b, int g, int c, int lane) {
    const int l31 = lane & 31, hi = lane >> 5;
    bf16x8 bbt[4];
#pragma unroll
    for (int tt = 0; tt < 4; ++tt) bbt[tt] = *((const bf16x8*)(tab + S5_BB_OFF) + (g * 4 + tt) * 64 + lane);
    float l1r[2], l1i[2], l2r[2], l2i[2], l3r[2], l3i[2], l4r[2], l4i[2], cr[2], ci[2];
#pragma unroll
    for (int cc = 0; cc < 2; ++cc) {
        const float* lp = (const float*)(tab + S5_LAM_OFF) + (size_t)(g * 64 + 32 * cc + l31) * 16;
        const f32x4 a = *(const f32x4*)lp, bq = *(const f32x4*)(lp + 4);
        l1r[cc] = a[0]; l1i[cc] = a[1]; l2r[cc] = a[2]; l2i[cc] = a[3]; l3r[cc] = bq[0]; l3i[cc] = bq[1]; l4r[cc] = bq[2]; l4i[cc] = bq[3];
        cr[cc] = 0.f; ci[cc] = 0.f;
        if (OUT) {
            const float p256r = lp[12], p256i = lp[13];
            const float* ep = END + ((size_t)((b * 32 + g) * 16) * 64 + 32 * cc + l31) * 2;
#pragma unroll
            for (int m = 0; m < 15; ++m) { const int mm = m < c ? m : 0; f32x2 e = *(const f32x2*)(ep + (size_t)mm * 128); float tr_, ti_; cmul(p256r, p256i, cr[cc], ci[cc], tr_, ti_);
                if (m < c) { cr[cc] = tr_ + e.x; ci[cc] = ti_ + e.y; } }
        }
    }
    bf16x8 cm[9];
    if (OUT) {
#pragma unroll
        for (int s = 0; s < 9; ++s) cm[s] = *((const bf16x8*)(tab + S5_CM_OFF) + (g * 9 + s) * 64 + lane);
    }
    const size_t row0 = (size_t)b * L + 256 * c;
    bf16x8 ufn = *(const bf16x8*)(P + (row0 + l31) * 2560 + 2048 + g * 16 + 8 * hi);
#pragma unroll 1
    for (int step = 0; step < 8; ++step) {
        const bf16x8 uf = ufn;
        if (step < 7) ufn = *(const bf16x8*)(P + (row0 + 32 * (step + 1) + l31) * 2560 + 2048 + g * 16 + 8 * hi);
        f32x16 acc[4];
#pragma unroll
        for (int tt = 0; tt < 4; ++tt) {
#pragma unroll
            for (int r = 0; r < 16; ++r) acc[tt][r] = 0.f;
            acc[tt] = __builtin_amdgcn_mfma_f32_32x32x16_bf16(uf, bbt[tt], acc[tt], 0, 0, 0);
        }
#pragma unroll
        for (int cc = 0; cc < 2; ++cc) {
            f32x16& xr = acc[2 * cc]; f32x16& xi = acc[2 * cc + 1];
#pragma unroll
            for (int k = 0; k < 4; ++k)
#pragma unroll
                for (int i = 1; i < 4; ++i) { const int r = 4 * k + i;
                    const float nr = l1r[cc] * xr[r - 1] - l1i[cc] * xi[r - 1] + xr[r], ni = l1r[cc] * xi[r - 1] + l1i[cc] * xr[r - 1] + xi[r];
                    xr[r] = nr; xi[r] = ni; }
            float C0r = cr[cc], C0i = ci[cc];
            float mr[4], mi[4];
#pragma unroll
            for (int k = 0; k < 4; ++k) {
                const float er = xr[4 * k + 3], ei = xi[4 * k + 3];
                const float pr = __shfl_xor(er, 32), pi = __shfl_xor(ei, 32);
                const float e0r = hi ? pr : er, e0i = hi ? pi : ei, e1r = hi ? er : pr, e1i = hi ? ei : pi;
                float t1r, t1i; cmul(l4r[cc], l4i[cc], C0r, C0i, t1r, t1i); float C1r = t1r + e0r, C1i = t1i + e0i;
                asm volatile("s_nop 3" : "+v"(C1r), "+v"(C1i));
                mr[k] = hi ? C1r : C0r; mi[k] = hi ? C1i : C0i;
                float t2r, t2i; cmul(l4r[cc], l4i[cc], C1r, C1i, t2r, t2i); C0r = t2r + e1r; C0i = t2i + e1i;
                asm volatile("s_nop 3" : "+v"(C0r), "+v"(C0i), "+v"(mr[k]), "+v"(mi[k]));
            }
            cr[cc] = C0r; ci[cc] = C0i;
            if (OUT) {
#pragma unroll
                for (int k = 0; k < 4; ++k) {
                    float tr_, ti_;
                    cmul(l1r[cc], l1i[cc], mr[k], mi[k], tr_, ti_); xr[4 * k] += tr_; xi[4 * k] += ti_;
                    cmul(l2r[cc], l2i[cc], mr[k], mi[k], tr_, ti_); xr[4 * k + 1] += tr_; xi[4 * k + 1] += ti_;
                    cmul(l3r[cc], l3i[cc], mr[k], mi[k], tr_, ti_); xr[4 * k + 2] += tr_; xi[4 * k + 2] += ti_;
                    cmul(l4r[cc], l4i[cc], mr[k], mi[k], tr_, ti_); xr[4 * k + 3] += tr_; xi[4 * k + 3] += ti_;
                }
#pragma unroll
                for (int r = 0; r < 16; ++r) { const int tk = (r & 3) + 8 * (r >> 2) + 4 * hi;
                    *(LAS unsigned*)(xl + tk * 272 + (32 * cc + l31) * 4) = cvt_pk_bf16(xr[r], xi[r]); }
            }
        }
        if (!OUT) {
            if (step == 7 && hi == 0) {
                float* ep = END + ((size_t)((b * 32 + g) * 16 + c) * 64) * 2;
                f32x2 e0; e0.x = cr[0]; e0.y = ci[0]; f32x2 e1; e1.x = cr[1]; e1.y = ci[1];
                *(f32x2*)(ep + l31 * 2) = e0; *(f32x2*)(ep + (32 + l31) * 2) = e1;
            }
        } else {
            LDS_WAIT(); asm volatile("" ::: "memory");
            f32x16 y;
#pragma unroll
            for (int r = 0; r < 16; ++r) y[r] = 0.f;
#pragma unroll
            for (int s = 0; s < 8; ++s) { const bf16x8 xf = *(const LAS bf16x8*)(xl + l31 * 272 + 32 * s + 16 * hi);
                y = __builtin_amdgcn_mfma_f32_32x32x16_bf16(cm[s], xf, y, 0, 0, 0); }
            y = __builtin_amdgcn_mfma_f32_32x32x16_bf16(cm[8], uf, y, 0, 0, 0);
            bf16_t* gp = G + (row0 + 32 * step + l31) * 512 + g * 16 + 4 * hi;
#pragma unroll
            for (int rg = 0; rg < 2; ++rg) {
                float gv[4];
#pragma unroll
                for (int e = 0; e < 4; ++e) { const float v = y[4 * rg + e]; gv[e] = v * fast_sigmoid(1.5957691216057308f * (v + 0.044715f * v * v * v)); }
                u32x2 o; o.x = cvt_pk_bf16(gv[0], gv[1]); o.y = cvt_pk_bf16(gv[2], gv[3]);
                *(u32x2*)(gp + 8 * rg) = o;
            }
            LDS_WAIT(); asm volatile("" ::: "memory");
        }
    }
}

struct EpiGlu {
    static constexpr bool PERM = true;
    const bf16_t* G; const float* bias; bf16_t* MG;
    __device__ __forceinline__ void operator()(const f32x4 (&acc)[2][2][4][2], const Unit& u, int wr, int wc, int fr, int fq) const {
        const int row0 = u.pm * 256 + wr * 64 + fr;
#pragma unroll
        for (int ai = 0; ai < 2; ++ai)
#pragma unroll
            for (int m = 0; m < 4; ++m) {
                const int row = row0 + ai * 128 + m * 16;
#pragma unroll
                for (int bj = 0; bj < 2; ++bj) {
                    const int col = u.pn * 256 + bj * 128 + wc * 32 + 8 * fq;
                    const u32x4 gq = *(const u32x4*)(G + (size_t)row * 512 + col);
                    const f32x4 b0 = *(const f32x4*)(bias + col), b1 = *(const f32x4*)(bias + col + 4);
                    const f32x4 z0 = acc[ai][bj][m][0] + b0, z1 = acc[ai][bj][m][1] + b1;
                    u32x4 o;
                    o.x = cvt_pk_bf16(bflo(gq.x) * fast_sigmoid(z0[0]), bfhi(gq.x) * fast_sigmoid(z0[1]));
                    o.y = cvt_pk_bf16(bflo(gq.y) * fast_sigmoid(z0[2]), bfhi(gq.y) * fast_sigmoid(z0[3]));
                    o.z = cvt_pk_bf16(bflo(gq.z) * fast_sigmoid(z1[0]), bfhi(gq.z) * fast_sigmoid(z1[1]));
                    o.w = cvt_pk_bf16(bflo(gq.w) * fast_sigmoid(z1[2]), bfhi(gq.w) * fast_sigmoid(z1[3]));
                    *(u32x4*)(MG + (size_t)row * D + 512 + col) = o;
                }
            }
    }
};
struct Args {
    const float* in[25]; float* out; unsigned char* ws; int ph_lo, ph_hi;
};
enum { PH_PROLOGUE = 0, PH_INPROJ = 1, PH_MIX_A = 2, PH_MIX_B = 3, PH_GLU = 4, PH_OUTPROJ0 = 5, PH_ROUTER0 = 6, PH_GATEUP0 = 7, PH_DOWN0 = 8, PH_QKV = 9, PH_ATTN_AB = 10, PH_ATTN_C = 11, PH_OUTPROJ1 = 12, PH_ROUTER1 = 13, PH_MOE1X = 14, PH_MOE1Y = 15, PH_MOE1Z = 16, PH_FINAL = 17, PH_COUNT = 18 };

enum { CF_IN = 0, CF_OUT = 1, CF_GLU = 2, CF_QKV = 3, CF_CO = 4, CF_G = 5, CF_U = 6, CF_D = 7 };
struct ConvSeg { int fam, lo, n; };
template <int FAM>
__device__ __forceinline__ void conv_item(const Args& a, LAS float* scr, int r, int lane) {
    unsigned char* ws = a.ws;
    if (FAM == CF_IN) tr_item<1>(a.in[4], 2560, (bf16_t*)(ws + WS_WIN), 1024, 0, 0, a.in[1], scr, r, lane);
    else if (FAM == CF_OUT) tr_item<0>(a.in[5], 1024, (bf16_t*)(ws + WS_WOUT), 1024, 0, 0, nullptr, scr, r, lane);
    else if (FAM == CF_GLU) tr_item<0>(a.in[14], 512, (bf16_t*)(ws + WS_WGLU), 512, 0, 0, nullptr, scr, r, lane);
    else if (FAM == CF_QKV) tr_item<0>(a.in[16], 3072, (bf16_t*)(ws + WS_WQKV), 1024, 0, 0, a.in[1] + D, scr, r, lane);
    else if (FAM == CF_CO) tr_item<0>(a.in[17], 1024, (bf16_t*)(ws + WS_CWOUT), 1024, 0, 0, nullptr, scr, r, lane);
    else if (FAM == CF_G) { const int le = r >> 8, layer = le >> 4, ge = le & 15;
        tr_item<2>(a.in[22] + (size_t)le * 1024 * 512, 512, (bf16_t*)(ws + WS_WGU + layer * WS_MOE_LAYER) + (size_t)ge * 1024 * 1024, 1024, 0, 0, a.in[2] + layer * D, scr, r & 255, lane); }
    else if (FAM == CF_U) { const int le = r >> 8, layer = le >> 4, ge = le & 15;
        tr_item<3>(a.in[23] + (size_t)le * 1024 * 512, 512, (bf16_t*)(ws + WS_WGU + layer * WS_MOE_LAYER) + (size_t)ge * 1024 * 1024, 1024, 0, 0, a.in[2] + layer * D, scr, r & 255, lane); }
    else { const int le = r >> 8, layer = le >> 4, g = (le >> 2) & 3, e = le & 3;
        tr_item<0>(a.in[24] + (size_t)le * 512 * 1024, 1024, (bf16_t*)(ws + WS_WD + layer * WS_MOE_LAYER) + (size_t)g * 1024 * 2048, 2048, e * 512, 0, nullptr, scr, r & 255, lane); }
}
template <int SLOT>
__device__ __forceinline__ void conv_run(Frame& F, const Args& a, int widx, int wcount) {
    LAS float* scr = (LAS float*)(F.lds + F.wave * 16384);
    if (SLOT == 0) {
        constexpr int N0 = 16 * 80, N1 = 16 * 32, N2 = 8 * 16;
        for (int it = widx; it < N0 + N1 + N2; it += wcount) { int r = it;
            if (r < N0) { conv_item<CF_IN>(a, scr, r, F.lane); continue; } r -= N0;
            if (r < N1) { conv_item<CF_OUT>(a, scr, r, F.lane); continue; } r -= N1;
            conv_item<CF_GLU>(a, scr, r, F.lane); }
    } else if (SLOT == 1) {
        constexpr int N0 = 4096, N1 = 2048;
        for (int it = widx; it < N0 + N1; it += wcount) { int r = it;
            if (r < N0) { conv_item<CF_U>(a, scr, r, F.lane); continue; } r -= N0;
            conv_item<CF_G>(a, scr, r, F.lane); }
    } else if (SLOT == 4) {
        constexpr int N0 = 16 * 32, N1 = 4096, N2 = 16 * 96;
        for (int it = widx; it < N0 + N1 + N2; it += wcount) { int r = it;
            if (r < N0) { conv_item<CF_CO>(a, scr, r, F.lane); continue; } r -= N0;
            if (r < N1) { conv_item<CF_G>(a, scr, 4096 + r, F.lane); continue; } r -= N1;
            conv_item<CF_QKV>(a, scr, r, F.lane); }
    } else if (SLOT == 3) {
        for (int it = widx; it < 6144; it += wcount) { if (it < 4096) conv_item<CF_D>(a, scr, it, F.lane); else conv_item<CF_G>(a, scr, it - 2048, F.lane); }
    } else {
        for (int it = widx; it < 8192; it += wcount) {
            if (it < 4096) conv_item<CF_U>(a, scr, 4096 + it, F.lane); else conv_item<CF_D>(a, scr, it, F.lane); }
    }
}
__device__ __forceinline__ void p0_prologue(Frame& F, const Args& a) {
    unsigned char* ws = a.ws;
    const int gw = F.vcu * NWAVES + F.wave, NGW = F.G * NWAVES;
    conv_run<0>(F, a, gw, NGW);
    const float* x = a.in[0]; bf16_t* XB = (bf16_t*)(ws + WS_XB); float* ss0 = (float*)(ws + WS_SS0);
    for (int m = gw; m < T; m += NGW) {
        const f32x4* xr = (const f32x4*)(x + (size_t)m * D) + F.lane;
        f32x4 v[4]; float s = 0.f;
#pragma unroll
        for (int j = 0; j < 4; ++j) { v[j] = xr[64 * j]; s += (v[j].x * v[j].x + v[j].y * v[j].y) + (v[j].z * v[j].z + v[j].w * v[j].w); }
        s = wave_sum(s);
        u32x2* o8 = (u32x2*)(XB + (size_t)m * D) + F.lane;
#pragma unroll
        for (int j = 0; j < 4; ++j) { u32x2 w; w.x = pk2(v[j].x, v[j].y); w.y = pk2(v[j].z, v[j].w); o8[64 * j] = w; }
        if (F.lane == 0) __hip_atomic_store(ss0 + m, s, RLX_AGENT);
    }
    s5_tables(ws + WS_S5T, a.in[6], a.in[7], a.in[8], a.in[9], a.in[10], a.in[11], a.in[12], a.in[13], F.vcu * NWAVES * 64 + F.tid, F.G * NWAVES * 64);
    {   float* rtw = (float*)(ws + WS_RTW);
        for (int i = (F.vcu * NWAVES * 64) + F.tid; i < 2 * 20 * 1024; i += F.G * NWAVES * 64) {
            const int layer = i / 20480, r = i - layer * 20480, j = r >> 10, k = r & 1023;
            const float wv = j < 4 ? a.in[18][(size_t)layer * 4096 + k * 4 + j] : a.in[20][(size_t)layer * 16384 + k * 16 + (j - 4)];
            rtw[i] = wv * a.in[2][layer * D + k]; } }
    float* rope = (float*)(ws + WS_ROPE);
    for (int i = (F.vcu * NWAVES * 64) + F.tid; i < L * 64; i += F.G * NWAVES * 64) {
        const int j = i & 63, pos = i >> 6;
        const float inv = powf(10000.0f, -(float)j / 64.0f);
        const float ang = (float)pos * inv;
        rope[i] = cosf(ang); rope[L * 64 + i] = sinf(ang);
    }
}

__device__ __forceinline__ void router_phase(Frame& F, const Args& a, int layer) {
    unsigned char* ws = a.ws;
    LAS float* wT = (LAS float*)F.lds;
    LAS float* gn = wT + 20 * 1024;
    LAS float* bias = gn + 1024;
    LAS int* rcls = (LAS int*)(bias + 32);
    LAS float* rwl = (LAS float*)(rcls + 64);
    LAS float* rwh = rwl + 64;
    LAS int* cbase = (LAS int*)(rwh + 64);
    const float* wg = a.in[18] + (size_t)layer * 4096; const float* bg = a.in[19] + layer * 4;
    const float* wrr = a.in[20] + (size_t)layer * 16384; const float* brr = a.in[21] + layer * 16;
    const float* gain = a.in[2] + layer * D;
    unsigned* cnt = F.ctl + (layer ? CW_CLS1 : CW_CLS0);
    const bf16_t* H = layer ? (const bf16_t*)(ws + WS_XB) : (const bf16_t*)a.out;
    int* list = (int*)(ws + WS_LIST); f32x2* lw = (f32x2*)(ws + WS_LW);
    {   const f32x4* rt = (const f32x4*)(ws + WS_RTW) + (size_t)layer * 5120;
#pragma unroll
        for (int i = 0; i < 10; ++i) ((LAS f32x4*)wT)[F.tid + 512 * i] = rt[F.tid + 512 * i]; }
    if (F.tid < 4) bias[F.tid] = bg[F.tid]; else if (F.tid < 20) bias[F.tid] = brr[F.tid - 4];
    __syncthreads();
    for (int rb = F.vcu; rb < T / 64; rb += F.G) {
        constexpr int RB = 4;
        u32x2 nv[RB][4];
#pragma unroll
        for (int r = 0; r < RB; ++r) { const u32x2* hr0 = (const u32x2*)(H + (size_t)(rb * 64 + F.wave * 8 + r) * D) + F.lane;
#pragma unroll
            for (int j = 0; j < 4; ++j) nv[r][j] = hr0[64 * j]; }
#pragma unroll 1
        for (int rg = 0; rg < 8 / RB; ++rg) {
            const int rloc0 = F.wave * 8 + rg * RB, row0 = rb * 64 + rloc0;
            f32x4 v[RB][4]; float rstd[RB];
#pragma unroll
            for (int r = 0; r < RB; ++r)
#pragma unroll
                for (int j = 0; j < 4; ++j) v[r][j] = (f32x4){bflo(nv[r][j].x), bfhi(nv[r][j].x), bflo(nv[r][j].y), bfhi(nv[r][j].y)};
            if (rg + 1 < 8 / RB) {
#pragma unroll
                for (int r = 0; r < RB; ++r) { const u32x2* hr = (const u32x2*)(H + (size_t)(row0 + RB + r) * D) + F.lane;
#pragma unroll
                    for (int j = 0; j < 4; ++j) nv[r][j] = hr[64 * j]; } }
#pragma unroll
            for (int r = 0; r < RB; ++r) { float s = 0.f;
#pragma unroll
                for (int j = 0; j < 4; ++j) s += (v[r][j].x * v[r][j].x + v[r][j].y * v[r][j].y) + (v[r][j].z * v[r][j].z + v[r][j].w * v[r][j].w);
                rstd[r] = rsqrtf(wave_allsum(s) * (1.0f / D) + RMS_EPS); }
            float lgg[RB][4];
#pragma unroll
            for (int i = 0; i < 4; ++i) { float acc[RB];
#pragma unroll
                for (int r = 0; r < RB; ++r) acc[r] = 0.f;
#pragma unroll
                for (int j = 0; j < 4; ++j) { const f32x4 w4 = *(const LAS f32x4*)(wT + i * 1024 + 256 * j + 4 * F.lane);
#pragma unroll
                    for (int r = 0; r < RB; ++r) acc[r] += (v[r][j].x * w4.x + v[r][j].y * w4.y) + (v[r][j].z * w4.z + v[r][j].w * w4.w); }
                const float bi = bias[i];
#pragma unroll
                for (int r = 0; r < RB; ++r) lgg[r][i] = wave_allsum(acc[r]) * rstd[r] + bi; }
#pragma unroll
            for (int r = 0; r < RB; ++r) {
                const float* lg = lgg[r]; const int rloc = rloc0 + r;
                int gs = 0; float gm = lg[0];
#pragma unroll
                for (int i = 1; i < 4; ++i) if (lg[i] > gm) { gm = lg[i]; gs = i; }
                float se = 0.f;
#pragma unroll
                for (int i = 0; i < 4; ++i) se += expf(lg[i] - gm);
                const float gval = 1.0f / se;
                float ev[4];
#pragma unroll
                for (int i = 0; i < 4; ++i) { const LAS float* wrow = wT + (4 + gs * 4 + i) * 1024; float acc = 0.f;
#pragma unroll
                    for (int j = 0; j < 4; ++j) { const f32x4 w4 = *(const LAS f32x4*)(wrow + 256 * j + 4 * F.lane); acc += (v[r][j].x * w4.x + v[r][j].y * w4.y) + (v[r][j].z * w4.z + v[r][j].w * w4.w); }
                    ev[i] = wave_allsum(acc) * rstd[r] + bias[4 + gs * 4 + i]; }
                int i1 = 0; float v1 = ev[0];
#pragma unroll
                for (int i = 1; i < 4; ++i) if (ev[i] > v1) { v1 = ev[i]; i1 = i; }
                int i2 = -1; float v2 = -3.0e38f;
#pragma unroll
                for (int i = 0; i < 4; ++i) if (i != i1 && ev[i] > v2) { v2 = ev[i]; i2 = i; }
                const float e2 = expf(v2 - v1);
                const float w1 = gval / (1.0f + e2), w2 = gval * e2 / (1.0f + e2);
                const int lo = i1 < i2 ? i1 : i2, hi = i1 < i2 ? i2 : i1;
                const int pidx = lo == 0 ? hi - 1 : (lo == 1 ? hi + 1 : 5);
                if (F.lane == 0) { rcls[rloc] = gs * 6 + pidx; rwl[rloc] = __uint_as_float(pk2(i1 < i2 ? w1 : w2, i1 < i2 ? w2 : w1)); rwh[rloc] = rstd[r]; }
            }
        }
        __syncthreads();
        if (F.tid < 24) { int tot = 0; for (int r = 0; r < 64; ++r) tot += (rcls[r] == F.tid) ? 1 : 0;
            cbase[F.tid] = tot ? (int)__hip_atomic_fetch_add(cnt + 64 * F.tid, (unsigned)tot, RLX_AGENT) : 0; }
        __syncthreads();
        if (F.tid < 64) { const int myc = rcls[F.tid]; int rank = 0; for (int r = 0; r < F.tid; ++r) rank += (rcls[r] == myc) ? 1 : 0;
            const int pos = cbase[myc] + rank; __hip_atomic_store(list + myc * 16384 + pos, rb * 64 + F.tid, RLX_AGENT);
            __hip_atomic_store((unsigned long long*)(lw + myc * 16384 + pos), ((unsigned long long)__float_as_uint(rwh[F.tid]) << 32) | __float_as_uint(rwl[F.tid]), RLX_AGENT); }
        __syncthreads();
    }
}
__device__ __forceinline__ void moe_setup(Frame& F, int layer) {
    LAS int* tb = (LAS int*)(F.lds + MOE_TB_OFF); LAS int* cc = tb + 25;
    if (F.tid == 0) { const unsigned* cnt = F.ctl + (layer ? CW_CLS1 : CW_CLS0); int run = 0;
        for (int c = 0; c < 24; ++c) { const int n = (int)__hip_atomic_load(cnt + 64 * c, RLX_AGENT); cc[c] = n; tb[c] = run; run += (n + 255) >> 8; }
        tb[24] = run; }
    __syncthreads();
}
template <bool LAST>
__device__ __forceinline__ void moe_phases(Frame& F, const Args& a, int layer, int which) {
    unsigned char* ws = a.ws;
    moe_setup(F, layer);
    const LAS int* tb = (const LAS int*)(F.lds + MOE_TB_OFF); const LAS int* cc = tb + 25;
    if (which == 0) {
        MoeOrder S{layer ? (const char*)(ws + WS_XB) : (const char*)a.out, (const char*)(ws + WS_WGU + layer * WS_MOE_LAYER), (const int*)(ws + WS_LIST), tb, cc, 8, F.G, F.vcu, 0, 0, tb[24] * 8};
        EpiGateUp E{(bf16_t*)(ws + WS_P), (const f32x2*)(ws + WS_LW), tb};
        pg8::gemm_phase<EpiGateUp, MoeOrder, true, true, false>(F.lds, 1024, 1024, 1024, S, E);
        if (layer == 0) {
            __syncthreads();
            const int nGU = tb[24] * 8, start = nGU % F.G;
            if (F.vcu >= start) conv_run<4>(F, a, (F.vcu - start) * NWAVES + F.wave, (F.G - start) * NWAVES);
        }
    } else {
        MoeOrder S{(const char*)(ws + WS_P), (const char*)(ws + WS_WD + layer * WS_MOE_LAYER), (const int*)(ws + WS_LIST), tb, cc, 4, F.G, F.vcu, 1, 0, tb[24] * 4};
        EpiDown E{layer ? (const bf16_t*)(ws + WS_XB) : (const bf16_t*)a.out, (bf16_t*)(ws + WS_XB), (float*)(ws + WS_SSP), (const int*)(ws + WS_LIST), tb};
        pg8::gemm_phase<EpiDown, MoeOrder, true, false, true>(F.lds, 1024, 2048, 1024, S, E);
        if (layer == 0) {
            __syncthreads();
            const int nD = tb[24] * 4, start = nD % F.G;
            if (F.vcu >= start) conv_run<2>(F, a, (F.vcu - start) * NWAVES + F.wave, (F.G - start) * NWAVES);
        }
    }
    __syncthreads();
}
template <int SUB>
__device__ __forceinline__ void moe_sub(Frame& F, const Args& a) {
    unsigned char* ws = a.ws; constexpr int layer = 1;
    moe_setup(F, layer);
    const LAS int* tb = (const LAS int*)(F.lds + MOE_TB_OFF); const LAS int* cc = tb + 25;
    const int nt = tb[24], nGU = nt * 8, nD = nt * 4, full = (nGU / F.G) * F.G, rest = nGU - full;
    int dY = F.G - rest; { const int cap = (full >> 3) * 4; dY = dY < cap ? dY : cap; dY = dY < nD ? dY : nD; }
    if (SUB < 2) {
        MoeOrder S{(const char*)(ws + WS_XB), (const char*)(ws + WS_WGU + layer * WS_MOE_LAYER), (const int*)(ws + WS_LIST), tb, cc, 8, F.G, F.vcu, 0, SUB == 0 ? 0 : full, SUB == 0 ? full : nGU};
        EpiGateUp E{(bf16_t*)(ws + WS_P), (const f32x2*)(ws + WS_LW), tb};
        pg8::gemm_phase<EpiGateUp, MoeOrder, true, true, false>(F.lds, 1024, 1024, 1024, S, E);
    }
    if (SUB > 0) {
        MoeOrder S{(const char*)(ws + WS_P), (const char*)(ws + WS_WD + layer * WS_MOE_LAYER), (const int*)(ws + WS_LIST), tb, cc, 4, SUB == 1 ? F.G - rest : F.G, SUB == 1 ? F.vcu - rest : F.vcu, 1, SUB == 1 ? 0 : dY, SUB == 1 ? dY : nD};
        EpiDown E{(const bf16_t*)(ws + WS_XB), (bf16_t*)(ws + WS_XB), (float*)(ws + WS_SSP), (const int*)(ws + WS_LIST), tb};
        pg8::gemm_phase<EpiDown, MoeOrder, true, false, true>(F.lds, 1024, 2048, 1024, S, E);
    }
    __syncthreads();
}
__device__ __forceinline__ void final_phase(Frame& F, const Args& a) {
    const float* ss = (const float*)(a.ws + WS_SSP); const float* gain = a.in[3]; const bf16_t* H = (const bf16_t*)(a.ws + WS_XB);
    const int gw = F.vcu * NWAVES + F.wave, NGW = F.G * NWAVES;
    f32x4 g4[4];
#pragma unroll
    for (int j = 0; j < 4; ++j) g4[j] = *((const f32x4*)gain + F.lane + 64 * j);
    for (int m = gw; m < T; m += NGW) {
        f32x4* hr = (f32x4*)(a.out + (size_t)m * D) + F.lane;
        const u32x2* hs = (const u32x2*)(H + (size_t)m * D) + F.lane;
        const f32x4* sp = (const f32x4*)(ss + (size_t)m * 32);
        const f32x4 s4 = (sp[0] + sp[1]) + (sp[2] + sp[3]);
        const float rstd = rsqrtf(((s4[0] + s4[1]) + (s4[2] + s4[3])) * (1.0f / D) + RMS_EPS);
#pragma unroll
        for (int j = 0; j < 4; ++j) { const u32x2 q = hs[64 * j]; hr[64 * j] = (f32x4){bflo(q.x), bfhi(q.x), bflo(q.y), bfhi(q.y)} * rstd * g4[j]; }
    }
}

__global__ void __launch_bounds__(NWAVES * 64, 2) mega(Args args) {
    extern __shared__ __attribute__((aligned(16))) unsigned char lds[];
    Frame F;
    F.lds = (LAS unsigned char*)lds;
    F.MISC = (volatile LAS unsigned*)(F.lds + MISC_OFF);
    F.tid = threadIdx.x; F.lane = F.tid & 63; F.wave = __builtin_amdgcn_readfirstlane(F.tid >> 6);
    F.G = gridDim.x; { const int bx = blockIdx.x; F.vcu = (F.G % 8 == 0) ? (bx % 8) * (F.G / 8) + bx / 8 : bx; }
    unsigned char* ws = args.ws;
    F.ctl = (unsigned*)ws;
    for (int u = F.tid; u < (LDS_BYTES - LDSCTL_OFF) / 4; u += NWAVES * 64) ((LAS unsigned*)(F.lds + LDSCTL_OFF))[u] = 0u;
    __syncthreads();
    const int lo = args.ph_lo, hi = args.ph_hi;
    XcdBarrier bar; bar.bar = F.ctl + CW_BAR; bar.x = 0; bar.st = nullptr;
    if (hi - lo > 1) bar = xcd_barrier_post(F.ctl + CW_BAR, F.MISC + 8);
#define IN(k) (lo <= (k) && (k) < hi)
#define SEAM(k) do { if (IN(k) && IN((k) + 1)) xcd_barrier(bar); } while (0)

    if (IN(PH_PROLOGUE)) {
        p0_prologue(F, args); SEAM(PH_PROLOGUE); }
    if (IN(PH_INPROJ)) {
        PlainOrder S; S.init(ws + WS_XB, ws + WS_WIN, 1024, 1024, T, 2560, F.G, (int)blockIdx.x);
        EpiInProj E{(bf16_t*)(ws + WS_P), (const float*)(ws + WS_SS0), (const float*)(ws + WS_ROPE)};
        pg8::gemm_phase<EpiInProj, PlainOrder, true, false, false>(F.lds, 1024, 1024, 1024, S, E);
        { const int nun = (T / 256) * 10, start = nun % F.G, bx = (int)blockIdx.x;
          __syncthreads();
          if (bx >= start) conv_run<3>(F, args, (bx - start) * NWAVES + F.wave, (F.G - start) * NWAVES); }
        SEAM(PH_INPROJ);
    }
    if (IN(PH_MIX_A)) {
        for (int u = F.vcu; u < 256; u += F.G) ret_kv_unit(F.lds, (const bf16_t*)(ws + WS_P), (bf16_t*)(ws + WS_XB), u >> 6, (u >> 4) & 3, u & 15, F.tid);
        for (int t = F.vcu * NWAVES + F.wave; t < 2048; t += F.G * NWAVES)
            s5_task<false>((const bf16_t*)(ws + WS_P), ws + WS_S5T, (float*)(ws + WS_S5END), nullptr, F.lds + F.wave * 8704, t >> 9, (t >> 4) & 31, t & 15, F.lane);
        SEAM(PH_MIX_A);
    }
    if (IN(PH_MIX_B)) {
        for (int u = F.vcu; u < 256; u += F.G) ret_out_unit(F.lds, (const bf16_t*)(ws + WS_P), (const bf16_t*)(ws + WS_XB), (bf16_t*)(ws + WS_MG), u >> 6, (u >> 4) & 3, u & 15, F.tid);
        for (int t = F.vcu * NWAVES + F.wave; t < 2048; t += F.G * NWAVES)
        {   const int v_ = t >> 3, wv_ = t & 7;
            s5_task<true>((const bf16_t*)(ws + WS_P), ws + WS_S5T, (float*)(ws + WS_S5END), (bf16_t*)(ws + WS_XB + 8 * MiB), F.lds + F.wave * 8704, v_ >> 6, (v_ & 3) * 8 + wv_, (v_ >> 2) & 15, F.lane); }
        SEAM(PH_MIX_B);
    }
    if (IN(PH_GLU)) {
        PlainOrder S; S.init(ws + WS_XB + 8 * MiB, ws + WS_WGLU, 512, 512, T, 512, F.G, (int)blockIdx.x);
        EpiGlu E{(const bf16_t*)(ws + WS_XB + 8 * MiB), args.in[15], (bf16_t*)(ws + WS_MG)};
        pg8::gemm_phase<EpiGlu, PlainOrder, true, false, false>(F.lds, 512, 512, 512, S, E);
        { const int nun = (T / 256) * 2, bx = (int)blockIdx.x;
          if (bx >= nun && F.G > nun) conv_run<1>(F, args, (bx - nun) * NWAVES + F.wave, (F.G - nun) * NWAVES);
          else if (F.G <= nun) conv_run<1>(F, args, bx * NWAVES + F.wave, F.G * NWAVES); }
        SEAM(PH_GLU);
    }
    if (IN(PH_OUTPROJ0)) {
        PlainOrder S; S.init(ws + WS_MG, ws + WS_WOUT, 1024, 1024, T, 1024, F.G, (int)blockIdx.x);
        EpiOutRes<true> E{args.in[0], nullptr, (bf16_t*)args.out};
        pg8::gemm_phase<EpiOutRes<true>, PlainOrder, true, false, false>(F.lds, 1024, 1024, 1024, S, E);
        SEAM(PH_OUTPROJ0);
    }
    if (IN(PH_ROUTER0)) { router_phase(F, args, 0); SEAM(PH_ROUTER0); }
    if (IN(PH_GATEUP0)) { moe_phases<false>(F, args, 0, 0); SEAM(PH_GATEUP0); }
    if (IN(PH_DOWN0)) { moe_phases<false>(F, args, 0, 1); SEAM(PH_DOWN0); }
    if (IN(PH_QKV)) {
        PlainOrder S; S.init(ws + WS_XB, ws + WS_WQKV, 1024, 1024, T, 3072, F.G, (int)blockIdx.x);
        EpiQKV E{(bf16_t*)(ws + WS_P), (const float*)(ws + WS_SSP), 0.08838834764831845f * 1.4426950408889634f};
        pg8::gemm_phase<EpiQKV, PlainOrder, true, false, false>(F.lds, 1024, 1024, 1024, S, E);
        SEAM(PH_QKV);
    }
    if (IN(PH_ATTN_AB)) {
        const bf16_t* P = (const bf16_t*)(ws + WS_P); float* lse = (float*)(ws + WS_LSE);
        const int per = (2048 + F.G - 1) / F.G; const int u0 = F.vcu * per, u1 = (u0 + per < 2048) ? u0 + per : 2048;
        u32x4 kreg[8], vreg[8];
#define ATT_DEC_AB(u, b_, h_, r_, n_, d_) const int b_ = (u) < 1024 ? (u) >> 8 : ((u) - 1024) >> 8, h_ = (u) < 1024 ? ((u) >> 5) & 7 : (((u) - 1024) >> 5) & 7, r_ = (u) < 1024 ? 0 : (((u) - 1024) >> 3) & 3, n_ = (u) < 1024 ? (u) & 31 : ((u) - 1024) & 7, d_ = (u) < 1024 ? 1 : 4
        bool full = true;
        if (u0 < u1) { ATT_DEC_AB(u0, b0, h0, r0, n0, d0); attn_load(P, b0, h0, r0, n0, d0, F.tid, true, kreg, vreg); }
#pragma unroll 1
        for (int u = u0; u < u1; ++u) {
            ATT_DEC_AB(u, bc, hc, rc, nc, dc);
            attn_store(F.lds, F.tid, nc, full, kreg, vreg);
            __syncthreads();
            bf16x8 qf[4]; attn_loadq(P, bc, hc, rc, nc, dc, F.tid, qf);
            if (u + 1 < u1) { ATT_DEC_AB(u + 1, b1, h1, r1, n1, d1);
                full = !(b1 == bc && h1 == hc && r1 == rc && d1 == dc && n1 == nc + 1);
                attn_load(P, b1, h1, r1, n1, d1, F.tid, full, kreg, vreg); }
            attn_compute<false>(F.lds, P, (u < 1024 ? (bf16_t*)args.out + (size_t)T * D : (bf16_t*)(ws + WS_MG)), lse + (u < 1024 ? 0 : (size_t)T * 8), nullptr, nullptr, nullptr, nullptr, bc, hc, rc, nc, dc, F.tid, qf);
            __syncthreads();
        }
        SEAM(PH_ATTN_AB);
    }
    if (IN(PH_ATTN_C)) {
        const bf16_t* P = (const bf16_t*)(ws + WS_P); float* lse = (float*)(ws + WS_LSE);
        const int per = (1024 + F.G - 1) / F.G; const int u0 = F.vcu * per, u1 = (u0 + per < 1024) ? u0 + per : 1024;
        u32x4 kreg[8], vreg[8];
        bool full = true;
        if (u0 < u1) attn_load(P, u0 >> 8, (u0 >> 5) & 7, (u0 >> 1) & 15, u0 & 1, 16, F.tid, true, kreg, vreg);
#pragma unroll 1
        for (int u = u0; u < u1; ++u) {
            attn_store(F.lds, F.tid, u & 1, full, kreg, vreg);
            __syncthreads();
            bf16x8 qf[4]; attn_loadq(P, u >> 8, (u >> 5) & 7, (u >> 1) & 15, u & 1, 16, F.tid, qf);
            if (u + 1 < u1) { full = !(((u + 1) >> 1) == (u >> 1) && ((u + 1) & 1) == (u & 1) + 1);
                attn_load(P, (u + 1) >> 8, ((u + 1) >> 5) & 7, ((u + 1) >> 1) & 15, (u + 1) & 1, 16, F.tid, full, kreg, vreg); }
            attn_compute<true>(F.lds, P, (bf16_t*)(ws + WS_MG), nullptr, (const bf16_t*)args.out + (size_t)T * D, (const bf16_t*)(ws + WS_MG), lse, lse + (size_t)T * 8, u >> 8, (u >> 5) & 7, (u >> 1) & 15, u & 1, 16, F.tid, qf);
            __syncthreads();
        }
        SEAM(PH_ATTN_C);
    }
    if (IN(PH_OUTPROJ1)) {
        PlainOrder S; S.init(ws + WS_MG, ws + WS_CWOUT, 1024, 1024, T, 1024, F.G, (int)blockIdx.x);
        EpiOutRes<false> E{nullptr, (const bf16_t*)(ws + WS_XB), (bf16_t*)(ws + WS_XB)};
        pg8::gemm_phase<EpiOutRes<false>, PlainOrder, true, false, false>(F.lds, 1024, 1024, 1024, S, E);
        SEAM(PH_OUTPROJ1);
    }
    if (IN(PH_ROUTER1)) { router_phase(F, args, 1); SEAM(PH_ROUTER1); }
    if (IN(PH_MOE1X)) { moe_sub<0>(F, args); SEAM(PH_MOE1X); }
    if (IN(PH_MOE1Y)) { moe_sub<1>(F, args); SEAM(PH_MOE1Y); }
    if (IN(PH_MOE1Z)) { moe_sub<2>(F, args); SEAM(PH_MOE1Z); }
    if (IN(PH_FINAL)) { final_phase(F, args); }
#undef IN
#undef SEAM
}

extern "C" void kernel_launch(void* const* d_in, const int* in_sizes, int n_in, void* d_out, int out_size, void* d_ws, size_t ws_size, hipStream_t stream) {
    static int grid = 0;
    if (grid == 0) {
        if (ws_size < WS_END || n_in != 25) { fprintf(stderr, "kernel_launch: ws %zu < %zu or n_in %d\n", ws_size, (size_t)WS_END, n_in); grid = -1; return; }
        int dev = 0, cus = 0;
        if (hipGetDevice(&dev) != hipSuccess || hipDeviceGetAttribute(&cus, hipDeviceAttributeMultiprocessorCount, dev) != hipSuccess) { grid = -1; return; }
        if (hipFuncSetAttribute((const void*)mega, hipFuncAttributeMaxDynamicSharedMemorySize, LDS_BYTES) != hipSuccess) { fprintf(stderr, "hipFuncSetAttribute failed\n"); grid = -1; return; }
        int per_cu = 0;
        if (hipOccupancyMaxActiveBlocksPerMultiprocessor(&per_cu, (const void*)mega, NWAVES * 64, LDS_BYTES) != hipSuccess || per_cu < 1) fprintf(stderr, "occupancy query says %d\n", per_cu);
        (void)hipGetLastError();
        grid = cus;
    }
    if (grid < 0) return;
    unsigned char* ws = (unsigned char*)d_ws;
    (void)hipMemsetAsync(ws, 0, CTL_ZERO_BYTES, stream);
    Args a{};
    for (int i = 0; i < 25; ++i) a.in[i] = (const float*)d_in[i];
    a.out = (float*)d_out; a.ws = ws;
    a.ph_lo = 0; a.ph_hi = PH_COUNT;
    hipLaunchKernelGGL(mega, dim3(grid), dim3(NWAVES * 64), LDS_BYTES, stream, a);
}
```

```cpp
#include <hip/hip_runtime.h>
#include <stdint.h>
#include <stdio.h>

#define LAS __attribute__((address_space(3)))
#define GAS __attribute__((address_space(1)))
typedef unsigned short bf16_t;
typedef short bf16x8 __attribute__((ext_vector_type(8)));
typedef short s16x4 __attribute__((ext_vector_type(4)));
typedef float f32x4 __attribute__((ext_vector_type(4)));
typedef float f32x2 __attribute__((ext_vector_type(2)));
typedef float f32x16 __attribute__((ext_vector_type(16)));
typedef unsigned u32x4 __attribute__((ext_vector_type(4)));
typedef unsigned u32x2 __attribute__((ext_vector_type(2)));

__device__ __forceinline__ float bf2f(bf16_t v) { return __uint_as_float(((unsigned)v) << 16); }
__device__ __forceinline__ unsigned f2bf(float f) { unsigned u = __float_as_uint(f); return (u + 0x7fffu + ((u >> 16) & 1u)) >> 16; }
__device__ __forceinline__ unsigned pk2(float lo, float hi) { return f2bf(lo) | (f2bf(hi) << 16); }
__device__ __forceinline__ float bflo(unsigned w) { return __uint_as_float(w << 16); }
__device__ __forceinline__ float bfhi(unsigned w) { return __uint_as_float(w & 0xffff0000u); }
__device__ __forceinline__ float wave_sum(float v) {
#pragma unroll
    for (int o = 1; o < 64; o <<= 1) v += __shfl_xor(v, o);
    return v;
}
__device__ __forceinline__ float dpp_add(float v, int ctrl_sel) {
    const int x = __float_as_int(v); int y;
    if (ctrl_sel == 0) y = __builtin_amdgcn_update_dpp(0, x, 0xB1, 0xF, 0xF, false);
    else if (ctrl_sel == 1) y = __builtin_amdgcn_update_dpp(0, x, 0x4E, 0xF, 0xF, false);
    else if (ctrl_sel == 2) y = __builtin_amdgcn_update_dpp(0, x, 0x124, 0xF, 0xF, false);
    else y = __builtin_amdgcn_update_dpp(0, x, 0x128, 0xF, 0xF, false);
    return v + __int_as_float(y);
}
__device__ __forceinline__ float wave_allsum(float v) {
    v = dpp_add(v, 0); v = dpp_add(v, 1); v = dpp_add(v, 2); v = dpp_add(v, 3);
    {   const auto r = __builtin_amdgcn_permlane16_swap(__float_as_uint(v), __float_as_uint(v), false, false);
        v = __uint_as_float(r[0]) + __uint_as_float(r[1]);
        const auto q = __builtin_amdgcn_permlane32_swap(__float_as_uint(v), __float_as_uint(v), false, false);
        v = __uint_as_float(q[0]) + __uint_as_float(q[1]); }
    return v;
}
__device__ __forceinline__ float fast_sigmoid(float x) { return __builtin_amdgcn_rcpf(1.0f + __builtin_amdgcn_exp2f(-1.4426950408889634f * x)); }

namespace pg8 {
constexpr int BM = 256, BK = 64, HALF = 128, HTB = HALF * BK * 2, STAGE_BYTES = 8 * HTB;
__host__ __device__ __forceinline__ int lds_byte(int r, int c) { const int st = (r >> 4) * 2 + (c >> 5), rr = r & 15, cc = c & 31, ob = rr * 64 + cc * 2; return st * 1024 + (ob ^ (((ob >> 9) & 1) << 5)); }
__host__ __device__ __forceinline__ void stage_rc(int b, int& R, int& C) { const int st = b / 1024, sb = b % 1024, swz = sb ^ (((sb >> 9) & 1) << 5); R = (st >> 1) * 16 + swz / 64; C = (st & 1) * 32 + (swz % 64) / 2; }
__host__ __device__ __forceinline__ int perm32(int rho) { const int n = rho >> 4, i = rho & 15; return 8 * (i >> 2) + 4 * n + (i & 3); }

struct Unit { int pm, pn, cls, nvalid; };

__device__ __forceinline__ unsigned cvt_pk_bf16(float lo, float hi) { unsigned r; asm volatile("s_nop 1\n\tv_cvt_pk_bf16_f32 %0, %1, %2" : "=v"(r) : "v"(lo), "v"(hi)); return r; }
typedef __bf16 bf16x2_t __attribute__((ext_vector_type(2)));
__device__ __forceinline__ unsigned cvt_pk_bf16_c(float lo, float hi) { f32x2 v = {lo, hi}; bf16x2_t b = __builtin_convertvector(v, bf16x2_t); return __builtin_bit_cast(unsigned, b); }

template <class Epi, class Sched, bool ALIGN_EPI, bool GATHER, bool BJUMP>
__device__ __forceinline__ void gemm_phase(LAS unsigned char* lds, const int lda, const int ldb, const int K, const Sched& S, const Epi& E) {
    const int tid = threadIdx.x, wid = __builtin_amdgcn_readfirstlane(tid >> 6), lane = tid & 63, wr = wid >> 2, wc = wid & 3, fr = lane & 15, fq = lane >> 4;
    const int nt = K / BK;
    int Rr[2], Cc[2];
    unsigned voffA[2], voffB[2];
#pragma unroll
    for (int i = 0; i < 2; ++i) { int R, C; stage_rc(tid * 16 + i * 8192, R, C); const int Rb = Epi::PERM ? ((R & ~31) + perm32(R & 31)) : R;
        Rr[i] = R; Cc[i] = C;
        voffA[i] = (unsigned)(R * lda + C) * 2u; voffB[i] = (unsigned)(Rb * ldb + C) * 2u; }
    const size_t kstep = (size_t)(BK * 2);
    const size_t hstepA = GATHER ? 0 : (size_t)HALF * lda * 2, hstepB = (size_t)HALF * ldb * 2;
    const unsigned ldsw = (unsigned)wid * 1024u;
    const int aoff = lds_byte(wr * 64 + fr, fq * 8), boff = lds_byte(wc * 32 + fr, fq * 8);
#define PG8_SA(b, h) (((b) * 2 + (h)) * HTB)
#define PG8_SB(b, h) ((4 + (b) * 2 + (h)) * HTB)
#define PG8_STG(bufoff, gbase, o0, o1) do { \
        __builtin_amdgcn_global_load_lds((const unsigned*)((const char*)(gbase) + (o0)), (LAS unsigned*)(lds + (bufoff) + ldsw), 16, 0, 0); \
        __builtin_amdgcn_global_load_lds((const unsigned*)((const char*)(gbase) + (o1)), (LAS unsigned*)(lds + (bufoff) + ldsw + 8192), 16, 0, 0); } while (0)
#define PG8_STGB(bufoff, gbase) PG8_STG(bufoff, gbase, voffB[0], voffB[1])
#define PG8_STGA_CUR(bufoff, gbase, h) PG8_STG(bufoff, (gbase) + (h) * hstepA, GATHER ? gvc[h][0] : voffA[0], GATHER ? gvc[h][1] : voffA[1])
#define PG8_STGA_SEL(bufoff, gbase, h) PG8_STG(bufoff, (gbase) + (h) * hstepA, GATHER ? gvs[h][0] : voffA[0], GATHER ? gvs[h][1] : voffA[1])
#define PG8_LDA(dst, b, h) do { _Pragma("unroll") for (int m = 0; m < 4; ++m) _Pragma("unroll") for (int k = 0; k < 2; ++k) dst[m][k] = *(const LAS bf16x8*)(lds + PG8_SA(b, h) + aoff + m * 2048 + k * 1024); } while (0)
#define PG8_LDB(dst, b, h) do { _Pragma("unroll") for (int n = 0; n < 2; ++n) _Pragma("unroll") for (int k = 0; k < 2; ++k) dst[n][k] = *(const LAS bf16x8*)(lds + PG8_SB(b, h) + boff + n * 2048 + k * 1024); } while (0)
#define PG8_MMA(ai, bj, At, Bt) do { __builtin_amdgcn_s_setprio(1); _Pragma("unroll") for (int m = 0; m < 4; ++m) _Pragma("unroll") for (int n = 0; n < 2; ++n) _Pragma("unroll") for (int k = 0; k < 2; ++k) \
        acc[ai][bj][m][n] = __builtin_amdgcn_mfma_f32_16x16x32_bf16(Bt[n][k], At[m][k], acc[ai][bj][m][n], 0, 0, 0); __builtin_amdgcn_s_setprio(0); } while (0)
#define PG8_WAIT_V(n) asm volatile("s_waitcnt vmcnt(" #n ")" ::: "memory")
#define PG8_WAIT_L(n) asm volatile("s_waitcnt lgkmcnt(" #n ")" ::: "memory")
#define PG8_BAR __builtin_amdgcn_s_barrier()
#define PG8_SCHED __builtin_amdgcn_sched_barrier(0)
    Unit cur, nxt; int ui = 0;
    if (!S.next(0, cur)) return;
    f32x4 acc[2][2][4][2];
#pragma unroll
    for (int a = 0; a < 2; ++a)
#pragma unroll
        for (int b = 0; b < 2; ++b)
#pragma unroll
            for (int m = 0; m < 4; ++m)
#pragma unroll
                for (int n = 0; n < 2; ++n) acc[a][b][m][n] = (f32x4){0.f, 0.f, 0.f, 0.f};
    bf16x8 At[4][2], B0[2][2], B1[2][2];
    unsigned gvc[2][2], gvn[2][2], gvs[2][2];
    const char* cA = S.a_base(cur); const char* cB = S.b_base(cur);
    long cJ = 0;
    if constexpr (BJUMP) cJ = S.b_jump(cur);
    if constexpr (GATHER) { S.a_voff(cur, Rr[0], Rr[1], Cc[0], Cc[1], gvc); }
    else { gvc[0][0] = gvc[0][1] = gvc[1][0] = gvc[1][1] = 0u; }
    PG8_STGB(PG8_SB(0, 0), cB); PG8_STGB(PG8_SB(0, 1), cB + hstepB); PG8_STGA_CUR(PG8_SA(0, 0), cA, 0); PG8_STGA_CUR(PG8_SA(0, 1), cA, 1);
    if (wr == 1) PG8_BAR;
    PG8_WAIT_V(2); PG8_BAR;
    PG8_STGB(PG8_SB(1, 0), cB + kstep); PG8_STGA_CUR(PG8_SA(1, 0), cA + kstep, 0); PG8_STGB(PG8_SB(1, 1), cB + hstepB + kstep);
    PG8_WAIT_V(6); PG8_BAR;
    for (;;) {
        const bool has_next = S.next(ui + 1, nxt);
        const char* nA = has_next ? S.a_base(nxt) : cA; const char* nB = has_next ? S.b_base(nxt) : cB;
        if constexpr (GATHER) { if (has_next) S.a_voff(nxt, Rr[0], Rr[1], Cc[0], Cc[1], gvn); else { gvn[0][0] = gvc[0][0]; gvn[0][1] = gvc[0][1]; gvn[1][0] = gvc[1][0]; gvn[1][1] = gvc[1][1]; } }
        for (int t = 0; t < nt; t += 2) {
            const bool last = (t == nt - 2);
            const char* a1 = cA + (size_t)(t + 1) * kstep;
            const char* a2 = last ? nA : cA + (size_t)(t + 2) * kstep;
            const char* b2 = last ? nB : cB + (size_t)(t + 2) * kstep + ((BJUMP && (t + 2) >= 8) ? cJ : 0);
            const char* a3 = a2 + kstep; const char* b3 = b2 + kstep;
            if constexpr (GATHER) {
#pragma unroll
                for (int h = 0; h < 2; ++h)
#pragma unroll
                    for (int i = 0; i < 2; ++i) gvs[h][i] = last ? gvn[h][i] : gvc[h][i];
            }
            PG8_LDB(B0, 0, 0); PG8_LDB(B1, 0, 1); PG8_SCHED; PG8_LDA(At, 0, 0); PG8_STGA_CUR(PG8_SA(1, 1), a1, 1);
            PG8_WAIT_V(8); PG8_WAIT_L(0); PG8_BAR; PG8_MMA(0, 0, At, B0); PG8_MMA(0, 1, At, B1); PG8_BAR; PG8_SCHED;
            PG8_LDA(At, 0, 1); PG8_STGB(PG8_SB(0, 0), b2); PG8_STGB(PG8_SB(0, 1), b2 + hstepB); PG8_STGA_SEL(PG8_SA(0, 0), a2, 0);
            PG8_WAIT_V(8); PG8_WAIT_L(0); PG8_BAR; PG8_MMA(1, 0, At, B0); PG8_MMA(1, 1, At, B1); PG8_BAR; PG8_SCHED;
            PG8_LDB(B0, 1, 0); PG8_LDB(B1, 1, 1); PG8_SCHED; PG8_LDA(At, 1, 0); PG8_STGA_SEL(PG8_SA(0, 1), a2, 1);
            PG8_WAIT_V(8); PG8_WAIT_L(0); PG8_BAR; PG8_MMA(0, 0, At, B0); PG8_MMA(0, 1, At, B1); PG8_BAR; PG8_SCHED;
            PG8_LDA(At, 1, 1); PG8_STGB(PG8_SB(1, 0), b3); PG8_STGB(PG8_SB(1, 1), b3 + hstepB); PG8_STGA_SEL(PG8_SA(1, 0), a3, 0);
            PG8_WAIT_V(8); PG8_WAIT_L(0); PG8_BAR; PG8_MMA(1, 0, At, B0); PG8_MMA(1, 1, At, B1); PG8_BAR; PG8_SCHED;
        }
        if constexpr (ALIGN_EPI) { if (wr == 0) PG8_BAR; }
        E(acc, cur, wr, wc, fr, fq);
        if (!has_next) break;
#pragma unroll
        for (int a = 0; a < 2; ++a)
#pragma unroll
            for (int b = 0; b < 2; ++b)
#pragma unroll
                for (int m = 0; m < 4; ++m)
#pragma unroll
                    for (int n = 0; n < 2; ++n) acc[a][b][m][n] = (f32x4){0.f, 0.f, 0.f, 0.f};
        cur = nxt; cA = nA; cB = nB; ++ui;
        if constexpr (BJUMP) cJ = S.b_jump(cur);
        if constexpr (GATHER) { gvc[0][0] = gvn[0][0]; gvc[0][1] = gvn[0][1]; gvc[1][0] = gvn[1][0]; gvc[1][1] = gvn[1][1]; }
        if constexpr (ALIGN_EPI) { if (wr == 1) PG8_BAR; }
    }
    PG8_WAIT_V(0);
    if constexpr (!ALIGN_EPI) { if (wr == 0) PG8_BAR; }
    PG8_BAR;
#undef PG8_SA
#undef PG8_SB
#undef PG8_STG
#undef PG8_STGB
#undef PG8_STGA_CUR
#undef PG8_STGA_SEL
#undef PG8_LDA
#undef PG8_LDB
#undef PG8_MMA
#undef PG8_WAIT_V
#undef PG8_WAIT_L
#undef PG8_BAR
#undef PG8_SCHED
}
}
constexpr int T = 16384, D = 1024, L = 4096, NB = 4;
constexpr int NWAVES = 8;
constexpr size_t MiB = 1u << 20;
constexpr int CW_BAR = 4096;
constexpr int CW_CLS0 = 8192, CW_CLS1 = 10240; constexpr int CW_CK = 14000;
constexpr size_t WS_SS1 = 64 * 1024;
constexpr size_t WS_SS0 = 128 * 1024;
constexpr size_t WS_SS2 = 192 * 1024;
constexpr size_t CTL_ZERO_BYTES = 1 * MiB;
constexpr size_t WS_TOK = 1 * MiB;
constexpr size_t WS_LIST = 2 * MiB;
constexpr size_t WS_TOKW = 3 * MiB + 512 * 1024;
constexpr size_t WS_TOKC = 3 * MiB + 640 * 1024;
constexpr size_t WS_RTW = 3 * MiB + 768 * 1024;
constexpr size_t WS_CNTWG = 3 * MiB + 704 * 1024;
constexpr size_t WS_ROPE = 4 * MiB;
constexpr size_t WS_S5T = 6 * MiB;
constexpr size_t WS_S5END = 1 * MiB;
constexpr size_t WS_LW = 7 * MiB;
constexpr size_t WS_SSP = 284 * MiB;
constexpr size_t WS_LSE = 11 * MiB;
constexpr size_t WS_WIN = 12 * MiB;
constexpr size_t WS_WOUT = 17 * MiB;
constexpr size_t WS_WGLU = 19 * MiB;
constexpr size_t WS_WQKV = 20 * MiB;
constexpr size_t WS_CWOUT = 26 * MiB;
constexpr size_t WS_WGU = 28 * MiB;
constexpr size_t WS_WD = 60 * MiB;
constexpr size_t WS_MOE_LAYER = 48 * MiB;
constexpr size_t WS_XB = 124 * MiB;
constexpr size_t WS_MG = 156 * MiB;
constexpr size_t WS_P = 188 * MiB;
constexpr size_t WS_END = 286 * MiB;

constexpr int RING_BYTES = 131072;
constexpr int LDSCTL_OFF = RING_BYTES, MISC_OFF = LDSCTL_OFF + 320;
constexpr int MOE_TB_OFF = LDSCTL_OFF + 512;
constexpr int LDS_BYTES = 147456;

#define RLX_AGENT __ATOMIC_RELAXED, __HIP_MEMORY_SCOPE_AGENT
#define LDS_WAIT() asm volatile("s_waitcnt lgkmcnt(0)" ::: "memory")
#define VM_WAIT() asm volatile("s_waitcnt vmcnt(0)" ::: "memory")

#define XB_TMO      128
#define XB_XCNT(j)  (256  + 64 * (j))
#define XB_XSUB(j)  (1280 + 64 * (j))
#define XB_XGEN(j)  (2304 + 64 * (j))
#define XB_TOP      3328
#define XB_TOPGEN   3392
#define XCD_BAR_WORDS 3456
#define XB_SPIN_CAP (1u << 18)
__device__ __forceinline__ unsigned xb_ld(unsigned* p)              { return __hip_atomic_load(p, __ATOMIC_RELAXED, __HIP_MEMORY_SCOPE_AGENT); }
__device__ __forceinline__ unsigned xb_add(unsigned* p, unsigned v) { return __hip_atomic_fetch_add(p, v, __ATOMIC_RELAXED, __HIP_MEMORY_SCOPE_AGENT); }
__device__ __forceinline__ unsigned xb_xcc_id() { return (unsigned)__builtin_amdgcn_s_getreg((3 << 11) | 20) & 0xFu; }
#define XB_SPIN(cond, bar) do { unsigned _sp = 0; while (cond) { __builtin_amdgcn_s_sleep(1); \
    if ((++_sp & 255u) == 0u) { if (xb_ld(&(bar)[XB_TMO])) break; if (_sp > XB_SPIN_CAP) { atomicAdd(&(bar)[XB_TMO], 1u); break; } } } } while (0)
struct XcdBarrier { unsigned* bar; unsigned x; volatile LAS unsigned* st; };
__device__ __forceinline__ XcdBarrier xcd_barrier_post(unsigned* bar, volatile LAS unsigned* st) {
    XcdBarrier b; b.bar = bar; b.x = xb_xcc_id(); b.st = st;
    if (threadIdx.x == 0) (void)xb_add(&bar[XB_XCNT(b.x)], 1u);
    return b;
}
__device__ __forceinline__ void xcd_barrier_complete(unsigned* bar, unsigned x, unsigned& nloc, unsigned& nx) {
    const unsigned G = gridDim.x * gridDim.y * gridDim.z;
    unsigned sum, cnt, mine, sp = 0u;
    for (;;) {
        sum = 0u; cnt = 0u; mine = 0u;
#pragma unroll
        for (unsigned j = 0; j < 16; ++j) { const unsigned c = xb_ld(&bar[XB_XCNT(j)]); sum += c; cnt += (c > 0u) ? 1u : 0u; mine = (j == x) ? c : mine; }
        if (sum == G) break;
        __builtin_amdgcn_s_sleep(1);
        if ((++sp & 255u) == 0u) { if (xb_ld(&bar[XB_TMO])) break; if (sp > XB_SPIN_CAP) { atomicAdd(&bar[XB_TMO], 1u); break; } }
    }
    nloc = mine > 0u ? mine : 1u; nx = cnt > 0u ? cnt : 1u;
}
__device__ __forceinline__ void xcd_barrier(const XcdBarrier& b) {
    asm volatile("s_waitcnt vmcnt(0)" ::: "memory");
    __syncthreads();
    if (threadIdx.x == 0) {
        unsigned* bar = b.bar;
        __builtin_amdgcn_s_waitcnt(0);
        unsigned nloc = b.st[0], nx = b.st[1];
        if (nloc == 0u) { xcd_barrier_complete(bar, b.x, nloc, nx); b.st[0] = nloc; b.st[1] = nx; }
        const unsigned old = xb_add(&bar[XB_XSUB(b.x)], 1u);
        const unsigned gen = old / nloc;
        if (old + 1u == (gen + 1u) * nloc) {
            __builtin_amdgcn_fence(__ATOMIC_RELEASE, "agent");
            asm volatile("s_waitcnt vmcnt(0)" ::: "memory");
            const unsigned og = xb_add(&bar[XB_TOP], 1u);
            const unsigned tg = og / nx;
            if (og + 1u == (tg + 1u) * nx) xb_add(&bar[XB_TOPGEN], 1u);
            else XB_SPIN(xb_ld(&bar[XB_TOPGEN]) == tg, bar);
            __builtin_amdgcn_fence(__ATOMIC_ACQUIRE, "agent");
            xb_add(&bar[XB_XGEN(b.x)], 1u);
            asm volatile("s_waitcnt vmcnt(0)" ::: "memory");
        } else {
            XB_SPIN(xb_ld(&bar[XB_XGEN(b.x)]) == gen, bar);
            __builtin_amdgcn_fence(__ATOMIC_ACQUIRE, "agent");
            asm volatile("s_waitcnt vmcnt(0)" ::: "memory");
        }
    }
    __syncthreads();
}

struct PlainOrder {
    const char* A; const char* Bt; int lda, ldb; int nM, nN, nwg, G, c;
    __device__ void init(const void* A_, const void* Bt_, int lda_, int ldb_, int M, int N, int G_, int c_) { A = (const char*)A_; Bt = (const char*)Bt_; lda = lda_; ldb = ldb_; nM = M / 256; nN = N / 256; nwg = nM * nN; G = G_; c = c_; }
    __device__ bool next(int i, pg8::Unit& u) const {
        const long Lx = (long)i * G + c; if (Lx >= nwg) return false;
        int wgid = (int)Lx; { const int q = nwg / 8, r = nwg % 8, xcd = wgid % 8, off = wgid / 8; wgid = (xcd < r ? xcd * (q + 1) : r * (q + 1) + (xcd - r) * q) + off; }
        const int nig = 8 * nN, gid = wgid / nig, fm = gid * 8, gsz = (nM - fm) < 8 ? (nM - fm) : 8;
        u.pm = fm + ((wgid % nig) % gsz); u.pn = (wgid % nig) / gsz; u.cls = 0; u.nvalid = 256; return true;
    }
    __device__ __forceinline__ const char* a_base(const pg8::Unit& u) const { return A + (size_t)u.pm * 256 * lda * 2; }
    __device__ __forceinline__ const char* b_base(const pg8::Unit& u) const { return Bt + (size_t)u.pn * 256 * ldb * 2; }
    __device__ __forceinline__ long b_jump(const pg8::Unit&) const { return 0; }
    __device__ __forceinline__ void a_voff(const pg8::Unit&, int, int, int, int, unsigned (&)[2][2]) const {}
};

using pg8::Unit; using pg8::cvt_pk_bf16; using pg8::cvt_pk_bf16_c;
constexpr float RMS_EPS = 1e-6f;
struct EpiInProj {
    static constexpr bool PERM = true;
    bf16_t* P; const float* ss; const float* rope;
    __device__ __forceinline__ void operator()(const f32x4 (&acc)[2][2][4][2], const Unit& u, int wr, int wc, int fr, int fq) const {
        const int row0 = u.pm * 256 + wr * 64 + fr; const int tile = u.pn;
        float ssv[8];
#pragma unroll
        for (int it = 0; it < 8; ++it) ssv[it] = ss[row0 + (it >> 2) * 128 + (it & 3) * 16];
#pragma unroll
        for (int ai = 0; ai < 2; ++ai)
#pragma unroll
            for (int m = 0; m < 4; ++m) {
                const int row = row0 + ai * 128 + m * 16;
                const float rstd = rsqrtf(ssv[ai * 4 + m] * (1.0f / D) + RMS_EPS);
                bf16_t* rowp = P + (size_t)row * 2560 + tile * 256;
#pragma unroll
                for (int bj = 0; bj < 2; ++bj) {
                    const int cb = bj * 128 + wc * 32 + 8 * fq;
                    f32x4 v0 = acc[ai][bj][m][0] * rstd, v1 = acc[ai][bj][m][1] * rstd;
                    if (tile < 4) {
                        const int i4 = (cb & 127) >> 1;
                        const int pos = row & (L - 1);
                        const f32x4 cs = *(const f32x4*)(rope + (size_t)pos * 64 + i4), sn = *(const f32x4*)(rope + (size_t)L * 64 + (size_t)pos * 64 + i4);
                        f32x4 o1 = v0 * cs - v1 * sn, o2 = v0 * sn + v1 * cs;
                        if (tile >= 2) { o1 = o1 * 0.08838834764831845f; o2 = o2 * 0.08838834764831845f; }
                        u32x2 w1, w2; w1.x = cvt_pk_bf16(o1[0], o1[1]); w1.y = cvt_pk_bf16(o1[2], o1[3]); w2.x = cvt_pk_bf16(o2[0], o2[1]); w2.y = cvt_pk_bf16(o2[2], o2[3]);
                        const auto sx = __builtin_amdgcn_permlane16_swap(w1.x, w2.x, false, false);
                        const auto sy = __builtin_amdgcn_permlane16_swap(w1.y, w2.y, false, false);
                        u32x4 wv; wv.x = sx[0]; wv.y = sy[0]; wv.z = sx[1]; wv.w = sy[1];
                        bf16_t* hp = rowp + (cb & 128) + wc * 16 + 4 * (fq & 2) + (fq & 1) * 64;
                        *(u32x4*)hp = wv;
                    } else {
                        if (tile == 6 || tile == 7) {
#pragma unroll
                            for (int e = 0; e < 4; ++e) { v0[e] = v0[e] * fast_sigmoid(v0[e]); v1[e] = v1[e] * fast_sigmoid(v1[e]); }
                        }
                        u32x4 w; w.x = cvt_pk_bf16(v0[0], v0[1]); w.y = cvt_pk_bf16(v0[2], v0[3]); w.z = cvt_pk_bf16(v1[0], v1[1]); w.w = cvt_pk_bf16(v1[2], v1[3]);
                        *(u32x4*)(rowp + cb) = w;
                    }
                }
            }
    }
};

struct EpiQKV {
    static constexpr bool PERM = true;
    bf16_t* P; const float* ss; float qscale;
    __device__ __forceinline__ void operator()(const f32x4 (&acc)[2][2][4][2], const Unit& u, int wr, int wc, int fr, int fq) const {
        const int row0 = u.pm * 256 + wr * 64 + fr;
        const float sc = (u.pn < 4) ? qscale : 1.0f;
#pragma unroll
        for (int ai = 0; ai < 2; ++ai)
#pragma unroll
            for (int m = 0; m < 4; ++m) {
                const int row = row0 + ai * 128 + m * 16;
                const f32x4* sp = (const f32x4*)(ss + (size_t)row * 32);
                const f32x4 s4 = (sp[0] + sp[1]) + (sp[2] + sp[3]);
                const float rstd = rsqrtf(((s4[0] + s4[1]) + (s4[2] + s4[3])) * (1.0f / D) + RMS_EPS) * sc;
                bf16_t* rowp = P + (size_t)row * 3072 + u.pn * 256 + wc * 32 + 8 * fq;
#pragma unroll
                for (int bj = 0; bj < 2; ++bj) {
                    const f32x4 v0 = acc[ai][bj][m][0] * rstd, v1 = acc[ai][bj][m][1] * rstd;
                    u32x4 w; w.x = cvt_pk_bf16(v0[0], v0[1]); w.y = cvt_pk_bf16(v0[2], v0[3]); w.z = cvt_pk_bf16(v1[0], v1[1]); w.w = cvt_pk_bf16(v1[2], v1[3]);
                    *(u32x4*)(rowp + bj * 128) = w;
                }
            }
    }
};
template <bool RF32>
struct EpiOutRes {
    static constexpr bool PERM = true;
    const float* residf; const bf16_t* residb; bf16_t* Hout;
    __device__ __forceinline__ void operator()(const f32x4 (&acc)[2][2][4][2], const Unit& u, int wr, int wc, int fr, int fq) const {
        const int row0 = u.pm * 256 + wr * 64 + fr;
#pragma unroll
        for (int ai = 0; ai < 2; ++ai)
#pragma unroll
            for (int m = 0; m < 4; ++m) {
                const size_t off = (size_t)(row0 + ai * 128 + m * 16) * D + u.pn * 256 + wc * 32 + 8 * fq;
#pragma unroll
                for (int bj = 0; bj < 2; ++bj) {
                    f32x4 r0, r1;
                    if (RF32) { r0 = *(const f32x4*)(residf + off + bj * 128); r1 = *(const f32x4*)(residf + off + bj * 128 + 4); }
                    else { const u32x4 q = *(const u32x4*)(residb + off + bj * 128); r0 = (f32x4){bflo(q.x), bfhi(q.x), bflo(q.y), bfhi(q.y)}; r1 = (f32x4){bflo(q.z), bfhi(q.z), bflo(q.w), bfhi(q.w)}; }
                    const f32x4 o0 = r0 + acc[ai][bj][m][0], o1 = r1 + acc[ai][bj][m][1];
                    u32x4 w; w.x = cvt_pk_bf16(o0[0], o0[1]); w.y = cvt_pk_bf16(o0[2], o0[3]); w.z = cvt_pk_bf16(o1[0], o1[1]); w.w = cvt_pk_bf16(o1[2], o1[3]);
                    *(u32x4*)(Hout + off + bj * 128) = w;
                }
            }
    }
};

__device__ __forceinline__ void cls_decode(int cls, int& g, int& lo, int& hi) { g = cls / 6; const int p = cls - 6 * g; lo = p < 3 ? 0 : (p < 5 ? 1 : 2); hi = p < 3 ? p + 1 : (p < 5 ? p - 1 : 3); }
struct MoeOrder {
    const char* A; const char* Bt; const int* list; const LAS int* tb; const LAS int* cc; int NPN, G, c, down, lo, hi;
    __device__ bool next(int i, pg8::Unit& u) const {
        const int idx = lo + i * G + c; if (c < 0 || idx >= hi) return false;
        const int ct = idx / NPN; int k = 0;
#pragma unroll 1
        for (int j = 1; j < 24; ++j) if (ct >= tb[j]) k = j;
        u.pm = ct; u.pn = idx - ct * NPN; u.cls = k; const int rem = cc[k] - (ct - tb[k]) * 256; u.nvalid = rem < 256 ? rem : 256; return true;
    }
    __device__ __forceinline__ const char* a_base(const pg8::Unit& u) const { return down ? A + (size_t)u.pm * 256 * 1024 * 2 : A; }
    __device__ __forceinline__ const char* b_base(const pg8::Unit& u) const {
        int g, lo, hi; cls_decode(u.cls, g, lo, hi);
        if (down) return Bt + ((size_t)(g * 1024 + u.pn * 256) * 2048 + lo * 512) * 2;
        const int e = u.pn < 4 ? lo : hi; return Bt + ((size_t)((g * 4 + e) * 1024 + (u.pn & 3) * 256) * 1024) * 2;
    }
    __device__ __forceinline__ long b_jump(const pg8::Unit& u) const { int g, lo, hi; cls_decode(u.cls, g, lo, hi); return (long)(hi - lo - 1) * 1024; }
    __device__ __forceinline__ void a_voff(const pg8::Unit& u, int R0, int R1, int C0, int C1, unsigned (&v)[2][2]) const {
        const int* lp = list + u.cls * 16384 + (u.pm - tb[u.cls]) * 256;
#pragma unroll
        for (int h = 0; h < 2; ++h) {
            const int r0 = h * 128 + R0, r1 = h * 128 + R1;
            const int t0 = lp[r0 < u.nvalid ? r0 : 0], t1 = lp[r1 < u.nvalid ? r1 : 0];
            v[h][0] = (unsigned)t0 * 2048u + (unsigned)C0 * 2u; v[h][1] = (unsigned)t1 * 2048u + (unsigned)C1 * 2u;
        }
    }
};
struct EpiGateUp {
    static constexpr bool PERM = true;
    bf16_t* HC; const f32x2* lw; const LAS int* tb;
    __device__ __forceinline__ void operator()(const f32x4 (&acc)[2][2][4][2], const Unit& u, int wr, int wc, int fr, int fq) const {
        const int slot = u.pn >> 2;
        const f32x2* lwp = lw + u.cls * 16384 + (u.pm - tb[u.cls]) * 256;
        f32x2 w2v[8];
#pragma unroll
        for (int it = 0; it < 8; ++it) { const int rl = wr * 64 + fr + (it >> 2) * 128 + (it & 3) * 16; w2v[it] = lwp[rl < u.nvalid ? rl : 0]; }
#pragma unroll
        for (int ai = 0; ai < 2; ++ai)
#pragma unroll
            for (int m = 0; m < 4; ++m) {
                const int rl = wr * 64 + fr + ai * 128 + m * 16;
                const f32x2 w2 = w2v[ai * 4 + m]; const unsigned wb = __float_as_uint(w2.x); const float w = slot ? bfhi(wb) : bflo(wb), rs = w2.y;
                u32x2 o[2];
#pragma unroll
                for (int bj = 0; bj < 2; ++bj) {
                    const f32x4 v0 = acc[ai][bj][m][0] * rs, v1 = acc[ai][bj][m][1] * rs;
                    const float h0 = v0[0] * fast_sigmoid(v0[0]) * v0[1] * w, h1 = v0[2] * fast_sigmoid(v0[2]) * v0[3] * w;
                    const float h2 = v1[0] * fast_sigmoid(v1[0]) * v1[1] * w, h3 = v1[2] * fast_sigmoid(v1[2]) * v1[3] * w;
                    o[bj].x = cvt_pk_bf16(h0, h1); o[bj].y = cvt_pk_bf16(h2, h3);
                }
                const auto sx = __builtin_amdgcn_permlane16_swap(o[0].x, o[1].x, false, false);
                const auto sy = __builtin_amdgcn_permlane16_swap(o[0].y, o[1].y, false, false);
                u32x4 wv; wv.x = sx[0]; wv.y = sy[0]; wv.z = sx[1]; wv.w = sy[1];
                bf16_t* rowp = HC + (size_t)(u.pm * 256 + rl) * 1024 + slot * 512 + (u.pn & 3) * 128 + wc * 16 + 4 * (fq & 2) + (fq & 1) * 64;
                if (rl < u.nvalid) *(u32x4*)rowp = wv;
            }
    }
};

struct EpiDown {
    static constexpr bool PERM = true;
    const bf16_t* Hin; bf16_t* Hout; float* ss; const int* list; const LAS int* tb;
    __device__ __forceinline__ void operator()(const f32x4 (&acc)[2][2][4][2], const Unit& u, int wr, int wc, int fr, int fq) const {
        const int* lp = list + u.cls * 16384 + (u.pm - tb[u.cls]) * 256;
        int tokv[8];
#pragma unroll
        for (int it = 0; it < 8; ++it) { const int rl = wr * 64 + fr + (it >> 2) * 128 + (it & 3) * 16; tokv[it] = lp[rl < u.nvalid ? rl : 0]; }
#pragma unroll
        for (int ai = 0; ai < 2; ++ai) {
            u32x4 q[4][2];
#pragma unroll
            for (int m = 0; m < 4; ++m) { const size_t off = (size_t)tokv[ai * 4 + m] * D + u.pn * 256 + wc * 32 + 8 * fq;
                q[m][0] = *(const u32x4*)(Hin + off); q[m][1] = *(const u32x4*)(Hin + off + 128); }
#pragma unroll
            for (int m = 0; m < 4; ++m) {
                const int rl = wr * 64 + fr + ai * 128 + m * 16;
                const bool ok = rl < u.nvalid;
                const int tok = tokv[ai * 4 + m];
                const size_t off = (size_t)tok * D + u.pn * 256 + wc * 32 + 8 * fq;
                float sq = 0.f;
#pragma unroll
                for (int bj = 0; bj < 2; ++bj) {
                    const u32x4 qq = q[m][bj];
                    const f32x4 o0 = (f32x4){bflo(qq.x), bfhi(qq.x), bflo(qq.y), bfhi(qq.y)} + acc[ai][bj][m][0], o1 = (f32x4){bflo(qq.z), bfhi(qq.z), bflo(qq.w), bfhi(qq.w)} + acc[ai][bj][m][1];
                    sq += (o0[0] * o0[0] + o0[1] * o0[1]) + (o0[2] * o0[2] + o0[3] * o0[3]) + (o1[0] * o1[0] + o1[1] * o1[1]) + (o1[2] * o1[2] + o1[3] * o1[3]);
                    u32x4 w; w.x = cvt_pk_bf16(o0[0], o0[1]); w.y = cvt_pk_bf16(o0[2], o0[3]); w.z = cvt_pk_bf16(o1[0], o1[1]); w.w = cvt_pk_bf16(o1[2], o1[3]);
                    if (ok) *(u32x4*)(Hout + off + bj * 128) = w;
                }
                sq += __shfl_xor(sq, 16); sq += __shfl_xor(sq, 32);
                if (ok && fq == 0) __hip_atomic_store(ss + (size_t)tok * 32 + u.pn * 4 + wc, sq, RLX_AGENT);
            }
        }
    }
};

struct Frame {
    LAS unsigned char* lds;
    volatile LAS unsigned* MISC;
    unsigned* ctl;
    int tid, lane, wave, vcu, G;
};

template <int ROWMODE>
__device__ __forceinline__ int tr_rowmap(int n, int row_off) {
    if (ROWMODE == 0) return row_off + n;
    if (ROWMODE == 1) { if (n >= 1024) return n; const int hb = n >> 7, jj = n & 127; return (hb << 7) + (jj < 64 ? 8 * (jj >> 2) + (jj & 3) : 8 * ((jj - 64) >> 2) + 4 + (jj & 3)); }
    if (ROWMODE == 2) return row_off + 2 * n;
    return row_off + 2 * n + 1;
}
template <int ROWMODE>
__device__ __forceinline__ void tr_item(const float* W, int N, bf16_t* WT, int ldt, int koff, int row_off, const float* gain, LAS float* scr, int item, int lane) {
    const int nblk = N / 32, kb = item / nblk, nb = item % nblk, k0 = 64 * kb, n0 = 32 * nb;
    float tv[32];
#pragma unroll
    for (int i = 0; i < 32; ++i) tv[i] = W[(size_t)(k0 + 2 * i + (lane >> 5)) * N + n0 + (lane & 31)];
#pragma unroll
    for (int i = 0; i < 32; ++i) { const int kk = 2 * i + (lane >> 5); float v = tv[i]; if (gain) v *= gain[k0 + kk]; scr[kk * 33 + (lane & 31)] = v; }
    LDS_WAIT(); asm volatile("" ::: "memory");
    const int c = lane & 7;
#pragma unroll
    for (int j = 0; j < 4; ++j) { const int n = (lane >> 3) + 8 * j; const LAS float* s = scr + (8 * c) * 33 + n;
        u32x4 o; o.x = pk2(s[0 * 33], s[1 * 33]); o.y = pk2(s[2 * 33], s[3 * 33]); o.z = pk2(s[4 * 33], s[5 * 33]); o.w = pk2(s[6 * 33], s[7 * 33]);
        *(u32x4*)(WT + (size_t)tr_rowmap<ROWMODE>(n0 + n, row_off) * ldt + koff + k0 + 8 * c) = o; }
    LDS_WAIT(); asm volatile("" ::: "memory");
}
typedef short v4i16_t __attribute__((ext_vector_type(4)));
__device__ __forceinline__ s16x4 ds_tr16(unsigned addr) { return __builtin_bit_cast(s16x4, __builtin_amdgcn_ds_read_tr16_b64_v4i16((LAS v4i16_t*)(uintptr_t)addr)); }

__device__ __forceinline__ void attn_load_half(const bf16_t* __restrict__ P, int b, int h, int r, int blk, int dil, int tid, u32x4* kreg, u32x4* vreg) {
#pragma unroll
    for (int i = 0; i < 4; ++i) {
        const int id = tid + 512 * i, row = id >> 4, ch = id & 15;
        const size_t grow = (size_t)b * L + r + (size_t)dil * (128 * blk + row);
        const bf16_t* src = P + grow * 3072 + 1024 + h * 128 + ch * 8;
        kreg[i] = *(const u32x4*)src; vreg[i] = *(const u32x4*)(src + 1024);
    }
}
__device__ __forceinline__ void attn_store_half(LAS unsigned char* lds, int tid, int slot, const u32x4* kreg, const u32x4* vreg) {
#pragma unroll
    for (int i = 0; i < 4; ++i) {
        const int id = tid + 512 * i, row = slot * 128 + (id >> 4), ch = id & 15;
        const int off = row * 256 + ((ch ^ (row & 15)) << 4);
        *(LAS u32x4*)(lds + off) = kreg[i]; *(LAS u32x4*)(lds + 65536 + off) = vreg[i];
    }
}
__device__ __forceinline__ void attn_load(const bf16_t* __restrict__ P, int b, int h, int r, int n, int dil, int tid, bool full, u32x4 (&kreg)[8], u32x4 (&vreg)[8]) {
    if (full) attn_load_half(P, b, h, r, n > 0 ? n - 1 : 0, dil, tid, kreg, vreg);
    attn_load_half(P, b, h, r, n, dil, tid, kreg + 4, vreg + 4);
}
__device__ __forceinline__ void attn_store(LAS unsigned char* lds, int tid, int n, bool full, const u32x4 (&kreg)[8], const u32x4 (&vreg)[8]) {
    if (full) attn_store_half(lds, tid, (n - 1) & 1, kreg, vreg);
    attn_store_half(lds, tid, n & 1, kreg + 4, vreg + 4);
}
__device__ __forceinline__ void attn_loadq(const bf16_t* __restrict__ P, int b, int h, int r, int n, int dil, int tid, bf16x8 (&qf)[4]) {
    const int lane = tid & 63, w = __builtin_amdgcn_readfirstlane(tid >> 6), fr = lane & 15, fq = lane >> 4;
    const size_t qrow = (size_t)b * L + r + (size_t)dil * (128 * n + 16 * w + fr);
#pragma unroll
    for (int ks = 0; ks < 4; ++ks) qf[ks] = *(const bf16x8*)(P + qrow * 3072 + h * 128 + 32 * ks + 8 * fq);
}
template <bool MERGE>
__device__ __forceinline__ void attn_compute(LAS unsigned char* lds, const bf16_t* __restrict__ P, bf16_t* O, float* lse_out, const bf16_t* OA, const bf16_t* OB, const float* lseA, const float* lseB,
                                             int b, int h, int r, int n, int dil, int tid, const bf16x8 (&qf)[4]) {
    const int lane = tid & 63, w = __builtin_amdgcn_readfirstlane(tid >> 6), fr = lane & 15, fq = lane >> 4;
    const size_t qrow = (size_t)b * L + r + (size_t)dil * (128 * n + 16 * w + fr);
    float m = -1e30f, lsum = 0.f;
    f32x4 ot[8];
#pragma unroll
    for (int dt = 0; dt < 8; ++dt) ot[dt] = (f32x4){0.f, 0.f, 0.f, 0.f};
    const float NEG = -__builtin_inff();
    const int pxor = ((n - 1) & 1) << 7;
    const unsigned ldsb = (unsigned)(uintptr_t)lds;
#pragma unroll
    for (int g = 0; g < 5; ++g) {
        const int tixA = w + 2 * g, tixB = tixA + 1;
        f32x4 sA = (f32x4){0.f, 0.f, 0.f, 0.f}, sB = (f32x4){0.f, 0.f, 0.f, 0.f};
        {
            const int rowA = (16 * tixA + fr) ^ pxor;
#pragma unroll
            for (int ks = 0; ks < 4; ++ks) {
                const bf16x8 kf = *(const LAS bf16x8*)(lds + rowA * 256 + (((4 * ks + fq) ^ (rowA & 15)) << 4));
                sA = __builtin_amdgcn_mfma_f32_16x16x32_bf16(kf, qf[ks], sA, 0, 0, 0);
            }
        }
        if (g < 4) {
            const int rowB = (16 * tixB + fr) ^ pxor;
#pragma unroll
            for (int ks = 0; ks < 4; ++ks) {
                const bf16x8 kf = *(const LAS bf16x8*)(lds + rowB * 256 + (((4 * ks + fq) ^ (rowB & 15)) << 4));
                sB = __builtin_amdgcn_mfma_f32_16x16x32_bf16(kf, qf[ks], sB, 0, 0, 0);
            }
        }
        const bool invA = (n == 0 && tixA < 8), invB = (g == 4) || (n == 0 && tixB < 8);
#pragma unroll
        for (int e = 0; e < 4; ++e) {
            bool okA = !invA, okB = !invB;
            if (g == 0) okA = okA && (4 * fq + e >= fr);
            if (g == 4) okA = okA && (4 * fq + e <= fr);
            if (!okA) sA[e] = NEG;
            if (!okB) sB[e] = NEG;
        }
        float mx = fmaxf(fmaxf(fmaxf(sA[0], sA[1]), fmaxf(sA[2], sA[3])), fmaxf(fmaxf(sB[0], sB[1]), fmaxf(sB[2], sB[3])));
        mx = fmaxf(mx, __shfl_xor(mx, 16)); mx = fmaxf(mx, __shfl_xor(mx, 32));
        const float mn = fmaxf(m, mx);
        const float alpha = __builtin_amdgcn_exp2f(m - mn);
        m = mn;
        float ps = 0.f;
#pragma unroll
        for (int e = 0; e < 4; ++e) { sA[e] = __builtin_amdgcn_exp2f(sA[e] - mn); sB[e] = __builtin_amdgcn_exp2f(sB[e] - mn); ps += sA[e] + sB[e]; }
        lsum = lsum * alpha + ps;
        u32x4 pw; pw.x = cvt_pk_bf16_c(sA[0], sA[1]); pw.y = cvt_pk_bf16_c(sA[2], sA[3]); pw.z = cvt_pk_bf16_c(sB[0], sB[1]); pw.w = cvt_pk_bf16_c(sB[2], sB[3]);
        const bf16x8 pf = __builtin_bit_cast(bf16x8, pw);
        const int qp = fr >> 2, pp = fr & 3;
        const int vrowA = (16 * tixA + 4 * fq + qp) ^ pxor, vrowB = (g < 4) ? ((16 * tixB + 4 * fq + qp) ^ pxor) : vrowA;
#pragma unroll
        for (int dt = 0; dt < 8; ++dt) {
            const unsigned aA = ldsb + 65536u + (unsigned)(vrowA * 256 + (((2 * dt + (pp >> 1)) ^ (vrowA & 15)) << 4) + (pp & 1) * 8);
            const unsigned aB = ldsb + 65536u + (unsigned)(vrowB * 256 + (((2 * dt + (pp >> 1)) ^ (vrowB & 15)) << 4) + (pp & 1) * 8);
            const s16x4 lo = ds_tr16(aA), hi = ds_tr16(aB);
            const bf16x8 vf = (bf16x8){lo[0], lo[1], lo[2], lo[3], hi[0], hi[1], hi[2], hi[3]};
            ot[dt] = ot[dt] * alpha;
            ot[dt] = __builtin_amdgcn_mfma_f32_16x16x32_bf16(vf, pf, ot[dt], 0, 0, 0);
        }
    }
    float lt = lsum; lt += __shfl_xor(lt, 16); lt += __shfl_xor(lt, 32);
    const float inv = 1.0f / lt;
    const float lse2 = m + __builtin_amdgcn_logf(lt);
    if (!MERGE) {
        if (fq == 0) lse_out[(size_t)((b * 8 + h) * dil + r) * (L / dil) + 128 * n + 16 * w + fr] = lse2;
#pragma unroll
        for (int dp = 0; dp < 4; ++dp) {
            u32x2 o[2];
#pragma unroll
            for (int q = 0; q < 2; ++q) { const int dt = 2 * dp + q; o[q].x = cvt_pk_bf16(ot[dt][0] * inv, ot[dt][1] * inv); o[q].y = cvt_pk_bf16(ot[dt][2] * inv, ot[dt][3] * inv); }
            const auto sx = __builtin_amdgcn_permlane16_swap(o[0].x, o[1].x, false, false);
            const auto sy = __builtin_amdgcn_permlane16_swap(o[0].y, o[1].y, false, false);
            u32x4 wv; wv.x = sx[0]; wv.y = sy[0]; wv.z = sx[1]; wv.w = sy[1];
            *(u32x4*)(O + qrow * D + h * 128 + 16 * (2 * dp + (fq & 1)) + 4 * (fq & 2)) = wv; }
    } else {
        const int pos = r + dil * (128 * n + 16 * w + fr);
        const float la = lseA[(size_t)(b * 8 + h) * L + pos], lb = lseB[(size_t)((b * 8 + h) * 4 + (pos & 3)) * (L / 4) + (pos >> 2)];
        const float M = fmaxf(fmaxf(la, lb), lse2);
        float wa = __builtin_amdgcn_exp2f(la - M), wb = __builtin_amdgcn_exp2f(lb - M), wc = __builtin_amdgcn_exp2f(lse2 - M);
        const float iw = 1.0f / (wa + wb + wc); wa *= iw; wb *= iw; wc *= iw * inv;
#pragma unroll
        for (int dt = 0; dt < 8; ++dt) {
            const size_t off = qrow * D + h * 128 + 16 * dt + 4 * fq;
            const u32x2 a = *(const u32x2*)(OA + off), bb = *(const u32x2*)(OB + off);
            const float r0 = wa * bflo(a.x) + wb * bflo(bb.x) + wc * ot[dt][0], r1 = wa * bfhi(a.x) + wb * bfhi(bb.x) + wc * ot[dt][1];
            const float r2 = wa * bflo(a.y) + wb * bflo(bb.y) + wc * ot[dt][2], r3 = wa * bfhi(a.y) + wb * bfhi(bb.y) + wc * ot[dt][3];
            u32x2 o; o.x = cvt_pk_bf16(r0, r1); o.y = cvt_pk_bf16(r2, r3);
            *(u32x2*)(O + off) = o;
        }
    }
}
__device__ __forceinline__ u32x4 scale_bf16x8(u32x4 v, float z) {
    u32x4 o; o.x = cvt_pk_bf16(bflo(v.x) * z, bfhi(v.x) * z); o.y = cvt_pk_bf16(bflo(v.y) * z, bfhi(v.y) * z);
    o.z = cvt_pk_bf16(bflo(v.z) * z, bfhi(v.z) * z); o.w = cvt_pk_bf16(bflo(v.w) * z, bfhi(v.w) * z); return o;
}
__device__ __forceinline__ int swz_tr(int row, int ch) { return row * 256 + ((ch ^ ((row & 3) << 2)) << 4); }
__device__ __forceinline__ int swz_row(int row, int ch) { return row * 256 + ((ch ^ (row & 15)) << 4); }

__device__ __forceinline__ void ret_kv_unit(LAS unsigned char* lds, const bf16_t* __restrict__ P, bf16_t* KVT, int b, int h, int N, int tid) {
    const int lane = tid & 63, w = __builtin_amdgcn_readfirstlane(tid >> 6);
    const float lg2 = log2f(1.0f - exp2f(-5.0f - (float)h));
    {
        u32x4 kreg[8], vreg[8];
#pragma unroll
        for (int i = 0; i < 8; ++i) {
            const int id = tid + 512 * i, row = id >> 4, ch = id & 15;
            const bf16_t* src = P + ((size_t)b * L + 256 * N + row) * 2560 + 512 + h * 128 + ch * 8;
            kreg[i] = *(const u32x4*)src; vreg[i] = *(const u32x4*)(src + 512);
        }
#pragma unroll
        for (int i = 0; i < 8; ++i) {
            const int id = tid + 512 * i, row = id >> 4, ch = id & 15;
            const int off = swz_tr(row, ch);
            *(LAS u32x4*)(lds + off) = kreg[i];
            *(LAS u32x4*)(lds + 65536 + off) = scale_bf16x8(vreg[i], exp2f((float)(255 - row) * lg2));
        }
    }
    __syncthreads();
    const int dkt = w >> 1, dvt0 = 2 * (w & 1);
    const int gq = lane >> 4, hi = gq >> 1, qp = (lane & 15) >> 2, pp = lane & 3;
    const unsigned ldsb = (unsigned)(uintptr_t)lds;
    f32x16 acc[2];
#pragma unroll
    for (int t = 0; t < 2; ++t)
#pragma unroll
        for (int r = 0; r < 16; ++r) acc[t][r] = 0.f;
    const int chA = 4 * dkt + 2 * (gq & 1) + (pp >> 1);
#pragma unroll 4
    for (int ks = 0; ks < 16; ++ks) {
        const int r1 = 16 * ks + 8 * hi + qp, r2 = r1 + 4;
        const s16x4 alo = ds_tr16(ldsb + swz_tr(r1, chA) + (pp & 1) * 8), ahi = ds_tr16(ldsb + swz_tr(r2, chA) + (pp & 1) * 8);
        const bf16x8 af = (bf16x8){alo[0], alo[1], alo[2], alo[3], ahi[0], ahi[1], ahi[2], ahi[3]};
#pragma unroll
        for (int t = 0; t < 2; ++t) {
            const int chB = 4 * (dvt0 + t) + 2 * (gq & 1) + (pp >> 1);
            const s16x4 blo = ds_tr16(ldsb + 65536u + swz_tr(r1, chB) + (pp & 1) * 8), bhi = ds_tr16(ldsb + 65536u + swz_tr(r2, chB) + (pp & 1) * 8);
            const bf16x8 bf = (bf16x8){blo[0], blo[1], blo[2], blo[3], bhi[0], bhi[1], bhi[2], bhi[3]};
            acc[t] = __builtin_amdgcn_mfma_f32_32x32x16_bf16(af, bf, acc[t], 0, 0, 0);
        }
    }
    bf16_t* out = KVT + ((size_t)((b * 4 + h) * 16 + N)) * 16384;
#pragma unroll
    for (int t = 0; t < 2; ++t) {
        const int dv = 32 * (dvt0 + t) + (lane & 31);
#pragma unroll
        for (int rg = 0; rg < 4; ++rg) {
            u32x2 o; o.x = cvt_pk_bf16_c(acc[t][4 * rg], acc[t][4 * rg + 1]); o.y = cvt_pk_bf16_c(acc[t][4 * rg + 2], acc[t][4 * rg + 3]);
            *(u32x2*)(out + dv * 128 + 32 * dkt + 8 * rg + 4 * (lane >> 5)) = o;
        }
    }
    __syncthreads();
}

__device__ __forceinline__ void ret_out_unit(LAS unsigned char* lds, const bf16_t* __restrict__ P, const bf16_t* __restrict__ KVT, bf16_t* MG, int b, int h, int N, int tid) {
    const int lane = tid & 63, w = __builtin_amdgcn_readfirstlane(tid >> 6), l31 = lane & 31, hi = lane >> 5;
    const float lg2 = log2f(1.0f - exp2f(-5.0f - (float)h));
    const size_t rowbase = (size_t)b * L + 256 * N;
    {
        const bf16_t* kvb = KVT + ((size_t)((b * 4 + h) * 16)) * 16384;
        float a8[4][8];
#pragma unroll
        for (int i = 0; i < 4; ++i)
#pragma unroll
            for (int e = 0; e < 8; ++e) a8[i][e] = 0.f;
#pragma unroll 1
        for (int m = 0; m < N; ++m) {
            const float wgt = exp2f((float)(256 * (N - 1 - m)) * lg2);
            u32x4 v[4];
#pragma unroll
            for (int i = 0; i < 4; ++i) { const int cid = tid + 512 * i, dv = cid >> 4, ch = cid & 15; v[i] = *(const u32x4*)(kvb + (size_t)m * 16384 + dv * 128 + ch * 8); }
#pragma unroll
            for (int i = 0; i < 4; ++i) {
                a8[i][0] += wgt * bflo(v[i].x); a8[i][1] += wgt * bfhi(v[i].x); a8[i][2] += wgt * bflo(v[i].y); a8[i][3] += wgt * bfhi(v[i].y);
                a8[i][4] += wgt * bflo(v[i].z); a8[i][5] += wgt * bfhi(v[i].z); a8[i][6] += wgt * bflo(v[i].w); a8[i][7] += wgt * bfhi(v[i].w); }
        }
#pragma unroll
        for (int i = 0; i < 4; ++i) {
            const int cid = tid + 512 * i, dv = cid >> 4, ch = cid & 15;
            u32x4 o; o.x = cvt_pk_bf16(a8[i][0], a8[i][1]); o.y = cvt_pk_bf16(a8[i][2], a8[i][3]); o.z = cvt_pk_bf16(a8[i][4], a8[i][5]); o.w = cvt_pk_bf16(a8[i][6], a8[i][7]);
            *(LAS u32x4*)(lds + swz_row(dv, ch)) = o;
        }
    }
    const size_t qrow = rowbase + 32 * w + l31;
    bf16x8 qf[8];
#pragma unroll
    for (int ks = 0; ks < 8; ++ks) qf[ks] = *(const bf16x8*)(P + qrow * 2560 + h * 128 + 16 * ks + 8 * hi);
    __syncthreads();
    f32x16 acc[4];
#pragma unroll
    for (int dvt = 0; dvt < 4; ++dvt) {
#pragma unroll
        for (int r = 0; r < 16; ++r) acc[dvt][r] = 0.f;
        const int dv = 32 * dvt + l31;
#pragma unroll
        for (int ks = 0; ks < 8; ++ks) {
            const bf16x8 pf = *(const LAS bf16x8*)(lds + swz_row(dv, 2 * ks + hi));
            acc[dvt] = __builtin_amdgcn_mfma_f32_32x32x16_bf16(pf, qf[ks], acc[dvt], 0, 0, 0);
        }
    }
    {
        const float xi = exp2f((float)(32 * w + l31 + 1) * lg2);
#pragma unroll
        for (int dvt = 0; dvt < 4; ++dvt)
#pragma unroll
            for (int r = 0; r < 16; ++r) acc[dvt][r] *= xi;
    }
    __syncthreads();
    {
        u32x4 kreg[8], vreg[8];
#pragma unroll
        for (int i = 0; i < 8; ++i) {
            const int id = tid + 512 * i, row = id >> 4, ch = id & 15;
            const bf16_t* src = P + (rowbase + row) * 2560 + 512 + h * 128 + ch * 8;
            kreg[i] = *(const u32x4*)src; vreg[i] = *(const u32x4*)(src + 512);
        }
#pragma unroll
        for (int i = 0; i < 8; ++i) {
            const int id = tid + 512 * i, row = id >> 4, ch = id & 15;
            *(LAS u32x4*)(lds + swz_row(row, ch)) = kreg[i];
            *(LAS u32x4*)(lds + 65536 + swz_tr(row, ch)) = vreg[i];
        }
    }
    __syncthreads();
    float dvec[16];
#pragma unroll
    for (int r = 0; r < 16; ++r) dvec[r] = exp2f((float)(l31 - ((r & 3) + 8 * (r >> 2) + 4 * hi)) * lg2);
    const int gq = lane >> 4, qp = (lane & 15) >> 2, pp = lane & 3;
    const unsigned ldsb = (unsigned)(uintptr_t)lds;
#pragma unroll 1
    for (int kt = 0; kt <= w; ++kt) {
        f32x16 st;
#pragma unroll
        for (int r = 0; r < 16; ++r) st[r] = 0.f;
        const int key = 32 * kt + l31;
#pragma unroll
        for (int ks = 0; ks < 8; ++ks) {
            const bf16x8 kf = *(const LAS bf16x8*)(lds + swz_row(key, 2 * ks + hi));
            st = __builtin_amdgcn_mfma_f32_32x32x16_bf16(kf, qf[ks], st, 0, 0, 0);
        }
        const float tsc = exp2f((float)(32 * (w - kt)) * lg2);
        const bool diag = (kt == w);
#pragma unroll
        for (int r = 0; r < 16; ++r) {
            const int krow = (r & 3) + 8 * (r >> 2) + 4 * hi;
            float pv = st[r] * dvec[r] * tsc;
            if (diag && krow > l31) pv = 0.f;
            st[r] = pv;
        }
        bf16x8 pf[2];
#pragma unroll
        for (int s = 0; s < 2; ++s) { u32x4 pw; pw.x = cvt_pk_bf16(st[8 * s], st[8 * s + 1]); pw.y = cvt_pk_bf16(st[8 * s + 2], st[8 * s + 3]);
            pw.z = cvt_pk_bf16(st[8 * s + 4], st[8 * s + 5]); pw.w = cvt_pk_bf16(st[8 * s + 6], st[8 * s + 7]); pf[s] = __builtin_bit_cast(bf16x8, pw); }
#pragma unroll
        for (int dvt = 0; dvt < 4; ++dvt) {
            const int chV = 4 * dvt + 2 * (gq & 1) + (pp >> 1);
#pragma unroll
            for (int s = 0; s < 2; ++s) {
                const int r1 = 32 * kt + 16 * s + 4 * hi + qp, r2 = r1 + 8;
                const s16x4 vlo = ds_tr16(ldsb + 65536u + swz_tr(r1, chV) + (pp & 1) * 8), vhi = ds_tr16(ldsb + 65536u + swz_tr(r2, chV) + (pp & 1) * 8);
                const bf16x8 vf = (bf16x8){vlo[0], vlo[1], vlo[2], vlo[3], vhi[0], vhi[1], vhi[2], vhi[3]};
                acc[dvt] = __builtin_amdgcn_mfma_f32_32x32x16_bf16(vf, pf[s], acc[dvt], 0, 0, 0);
            }
        }
    }
    float s1 = 0.f;
#pragma unroll
    for (int dvt = 0; dvt < 4; ++dvt)
#pragma unroll
        for (int r = 0; r < 16; ++r) s1 += acc[dvt][r];
    s1 += __shfl_xor(s1, 32);
    const float mu = s1 * (1.0f / 128.0f);
    float s2 = 0.f;
#pragma unroll
    for (int dvt = 0; dvt < 4; ++dvt)
#pragma unroll
        for (int r = 0; r < 16; ++r) { const float d = acc[dvt][r] - mu; s2 += d * d; }
    s2 += __shfl_xor(s2, 32);
    const float rs = rsqrtf(s2 * (1.0f / 128.0f) + 1e-6f);
#pragma unroll
    for (int dvt = 0; dvt < 4; ++dvt)
#pragma unroll
        for (int rg = 0; rg < 4; ++rg) {
            const int col = h * 128 + 32 * dvt + 8 * rg + 4 * hi;
            const u32x2 g = *(const u32x2*)(P + qrow * 2560 + 1536 + col);
            u32x2 o; o.x = cvt_pk_bf16(bflo(g.x) * (acc[dvt][4 * rg] - mu) * rs, bfhi(g.x) * (acc[dvt][4 * rg + 1] - mu) * rs);
            o.y = cvt_pk_bf16(bflo(g.y) * (acc[dvt][4 * rg + 2] - mu) * rs, bfhi(g.y) * (acc[dvt][4 * rg + 3] - mu) * rs);
            *(u32x2*)(MG + qrow * D + col) = o;
        }
    __syncthreads();
}
constexpr size_t S5_BB_OFF = 0, S5_CM_OFF = 128 * 1024, S5_LAM_OFF = 448 * 1024;
struct S5P { float lr, li; };
__device__ __forceinline__ void cmul(float ar, float ai, float br, float bi, float& cr, float& ci) { float r_ = ar * br - ai * bi; asm volatile("" : "+v"(r_)); float i_ = ar * bi + ai * br; asm volatile("" : "+v"(i_)); cr = r_; ci = i_; }
__device__ __forceinline__ void s5_coefs(const float* a_re, const float* a_im, const float* log_dt, int g, int st, float& lr, float& li, float& cr, float& ci) {
    const float dt = expf(log_dt[g]); const float are = a_re[g * 64 + st], aim = a_im[g * 64 + st];
    const float zr = are * dt, zi = aim * dt, mag = expf(zr);
    lr = mag * cosf(zi); li = mag * sinf(zi);
    const float nr = lr - 1.0f, ni = li, den = are * are + aim * aim;
    cr = (nr * are + ni * aim) / den; ci = (ni * are - nr * aim) / den;
}
__device__ __forceinline__ void s5_tables(unsigned char* tab, const float* a_re, const float* a_im, const float* b_re, const float* b_im, const float* c_re, const float* c_im,
                                          const float* dsk, const float* log_dt, int gtid, int gthreads) {
    for (int i = gtid; i < 32 * 64; i += gthreads) {
        const int g = i >> 6, st = i & 63;
        const float dt = expf(log_dt[g]); const float zr = a_re[g * 64 + st] * dt, zi = a_im[g * 64 + st] * dt;
        float* o = (float*)(tab + S5_LAM_OFF) + (size_t)i * 16;
        const float kk[7] = {1.f, 2.f, 3.f, 4.f, 32.f, 64.f, 256.f};
#pragma unroll
        for (int q = 0; q < 7; ++q) { const float mag = expf(kk[q] * zr); o[2 * q] = mag * cosf(kk[q] * zi); o[2 * q + 1] = mag * sinf(kk[q] * zi); }
        o[14] = 0.f; o[15] = 0.f;
    }
    for (int i = gtid; i < 32 * 4 * 64; i += gthreads) {
        const int lane = i & 63, tt = (i >> 6) & 3, g = i >> 8;
        const int st = 32 * (tt >> 1) + (lane & 31); float lr, li, cr, ci; s5_coefs(a_re, a_im, log_dt, g, st, lr, li, cr, ci);
        float v[8];
#pragma unroll
        for (int j = 0; j < 8; ++j) { const int h = 8 * (lane >> 5) + j; const float br = b_re[(g * 64 + st) * 16 + h], bi = b_im[(g * 64 + st) * 16 + h];
            v[j] = (tt & 1) ? (cr * bi + ci * br) : (cr * br - ci * bi); }
        u32x4 o; o.x = pk2(v[0], v[1]); o.y = pk2(v[2], v[3]); o.z = pk2(v[4], v[5]); o.w = pk2(v[6], v[7]);
        *((u32x4*)(tab + S5_BB_OFF) + i) = o;
    }
    for (int i = gtid; i < 32 * 9 * 64; i += gthreads) {
        const int lane = i & 63, s9 = (i >> 6) % 9, g = i / (9 * 64);
        const int h = lane & 31; float v[8];
#pragma unroll
        for (int j = 0; j < 8; ++j) {
            float x = 0.f;
            if (h < 16) {
                if (s9 < 8) { const int st = 8 * s9 + 4 * (lane >> 5) + (j >> 1); x = (j & 1) ? -c_im[(g * 16 + h) * 64 + st] : c_re[(g * 16 + h) * 64 + st]; }
                else { const int hp = 8 * (lane >> 5) + j; x = (hp == h) ? dsk[g * 16 + h] : 0.f; }
            }
            v[j] = x;
        }
        u32x4 o; o.x = pk2(v[0], v[1]); o.y = pk2(v[2], v[3]); o.z = pk2(v[4], v[5]); o.w = pk2(v[6], v[7]);
        *((u32x4*)(tab + S5_CM_OFF) + i) = o;
    }
}

template <bool OUT>
__device__ __forceinline__ void s5_task(const bf16_t* __restrict__ P, const unsigned char* __restrict__ tab, float* END, bf16_t* G, LAS unsigned char* xl, int b, int g, int c, int lane) {
    const int l31 = lane & 31, hi = lane >> 5;
    bf16x8 bbt[4];
#pragma unroll
    for (int tt = 0; tt < 4; ++tt) bbt[tt] = *((const bf16x8*)(tab + S5_BB_OFF) + (g * 4 + tt) * 64 + lane);
    float l1r[2], l1i[2], l2r[2], l2i[2], l3r[2], l3i[2], l4r[2], l4i[2], cr[2], ci[2];
#pragma unroll
    for (int cc = 0; cc < 2; ++cc) {
        const float* lp = (const float*)(tab + S5_LAM_OFF) + (size_t)(g * 64 + 32 * cc + l31) * 16;
        const f32x4 a = *(const f32x4*)lp, bq = *(const f32x4*)(lp + 4);
        l1r[cc] = a[0]; l1i[cc] = a[1]; l2r[cc] = a[2]; l2i[cc] = a[3]; l3r[cc] = bq[0]; l3i[cc] = bq[1]; l4r[cc] = bq[2]; l4i[cc] = bq[3];
        cr[cc] = 0.f; ci[cc] = 0.f;
        if (OUT) {
            const float p256r = lp[12], p256i = lp[13];
            const float* ep = END + ((size_t)((b * 32 + g) * 16) * 64 + 32 * cc + l31) * 2;
#pragma unroll
            for (int m = 0; m < 15; ++m) { const int mm = m < c ? m : 0; f32x2 e = *(const f32x2*)(ep + (size_t)mm * 128); float tr_, ti_; cmul(p256r, p256i, cr[cc], ci[cc], tr_, ti_);
                if (m < c) { cr[cc] = tr_ + e.x; ci[cc] = ti_ + e.y; } }
        }
    }
    bf16x8 cm[9];
    if (OUT) {
#pragma unroll
        for (int s = 0; s < 9; ++s) cm[s] = *((const bf16x8*)(tab + S5_CM_OFF) + (g * 9 + s) * 64 + lane);
    }
    const size_t row0 = (size_t)b * L + 256 * c;
    bf16x8 ufn = *(const bf16x8*)(P + (row0 + l31) * 2560 + 2048 + g * 16 + 8 * hi);
#pragma unroll 1
    for (int step = 0; step < 8; ++step) {
        const bf16x8 uf = ufn;
        if (step < 7) ufn = *(const bf16x8*)(P + (row0 + 32 * (step + 1) + l31) * 2560 + 2048 + g * 16 + 8 * hi);
        f32x16 acc[4];
#pragma unroll
        for (int tt = 0; tt < 4; ++tt) {
#pragma unroll
            for (int r = 0; r < 16; ++r) acc[tt][r] = 0.f;
            acc[tt] = __builtin_amdgcn_mfma_f32_32x32x16_bf16(uf, bbt[tt], acc[tt], 0, 0, 0);
        }
#pragma unroll
        for (int cc = 0; cc < 2; ++cc) {
            f32x16& xr = acc[2 * cc]; f32x16& xi = acc[2 * cc + 1];
#pragma unroll
            for (int k = 0; k < 4; ++k)
#pragma unroll
                for (int i = 1; i < 4; ++i) { const int r = 4 * k + i;
                    const float nr = l1r[cc] * xr[r - 1] - l1i[cc] * xi[r - 1] + xr[r], ni = l1r[cc] * xi[r - 1] + l1i[cc] * xr[r - 1] + xi[r];
                    xr[r] = nr; xi[r] = ni; }
            float C0r = cr[cc], C0i = ci[cc];
            float mr[4], mi[4];
#pragma unroll
            for (int k = 0; k < 4; ++k) {
                const float er = xr[4 * k + 3], ei = xi[4 * k + 3];
                const float pr = __shfl_xor(er, 32), pi = __shfl_xor(ei, 32);
                const float e0r = hi ? pr : er, e0i = hi ? pi : ei, e1r = hi ? er : pr, e1i = hi ? ei : pi;
                float t1r, t1i; cmul(l4r[cc], l4i[cc], C0r, C0i, t1r, t1i); float C1r = t1r + e0r, C1i = t1i + e0i;
                asm volatile("s_nop 3" : "+v"(C1r), "+v"(C1i));
                mr[k] = hi ? C1r : C0r; mi[k] = hi ? C1i : C0i;
                float t2r, t2i; cmul(l4r[cc], l4i[cc], C1r, C1i, t2r, t2i); C0r = t2r + e1r; C0i = t2i + e1i;
                asm volatile("s_nop 3" : "+v"(C0r), "+v"(C0i), "+v"(mr[k]), "+v"(mi[k]));
            }
            cr[cc] = C0r; ci[cc] = C0i;
            if (OUT) {
#pragma unroll
                for (int k = 0; k < 4; ++k) {
                    float tr_, ti_;
                    cmul(l1r[cc], l1i[cc], mr[k], mi[k], tr_, ti_); xr[4 * k] += tr_; xi[4 * k] += ti_;
                    cmul(l2r[cc], l2i[cc], mr[k], mi[k], tr_, ti_); xr[4 * k + 1] += tr_; xi[4 * k + 1] += ti_;
                    cmul(l3r[cc], l3i[cc], mr[k], mi[k], tr_, ti_); xr[4 * k + 2] += tr_; xi[4 * k + 2] += ti_;
                    cmul(l4r[cc], l4i[cc], mr[k], mi[k], tr_, ti_); xr[4 * k + 3] += tr_; xi[4 * k + 3] += ti_;
                }
#pragma unroll
                for (int r = 0; r < 16; ++r) { const int tk = (r & 3) + 8 * (r >> 2) + 4 * hi;
                    *(LAS unsigned*)(xl + tk * 272 + (32 * cc + l31) * 4) = cvt_pk_bf16(xr[r], xi[r]); }
            }
        }
        if (!OUT) {
            if (step == 7 && hi == 0) {
                float* ep = END + ((size_t)((b * 32 + g) * 16 + c) * 64) * 2;
                f32x2 e0; e0.x = cr[0]; e0.y = ci[0]; f32x2 e1; e1.x = cr[1]; e1.y = ci[1];
                *(f32x2*)(ep + l31 * 2) = e0; *(f32x2*)(ep + (32 + l31) * 2) = e1;
            }
        } else {
            LDS_WAIT(); asm volatile("" ::: "memory");
            f32x16 y;
#pragma unroll
            for (int r = 0; r < 16; ++r) y[r] = 0.f;
#pragma unroll
            for (int s = 0; s < 8; ++s) { const bf16x8 xf = *(const LAS bf16x8*)(xl + l31 * 272 + 32 * s + 16 * hi);
                y = __builtin_amdgcn_mfma_f32_32x32x16_bf16(cm[s], xf, y, 0, 0, 0); }
            y = __builtin_amdgcn_mfma_f32_32x32x16_bf16(cm[8], uf, y, 0, 0, 0);
            bf16_t* gp = G + (row0 + 32 * step + l31) * 512 + g * 16 + 4 * hi;
#pragma unroll
            for (int rg = 0; rg < 2; ++rg) {
                float gv[4];
#pragma unroll
                for (int e = 0; e < 4; ++e) { const float v = y[4 * rg + e]; gv[e] = v * fast_sigmoid(1.5957691216057308f * (v + 0.044715f * v * v * v)); }
                u32x2 o; o.x = cvt_pk_bf16(gv[0], gv[1]); o.y = cvt_pk_bf16(gv[2], gv[3]);
                *(u32x2*)(gp + 8 * rg) = o;
            }
            LDS_WAIT(); asm volatile("" ::: "memory");
        }
    }
}

struct EpiGlu {
    static constexpr bool PERM = true;
    const bf16_t* G; const float* bias; bf16_t* MG;
    __device__ __forceinline__ void operator()(const f32x4 (&acc)[2][2][4][2], const Unit& u, int wr, int wc, int fr, int fq) const {
        const int row0 = u.pm * 256 + wr * 64 + fr;
#pragma unroll
        for (int ai = 0; ai < 2; ++ai)
#pragma unroll
            for (int m = 0; m < 4; ++m) {
                const int row = row0 + ai * 128 + m * 16;
#pragma unroll
                for (int bj = 0; bj < 2; ++bj) {
                    const int col = u.pn * 256 + bj * 128 + wc * 32 + 8 * fq;
                    const u32x4 gq = *(const u32x4*)(G + (size_t)row * 512 + col);
                    const f32x4 b0 = *(const f32x4*)(bias + col), b1 = *(const f32x4*)(bias + col + 4);
                    const f32x4 z0 = acc[ai][bj][m][0] + b0, z1 = acc[ai][bj][m][1] + b1;
                    u32x4 o;
                    o.x = cvt_pk_bf16(bflo(gq.x) * fast_sigmoid(z0[0]), bfhi(gq.x) * fast_sigmoid(z0[1]));
                    o.y = cvt_pk_bf16(bflo(gq.y) * fast_sigmoid(z0[2]), bfhi(gq.y) * fast_sigmoid(z0[3]));
                    o.z = cvt_pk_bf16(bflo(gq.z) * fast_sigmoid(z1[0]), bfhi(gq.z) * fast_sigmoid(z1[1]));
                    o.w = cvt_pk_bf16(bflo(gq.w) * fast_sigmoid(z1[2]), bfhi(gq.w) * fast_sigmoid(z1[3]));
                    *(u32x4*)(MG + (size_t)row * D + 512 + col) = o;
                }
            }
    }
};
struct Args {
    const float* in[25]; float* out; unsigned char* ws; int ph_lo, ph_hi;
};
enum { PH_PROLOGUE = 0, PH_INPROJ = 1, PH_MIX_A = 2, PH_MIX_B = 3, PH_GLU = 4, PH_OUTPROJ0 = 5, PH_ROUTER0 = 6, PH_GATEUP0 = 7, PH_DOWN0 = 8, PH_QKV = 9, PH_ATTN_AB = 10, PH_ATTN_C = 11, PH_OUTPROJ1 = 12, PH_ROUTER1 = 13, PH_MOE1X = 14, PH_MOE1Y = 15, PH_MOE1Z = 16, PH_FINAL = 17, PH_COUNT = 18 };

enum { CF_IN = 0, CF_OUT = 1, CF_GLU = 2, CF_QKV = 3, CF_CO = 4, CF_G = 5, CF_U = 6, CF_D = 7 };
struct ConvSeg { int fam, lo, n; };
template <int FAM>
__device__ __forceinline__ void conv_item(const Args& a, LAS float* scr, int r, int lane) {
    unsigned char* ws = a.ws;
    if (FAM == CF_IN) tr_item<1>(a.in[4], 2560, (bf16_t*)(ws + WS_WIN), 1024, 0, 0, a.in[1], scr, r, lane);
    else if (FAM == CF_OUT) tr_item<0>(a.in[5], 1024, (bf16_t*)(ws + WS_WOUT), 1024, 0, 0, nullptr, scr, r, lane);
    else if (FAM == CF_GLU) tr_item<0>(a.in[14], 512, (bf16_t*)(ws + WS_WGLU), 512, 0, 0, nullptr, scr, r, lane);
    else if (FAM == CF_QKV) tr_item<0>(a.in[16], 3072, (bf16_t*)(ws + WS_WQKV), 1024, 0, 0, a.in[1] + D, scr, r, lane);
    else if (FAM == CF_CO) tr_item<0>(a.in[17], 1024, (bf16_t*)(ws + WS_CWOUT), 1024, 0, 0, nullptr, scr, r, lane);
    else if (FAM == CF_G) { const int le = r >> 8, layer = le >> 4, ge = le & 15;
        tr_item<2>(a.in[22] + (size_t)le * 1024 * 512, 512, (bf16_t*)(ws + WS_WGU + layer * WS_MOE_LAYER) + (size_t)ge * 1024 * 1024, 1024, 0, 0, a.in[2] + layer * D, scr, r & 255, lane); }
    else if (FAM == CF_U) { const int le = r >> 8, layer = le >> 4, ge = le & 15;
        tr_item<3>(a.in[23] + (size_t)le * 1024 * 512, 512, (bf16_t*)(ws + WS_WGU + layer * WS_MOE_LAYER) + (size_t)ge * 1024 * 1024, 1024, 0, 0, a.in[2] + layer * D, scr, r & 255, lane); }
    else { const int le = r >> 8, layer = le >> 4, g = (le >> 2) & 3, e = le & 3;
        tr_item<0>(a.in[24] + (size_t)le * 512 * 1024, 1024, (bf16_t*)(ws + WS_WD + layer * WS_MOE_LAYER) + (size_t)g * 1024 * 2048, 2048, e * 512, 0, nullptr, scr, r & 255, lane); }
}
template <int SLOT>
__device__ __forceinline__ void conv_run(Frame& F, const Args& a, int widx, int wcount) {
    LAS float* scr = (LAS float*)(F.lds + F.wave * 16384);
    if (SLOT == 0) {
        constexpr int N0 = 16 * 80, N1 = 16 * 32, N2 = 8 * 16;
        for (int it = widx; it < N0 + N1 + N2; it += wcount) { int r = it;
            if (r < N0) { conv_item<CF_IN>(a, scr, r, F.lane); continue; } r -= N0;
            if (r < N1) { conv_item<CF_OUT>(a, scr, r, F.lane); continue; } r -= N1;
            conv_item<CF_GLU>(a, scr, r, F.lane); }
    } else if (SLOT == 1) {
        constexpr int N0 = 4096, N1 = 2048;
        for (int it = widx; it < N0 + N1; it += wcount) { int r = it;
            if (r < N0) { conv_item<CF_U>(a, scr, r, F.lane); continue; } r -= N0;
            conv_item<CF_G>(a, scr, r, F.lane); }
    } else if (SLOT == 4) {
        constexpr int N0 = 16 * 32, N1 = 4096, N2 = 16 * 96;
        for (int it = widx; it < N0 + N1 + N2; it += wcount) { int r = it;
            if (r < N0) { conv_item<CF_CO>(a, scr, r, F.lane); continue; } r -= N0;
            if (r < N1) { conv_item<CF_G>(a, scr, 4096 + r, F.lane); continue; } r -= N1;
            conv_item<CF_QKV>(a, scr, r, F.lane); }
    } else if (SLOT == 3) {
        for (int it = widx; it < 6144; it += wcount) { if (it < 4096) conv_item<CF_D>(a, scr, it, F.lane); else conv_item<CF_G>(a, scr, it - 2048, F.lane); }
    } else {
        for (int it = widx; it < 8192; it += wcount) {
            if (it < 4096) conv_item<CF_U>(a, scr, 4096 + it, F.lane); else conv_item<CF_D>(a, scr, it, F.lane); }
    }
}
__device__ __forceinline__ void p0_prologue(Frame& F, const Args& a) {
    unsigned char* ws = a.ws;
    const int gw = F.vcu * NWAVES + F.wave, NGW = F.G * NWAVES;
    conv_run<0>(F, a, gw, NGW);
    const float* x = a.in[0]; bf16_t* XB = (bf16_t*)(ws + WS_XB); float* ss0 = (float*)(ws + WS_SS0);
    for (int m = gw; m < T; m += NGW) {
        const f32x4* xr = (const f32x4*)(x + (size_t)m * D) + F.lane;
        f32x4 v[4]; float s = 0.f;
#pragma unroll
        for (int j = 0; j < 4; ++j) { v[j] = xr[64 * j]; s += (v[j].x * v[j].x + v[j].y * v[j].y) + (v[j].z * v[j].z + v[j].w * v[j].w); }
        s = wave_sum(s);
        u32x2* o8 = (u32x2*)(XB + (size_t)m * D) + F.lane;
#pragma unroll
        for (int j = 0; j < 4; ++j) { u32x2 w; w.x = pk2(v[j].x, v[j].y); w.y = pk2(v[j].z, v[j].w); o8[64 * j] = w; }
        if (F.lane == 0) __hip_atomic_store(ss0 + m, s, RLX_AGENT);
    }
    s5_tables(ws + WS_S5T, a.in[6], a.in[7], a.in[8], a.in[9], a.in[10], a.in[11], a.in[12], a.in[13], F.vcu * NWAVES * 64 + F.tid, F.G * NWAVES * 64);
    {   float* rtw = (float*)(ws + WS_RTW);
        for (int i = (F.vcu * NWAVES * 64) + F.tid; i < 2 * 20 * 1024; i += F.G * NWAVES * 64) {
            const int layer = i / 20480, r = i - layer * 20480, j = r >> 10, k = r & 1023;
            const float wv = j < 4 ? a.in[18][(size_t)layer * 4096 + k * 4 + j] : a.in[20][(size_t)layer * 16384 + k * 16 + (j - 4)];
            rtw[i] = wv * a.in[2][layer * D + k]; } }
    float* rope = (float*)(ws + WS_ROPE);
    for (int i = (F.vcu * NWAVES * 64) + F.tid; i < L * 64; i += F.G * NWAVES * 64) {
        const int j = i & 63, pos = i >> 6;
        const float inv = powf(10000.0f, -(float)j / 64.0f);
        const float ang = (float)pos * inv;
        rope[i] = cosf(ang); rope[L * 64 + i] = sinf(ang);
    }
}

__device__ __forceinline__ void router_phase(Frame& F, const Args& a, int layer) {
    unsigned char* ws = a.ws;
    LAS float* wT = (LAS float*)F.lds;
    LAS float* gn = wT + 20 * 1024;
    LAS float* bias = gn + 1024;
    LAS int* rcls = (LAS int*)(bias + 32);
    LAS float* rwl = (LAS float*)(rcls + 64);
    LAS float* rwh = rwl + 64;
    LAS int* cbase = (LAS int*)(rwh + 64);
    const float* wg = a.in[18] + (size_t)layer * 4096; const float* bg = a.in[19] + layer * 4;
    const float* wrr = a.in[20] + (size_t)layer * 16384; const float* brr = a.in[21] + layer * 16;
    const float* gain = a.in[2] + layer * D;
    unsigned* cnt = F.ctl + (layer ? CW_CLS1 : CW_CLS0);
    const bf16_t* H = layer ? (const bf16_t*)(ws + WS_XB) : (const bf16_t*)a.out;
    int* list = (int*)(ws + WS_LIST); f32x2* lw = (f32x2*)(ws + WS_LW);
    {   const f32x4* rt = (const f32x4*)(ws + WS_RTW) + (size_t)layer * 5120;
#pragma unroll
        for (int i = 0; i < 10; ++i) ((LAS f32x4*)wT)[F.tid + 512 * i] = rt[F.tid + 512 * i]; }
    if (F.tid < 4) bias[F.tid] = bg[F.tid]; else if (F.tid < 20) bias[F.tid] = brr[F.tid - 4];
    __syncthreads();
    for (int rb = F.vcu; rb < T / 64; rb += F.G) {
        constexpr int RB = 4;
        u32x2 nv[RB][4];
#pragma unroll
        for (int r = 0; r < RB; ++r) { const u32x2* hr0 = (const u32x2*)(H + (size_t)(rb * 64 + F.wave * 8 + r) * D) + F.lane;
#pragma unroll
            for (int j = 0; j < 4; ++j) nv[r][j] = hr0[64 * j]; }
#pragma unroll 1
        for (int rg = 0; rg < 8 / RB; ++rg) {
            const int rloc0 = F.wave * 8 + rg * RB, row0 = rb * 64 + rloc0;
            f32x4 v[RB][4]; float rstd[RB];
#pragma unroll
            for (int r = 0; r < RB; ++r)
#pragma unroll
                for (int j = 0; j < 4; ++j) v[r][j] = (f32x4){bflo(nv[r][j].x), bfhi(nv[r][j].x), bflo(nv[r][j].y), bfhi(nv[r][j].y)};
            if (rg + 1 < 8 / RB) {
#pragma unroll
                for (int r = 0; r < RB; ++r) { const u32x2* hr = (const u32x2*)(H + (size_t)(row0 + RB + r) * D) + F.lane;
#pragma unroll
                    for (int j = 0; j < 4; ++j) nv[r][j] = hr[64 * j]; } }
#pragma unroll
            for (int r = 0; r < RB; ++r) { float s = 0.f;
#pragma unroll
                for (int j = 0; j < 4; ++j) s += (v[r][j].x * v[r][j].x + v[r][j].y * v[r][j].y) + (v[r][j].z * v[r][j].z + v[r][j].w * v[r][j].w);
                rstd[r] = rsqrtf(wave_allsum(s) * (1.0f / D) + RMS_EPS); }
            float lgg[RB][4];
#pragma unroll
            for (int i = 0; i < 4; ++i) { float acc[RB];
#pragma unroll
                for (int r = 0; r < RB; ++r) acc[r] = 0.f;
#pragma unroll
                for (int j = 0; j < 4; ++j) { const f32x4 w4 = *(const LAS f32x4*)(wT + i * 1024 + 256 * j + 4 * F.lane);
#pragma unroll
                    for (int r = 0; r < RB; ++r) acc[r] += (v[r][j].x * w4.x + v[r][j].y * w4.y) + (v[r][j].z * w4.z + v[r][j].w * w4.w); }
                const float bi = bias[i];
#pragma unroll
                for (int r = 0; r < RB; ++r) lgg[r][i] = wave_allsum(acc[r]) * rstd[r] + bi; }
#pragma unroll
            for (int r = 0; r < RB; ++r) {
                const float* lg = lgg[r]; const int rloc = rloc0 + r;
                int gs = 0; float gm = lg[0];
#pragma unroll
                for (int i = 1; i < 4; ++i) if (lg[i] > gm) { gm = lg[i]; gs = i; }
                float se = 0.f;
#pragma unroll
                for (int i = 0; i < 4; ++i) se += expf(lg[i] - gm);
                const float gval = 1.0f / se;
                float ev[4];
#pragma unroll
                for (int i = 0; i < 4; ++i) { const LAS float* wrow = wT + (4 + gs * 4 + i) * 1024; float acc = 0.f;
#pragma unroll
                    for (int j = 0; j < 4; ++j) { const f32x4 w4 = *(const LAS f32x4*)(wrow + 256 * j + 4 * F.lane); acc += (v[r][j].x * w4.x + v[r][j].y * w4.y) + (v[r][j].z * w4.z + v[r][j].w * w4.w); }
                    ev[i] = wave_allsum(acc) * rstd[r] + bias[4 + gs * 4 + i]; }
                int i1 = 0; float v1 = ev[0];
#pragma unroll
                for (int i = 1; i < 4; ++i) if (ev[i] > v1) { v1 = ev[i]; i1 = i; }
                int i2 = -1; float v2 = -3.0e38f;
#pragma unroll
                for (int i = 0; i < 4; ++i) if (i != i1 && ev[i] > v2) { v2 = ev[i]; i2 = i; }
                const float e2 = expf(v2 - v1);
                const float w1 = gval / (1.0f + e2), w2 = gval * e2 / (1.0f + e2);
                const int lo = i1 < i2 ? i1 : i2, hi = i1 < i2 ? i2 : i1;
                const int pidx = lo == 0 ? hi - 1 : (lo == 1 ? hi + 1 : 5);
                if (F.lane == 0) { rcls[rloc] = gs * 6 + pidx; rwl[rloc] = __uint_as_float(pk2(i1 < i2 ? w1 : w2, i1 < i2 ? w2 : w1)); rwh[rloc] = rstd[r]; }
            }
        }
        __syncthreads();
        if (F.tid < 24) { int tot = 0; for (int r = 0; r < 64; ++r) tot += (rcls[r] == F.tid) ? 1 : 0;
            cbase[F.tid] = tot ? (int)__hip_atomic_fetch_add(cnt + 64 * F.tid, (unsigned)tot, RLX_AGENT) : 0; }
        __syncthreads();
        if (F.tid < 64) { const int myc = rcls[F.tid]; int rank = 0; for (int r = 0; r < F.tid; ++r) rank += (rcls[r] == myc) ? 1 : 0;
            const int pos = cbase[myc] + rank; __hip_atomic_store(list + myc * 16384 + pos, rb * 64 + F.tid, RLX_AGENT);
            __hip_atomic_store((unsigned long long*)(lw + myc * 16384 + pos), ((unsigned long long)__float_as_uint(rwh[F.tid]) << 32) | __float_as_uint(rwl[F.tid]), RLX_AGENT); }
        __syncthreads();
    }
}
__device__ __forceinline__ void moe_setup(Frame& F, int layer) {
    LAS int* tb = (LAS int*)(F.lds + MOE_TB_OFF); LAS int* cc = tb + 25;
    if (F.tid == 0) { const unsigned* cnt = F.ctl + (layer ? CW_CLS1 : CW_CLS0); int run = 0;
        for (int c = 0; c < 24; ++c) { const int n = (int)__hip_atomic_load(cnt + 64 * c, RLX_AGENT); cc[c] = n; tb[c] = run; run += (n + 255) >> 8; }
        tb[24] = run; }
    __syncthreads();
}
template <bool LAST>
__device__ __forceinline__ void moe_phases(Frame& F, const Args& a, int layer, int which) {
    unsigned char* ws = a.ws;
    moe_setup(F, layer);
    const LAS int* tb = (const LAS int*)(F.lds + MOE_TB_OFF); const LAS int* cc = tb + 25;
    if (which == 0) {
        MoeOrder S{layer ? (const char*)(ws + WS_XB) : (const char*)a.out, (const char*)(ws + WS_WGU + layer * WS_MOE_LAYER), (const int*)(ws + WS_LIST), tb, cc, 8, F.G, F.vcu, 0, 0, tb[24] * 8};
        EpiGateUp E{(bf16_t*)(ws + WS_P), (const f32x2*)(ws + WS_LW), tb};
        pg8::gemm_phase<EpiGateUp, MoeOrder, true, true, false>(F.lds, 1024, 1024, 1024, S, E);
        if (layer == 0) {
            __syncthreads();
            const int nGU = tb[24] * 8, start = nGU % F.G;
            if (F.vcu >= start) conv_run<4>(F, a, (F.vcu - start) * NWAVES + F.wave, (F.G - start) * NWAVES);
        }
    } else {
        MoeOrder S{(const char*)(ws + WS_P), (const char*)(ws + WS_WD + layer * WS_MOE_LAYER), (const int*)(ws + WS_LIST), tb, cc, 4, F.G, F.vcu, 1, 0, tb[24] * 4};
        EpiDown E{layer ? (const bf16_t*)(ws + WS_XB) : (const bf16_t*)a.out, (bf16_t*)(ws + WS_XB), (float*)(ws + WS_SSP), (const int*)(ws + WS_LIST), tb};
        pg8::gemm_phase<EpiDown, MoeOrder, true, false, true>(F.lds, 1024, 2048, 1024, S, E);
        if (layer == 0) {
            __syncthreads();
            const int nD = tb[24] * 4, start = nD % F.G;
            if (F.vcu >= start) conv_run<2>(F, a, (F.vcu - start) * NWAVES + F.wave, (F.G - start) * NWAVES);
        }
    }
    __syncthreads();
}
template <int SUB>
__device__ __forceinline__ void moe_sub(Frame& F, const Args& a) {
    unsigned char* ws = a.ws; constexpr int layer = 1;
    moe_setup(F, layer);
    const LAS int* tb = (const LAS int*)(F.lds + MOE_TB_OFF); const LAS int* cc = tb + 25;
    const int nt = tb[24], nGU = nt * 8, nD = nt * 4, full = (nGU / F.G) * F.G, rest = nGU - full;
    int dY = F.G - rest; { const int cap = (full >> 3) * 4; dY = dY < cap ? dY : cap; dY = dY < nD ? dY : nD; }
    if (SUB < 2) {
        MoeOrder S{(const char*)(ws + WS_XB), (const char*)(ws + WS_WGU + layer * WS_MOE_LAYER), (const int*)(ws + WS_LIST), tb, cc, 8, F.G, F.vcu, 0, SUB == 0 ? 0 : full, SUB == 0 ? full : nGU};
        EpiGateUp E{(bf16_t*)(ws + WS_P), (const f32x2*)(ws + WS_LW), tb};
        pg8::gemm_phase<EpiGateUp, MoeOrder, true, true, false>(F.lds, 1024, 1024, 1024, S, E);
    }
    if (SUB > 0) {
        MoeOrder S{(const char*)(ws + WS_P), (const char*)(ws + WS_WD + layer * WS_MOE_LAYER), (const int*)(ws + WS_LIST), tb, cc, 4, SUB == 1 ? F.G - rest : F.G, SUB == 1 ? F.vcu - rest : F.vcu, 1, SUB == 1 ? 0 : dY, SUB == 1 ? dY : nD};
        EpiDown E{(const bf16_t*)(ws + WS_XB), (bf16_t*)(ws + WS_XB), (float*)(ws + WS_SSP), (const int*)(ws + WS_LIST), tb};
        pg8::gemm_phase<EpiDown, MoeOrder, true, false, true>(F.lds, 1024, 2048, 1024, S, E);
    }
    __syncthreads();
}
__device__ __forceinline__ void final_phase(Frame& F, const Args& a) {
    const float* ss = (const float*)(a.ws + WS_SSP); const float* gain = a.in[3]; const bf16_t* H = (const bf16_t*)(a.ws + WS_XB);
    const int gw = F.vcu * NWAVES + F.wave, NGW = F.G * NWAVES;
    f32x4 g4[4];
#pragma unroll
    for (int j = 0; j < 4; ++j) g4[j] = *((const f32x4*)gain + F.lane + 64 * j);
    for (int m = gw; m < T; m += NGW) {
        f32x4* hr = (f32x4*)(a.out + (size_t)m * D) + F.lane;
        const u32x2* hs = (const u32x2*)(H + (size_t)m * D) + F.lane;
        const f32x4* sp = (const f32x4*)(ss + (size_t)m * 32);
        const f32x4 s4 = (sp[0] + sp[1]) + (sp[2] + sp[3]);
        const float rstd = rsqrtf(((s4[0] + s4[1]) + (s4[2] + s4[3])) * (1.0f / D) + RMS_EPS);
#pragma unroll
        for (int j = 0; j < 4; ++j) { const u32x2 q = hs[64 * j]; hr[64 * j] = (f32x4){bflo(q.x), bfhi(q.x), bflo(q.y), bfhi(q.y)} * rstd * g4[j]; }
    }
}

__global__ void __launch_bounds__(NWAVES * 64, 2) mega(Args args) {
    extern __shared__ __attribute__((aligned(16))) unsigned char lds[];
    Frame F;
    F.lds = (LAS unsigned char*)lds;
    F.MISC = (volatile LAS unsigned*)(F.lds + MISC_OFF);
    F.tid = threadIdx.x; F.lane = F.tid & 63; F.wave = __builtin_amdgcn_readfirstlane(F.tid >> 6);
    F.G = gridDim.x; { const int bx = blockIdx.x; F.vcu = (F.G % 8 == 0) ? (bx % 8) * (F.G / 8) + bx / 8 : bx; }
    unsigned char* ws = args.ws;
    F.ctl = (unsigned*)ws;
    for (int u = F.tid; u < (LDS_BYTES - LDSCTL_OFF) / 4; u += NWAVES * 64) ((LAS unsigned*)(F.lds + LDSCTL_OFF))[u] = 0u;
    __syncthreads();
    const int lo = args.ph_lo, hi = args.ph_hi;
    XcdBarrier bar; bar.bar = F.ctl + CW_BAR; bar.x = 0; bar.st = nullptr;
    if (hi - lo > 1) bar = xcd_barrier_post(F.ctl + CW_BAR, F.MISC + 8);
#define IN(k) (lo <= (k) && (k) < hi)
#define SEAM(k) do { if (IN(k) && IN((k) + 1)) xcd_barrier(bar); } while (0)

    if (IN(PH_PROLOGUE)) {
        p0_prologue(F, args); SEAM(PH_PROLOGUE); }
    if (IN(PH_INPROJ)) {
        PlainOrder S; S.init(ws + WS_XB, ws + WS_WIN, 1024, 1024, T, 2560, F.G, (int)blockIdx.x);
        EpiInProj E{(bf16_t*)(ws + WS_P), (const float*)(ws + WS_SS0), (const float*)(ws + WS_ROPE)};
        pg8::gemm_phase<EpiInProj, PlainOrder, true, false, false>(F.lds, 1024, 1024, 1024, S, E);
        { const int nun = (T / 256) * 10, start = nun % F.G, bx = (int)blockIdx.x;
          __syncthreads();
          if (bx >= start) conv_run<3>(F, args, (bx - start) * NWAVES + F.wave, (F.G - start) * NWAVES); }
        SEAM(PH_INPROJ);
    }
    if (IN(PH_MIX_A)) {
        for (int u = F.vcu; u < 256; u += F.G) ret_kv_unit(F.lds, (const bf16_t*)(ws + WS_P), (bf16_t*)(ws + WS_XB), u >> 6, (u >> 4) & 3, u & 15, F.tid);
        for (int t = F.vcu * NWAVES + F.wave; t < 2048; t += F.G * NWAVES)
            s5_task<false>((const bf16_t*)(ws + WS_P), ws + WS_S5T, (float*)(ws + WS_S5END), nullptr, F.lds + F.wave * 8704, t >> 9, (t >> 4) & 31, t & 15, F.lane);
        SEAM(PH_MIX_A);
    }
    if (IN(PH_MIX_B)) {
        for (int u = F.vcu; u < 256; u += F.G) ret_out_unit(F.lds, (const bf16_t*)(ws + WS_P), (const bf16_t*)(ws + WS_XB), (bf16_t*)(ws + WS_MG), u >> 6, (u >> 4) & 3, u & 15, F.tid);
        for (int t = F.vcu * NWAVES + F.wave; t < 2048; t += F.G * NWAVES)
        {   const int v_ = t >> 3, wv_ = t & 7;
            s5_task<true>((const bf16_t*)(ws + WS_P), ws + WS_S5T, (float*)(ws + WS_S5END), (bf16_t*)(ws + WS_XB + 8 * MiB), F.lds + F.wave * 8704, v_ >> 6, (v_ & 3) * 8 + wv_, (v_ >> 2) & 15, F.lane); }
        SEAM(PH_MIX_B);
    }
    if (IN(PH_GLU)) {
        PlainOrder S; S.init(ws + WS_XB + 8 * MiB, ws + WS_WGLU, 512, 512, T, 512, F.G, (int)blockIdx.x);
        EpiGlu E{(const bf16_t*)(ws + WS_XB + 8 * MiB), args.in[15], (bf16_t*)(ws + WS_MG)};
        pg8::gemm_phase<EpiGlu, PlainOrder, true, false, false>(F.lds, 512, 512, 512, S, E);
        { const int nun = (T / 256) * 2, bx = (int)blockIdx.x;
          if (bx >= nun && F.G > nun) conv_run<1>(F, args, (bx - nun) * NWAVES + F.wave, (F.G - nun) * NWAVES);
          else if (F.G <= nun) conv_run<1>(F, args, bx * NWAVES + F.wave, F.G * NWAVES); }
        SEAM(PH_GLU);
    }
    if (IN(PH_OUTPROJ0)) {
        PlainOrder S; S.init(ws + WS_MG, ws + WS_WOUT, 1024, 1024, T, 1024, F.G, (int)blockIdx.x);
        EpiOutRes<true> E{args.in[0], nullptr, (bf16_t*)args.out};
        pg8::gemm_phase<EpiOutRes<true>, PlainOrder, true, false, false>(F.lds, 1024, 1024, 1024, S, E);
        SEAM(PH_OUTPROJ0);
    }
    if (IN(PH_ROUTER0)) { router_phase(F, args, 0); SEAM(PH_ROUTER0); }
    if (IN(PH_GATEUP0)) { moe_phases<false>(F, args, 0, 0); SEAM(PH_GATEUP0); }
    if (IN(PH_DOWN0)) { moe_phases<false>(F, args, 0, 1); SEAM(PH_DOWN0); }
    if (IN(PH_QKV)) {
        PlainOrder S; S.init(ws + WS_XB, ws + WS_WQKV, 1024, 1024, T, 3072, F.G, (int)blockIdx.x);
        EpiQKV E{(bf16_t*)(ws + WS_P), (const float*)(ws + WS_SSP), 0.08838834764831845f * 1.4426950408889634f};
        pg8::gemm_phase<EpiQKV, PlainOrder, true, false, false>(F.lds, 1024, 1024, 1024, S, E);
        SEAM(PH_QKV);
    }
    if (IN(PH_ATTN_AB)) {
        const bf16_t* P = (const bf16_t*)(ws + WS_P); float* lse = (float*)(ws + WS_LSE);
        const int per = (2048 + F.G - 1) / F.G; const int u0 = F.vcu * per, u1 = (u0 + per < 2048) ? u0 + per : 2048;
        u32x4 kreg[8], vreg[8];
#define ATT_DEC_AB(u, b_, h_, r_, n_, d_) const int b_ = (u) < 1024 ? (u) >> 8 : ((u) - 1024) >> 8, h_ = (u) < 1024 ? ((u) >> 5) & 7 : (((u) - 1024) >> 5) & 7, r_ = (u) < 1024 ? 0 : (((u) - 1024) >> 3) & 3, n_ = (u) < 1024 ? (u) & 31 : ((u) - 1024) & 7, d_ = (u) < 1024 ? 1 : 4
        bool full = true;
        if (u0 < u1) { ATT_DEC_AB(u0, b0, h0, r0, n0, d0); attn_load(P, b0, h0, r0, n0, d0, F.tid, true, kreg, vreg); }
#pragma unroll 1
        for (int u = u0; u < u1; ++u) {
            ATT_DEC_AB(u, bc, hc, rc, nc, dc);
            attn_store(F.lds, F.tid, nc, full, kreg, vreg);
            __syncthreads();
            bf16x8 qf[4]; attn_loadq(P, bc, hc, rc, nc, dc, F.tid, qf);
            if (u + 1 < u1) { ATT_DEC_AB(u + 1, b1, h1, r1, n1, d1);
                full = !(b1 == bc && h1 == hc && r1 == rc && d1 == dc && n1 == nc + 1);
                attn_load(P, b1, h1, r1, n1, d1, F.tid, full, kreg, vreg); }
            attn_compute<false>(F.lds, P, (u < 1024 ? (bf16_t*)args.out + (size_t)T * D : (bf16_t*)(ws + WS_MG)), lse + (u < 1024 ? 0 : (size_t)T * 8), nullptr, nullptr, nullptr, nullptr, bc, hc, rc, nc, dc, F.tid, qf);
            __syncthreads();
        }
        SEAM(PH_ATTN_AB);
    }
    if (IN(PH_ATTN_C)) {
        const bf16_t* P = (const bf16_t*)(ws + WS_P); float* lse = (float*)(ws + WS_LSE);
        const int per = (1024 + F.G - 1) / F.G; const int u0 = F.vcu * per, u1 = (u0 + per < 1024) ? u0 + per : 1024;
        u32x4 kreg[8], vreg[8];
        bool full = true;
        if (u0 < u1) attn_load(P, u0 >> 8, (u0 >> 5) & 7, (u0 >> 1) & 15, u0 & 1, 16, F.tid, true, kreg, vreg);
#pragma unroll 1
        for (int u = u0; u < u1; ++u) {
            attn_store(F.lds, F.tid, u & 1, full, kreg, vreg);
            __syncthreads();
            bf16x8 qf[4]; attn_loadq(P, u >> 8, (u >> 5) & 7, (u >> 1) & 15, u & 1, 16, F.tid, qf);
            if (u + 1 < u1) { full = !(((u + 1) >> 1) == (u >> 1) && ((u + 1) & 1) == (u & 1) + 1);
                attn_load(P, (u + 1) >> 8, ((u + 1) >> 5) & 7, ((u + 1) >> 1) & 15, (u + 1) & 1, 16, F.tid, full, kreg, vreg); }
            attn_compute<true>(F.lds, P, (bf16_t*)(ws + WS_MG), nullptr, (const bf16_t*)args.out + (size_t)T * D, (const bf16_t*)(ws + WS_MG), lse, lse + (size_t)T * 8, u >> 8, (u >> 5) & 7, (u >> 1) & 15, u & 1, 16, F.tid, qf);
            __syncthreads();
        }
        SEAM(PH_ATTN_C);
    }
    if (IN(PH_OUTPROJ1)) {
        PlainOrder S; S.init(ws + WS_MG, ws + WS_CWOUT, 1024, 1024, T, 1024, F.G, (int)blockIdx.x);
        EpiOutRes<false> E{nullptr, (const bf16_t*)(ws + WS_XB), (bf16_t*)(ws + WS_XB)};
        pg8::gemm_phase<EpiOutRes<false>, PlainOrder, true, false, false>(F.lds, 1024, 1024, 1024, S, E);
        SEAM(PH_OUTPROJ1);
    }
    if (IN(PH_ROUTER1)) { router_phase(F, args, 1); SEAM(PH_ROUTER1); }
    if (IN(PH_MOE1X)) { moe_sub<0>(F, args); SEAM(PH_MOE1X); }
    if (IN(PH_MOE1Y)) { moe_sub<1>(F, args); SEAM(PH_MOE1Y); }
    if (IN(PH_MOE1Z)) { moe_sub<2>(F, args); SEAM(PH_MOE1Z); }
    if (IN(PH_FINAL)) { final_phase(F, args); }
#undef IN
#undef SEAM
}

extern "C" void kernel_launch(void* const* d_in, const int* in_sizes, int n_in, void* d_out, int out_size, void* d_ws, size_t ws_size, hipStream_t stream) {
    static int grid = 0;
    if (grid == 0) {
        if (ws_size < WS_END || n_in != 25) { fprintf(stderr, "kernel_launch: ws %zu < %zu or n_in %d\n", ws_size, (size_t)WS_END, n_in); grid = -1; return; }
        int dev = 0, cus = 0;
        if (hipGetDevice(&dev) != hipSuccess || hipDeviceGetAttribute(&cus, hipDeviceAttributeMultiprocessorCount, dev) != hipSuccess) { grid = -1; return; }
        if (hipFuncSetAttribute((const void*)mega, hipFuncAttributeMaxDynamicSharedMemorySize, LDS_BYTES) != hipSuccess) { fprintf(stderr, "hipFuncSetAttribute failed\n"); grid = -1; return; }
        int per_cu = 0;
        if (hipOccupancyMaxActiveBlocksPerMultiprocessor(&per_cu, (const void*)mega, NWAVES * 64, LDS_BYTES) != hipSuccess || per_cu < 1) fprintf(stderr, "occupancy query says %d\n", per_cu);
        (void)hipGetLastError();
        grid = cus;
    }
    if (grid < 0) return;
    unsigned char* ws = (unsigned char*)d_ws;
    (void)hipMemsetAsync(ws, 0, CTL_ZERO_BYTES, stream);
    Args a{};
    for (int i = 0; i < 25; ++i) a.in[i] = (const float*)d_in[i];
    a.out = (float*)d_out; a.ws = ws;
    a.ph_lo = 0; a.ph_hi = PH_COUNT;
    hipLaunchKernelGGL(mega, dim3(grid), dim3(NWAVES * 64), LDS_BYTES, stream, a);
}
```

```cpp
#include <hip/hip_runtime.h>
#include <stdint.h>
#include <stdio.h>

#define LAS __attribute__((address_space(3)))
#define GAS __attribute__((address_space(1)))
typedef unsigned short bf16_t;
typedef short bf16x8 __attribute__((ext_vector_type(8)));
typedef short s16x4 __attribute__((ext_vector_type(4)));
typedef float f32x4 __attribute__((ext_vector_type(4)));
typedef float f32x2 __attribute__((ext_vector_type(2)));
typedef float f32x16 __attribute__((ext_vector_type(16)));
typedef unsigned u32x4 __attribute__((ext_vector_type(4)));
typedef unsigned u32x2 __attribute__((ext_vector_type(2)));

__device__ __forceinline__ float bf2f(bf16_t v) { return __uint_as_float(((unsigned)v) << 16); }
__device__ __forceinline__ unsigned f2bf(float f) { unsigned u = __float_as_uint(f); return (u + 0x7fffu + ((u >> 16) & 1u)) >> 16; }
__device__ __forceinline__ unsigned pk2(float lo, float hi) { return f2bf(lo) | (f2bf(hi) << 16); }
__device__ __forceinline__ float bflo(unsigned w) { return __uint_as_float(w << 16); }
__device__ __forceinline__ float bfhi(unsigned w) { return __uint_as_float(w & 0xffff0000u); }
__device__ __forceinline__ float wave_sum(float v) {
#pragma unroll
    for (int o = 1; o < 64; o <<= 1) v += __shfl_xor(v, o);
    return v;
}
__device__ __forceinline__ float dpp_add(float v, int ctrl_sel) {
    const int x = __float_as_int(v); int y;
    if (ctrl_sel == 0) y = __builtin_amdgcn_update_dpp(0, x, 0xB1, 0xF, 0xF, false);
    else if (ctrl_sel == 1) y = __builtin_amdgcn_update_dpp(0, x, 0x4E, 0xF, 0xF, false);
    else if (ctrl_sel == 2) y = __builtin_amdgcn_update_dpp(0, x, 0x124, 0xF, 0xF, false);
    else y = __builtin_amdgcn_update_dpp(0, x, 0x128, 0xF, 0xF, false);
    return v + __int_as_float(y);
}
__device__ __forceinline__ float wave_allsum(float v) {
    v = dpp_add(v, 0); v = dpp_add(v, 1); v = dpp_add(v, 2); v = dpp_add(v, 3);
    {   const auto r = __builtin_amdgcn_permlane16_swap(__float_as_uint(v), __float_as_uint(v), false, false);
        v = __uint_as_float(r[0]) + __uint_as_float(r[1]);
        const auto q = __builtin_amdgcn_permlane32_swap(__float_as_uint(v), __float_as_uint(v), false, false);
        v = __uint_as_float(q[0]) + __uint_as_float(q[1]); }
    return v;
}
__device__ __forceinline__ float fast_sigmoid(float x) { return __builtin_amdgcn_rcpf(1.0f + __builtin_amdgcn_exp2f(-1.4426950408889634f * x)); }

namespace pg8 {
constexpr int BM = 256, BK = 64, HALF = 128, HTB = HALF * BK * 2, STAGE_BYTES = 8 * HTB;
__host__ __device__ __forceinline__ int lds_byte(int r, int c) { const int st = (r >> 4) * 2 + (c >> 5), rr = r & 15, cc = c & 31, ob = rr * 64 + cc * 2; return st * 1024 + (ob ^ (((ob >> 9) & 1) << 5)); }
__host__ __device__ __forceinline__ void stage_rc(int b, int& R, int& C) { const int st = b / 1024, sb = b % 1024, swz = sb ^ (((sb >> 9) & 1) << 5); R = (st >> 1) * 16 + swz / 64; C = (st & 1) * 32 + (swz % 64) / 2; }
__host__ __device__ __forceinline__ int perm32(int rho) { const int n = rho >> 4, i = rho & 15; return 8 * (i >> 2) + 4 * n + (i & 3); }

struct Unit { int pm, pn, cls, nvalid; };

__device__ __forceinline__ unsigned cvt_pk_bf16(float lo, float hi) { unsigned r; asm volatile("s_nop 1\n\tv_cvt_pk_bf16_f32 %0, %1, %2" : "=v"(r) : "v"(lo), "v"(hi)); return r; }
typedef __bf16 bf16x2_t __attribute__((ext_vector_type(2)));
__device__ __forceinline__ unsigned cvt_pk_bf16_c(float lo, float hi) { f32x2 v = {lo, hi}; bf16x2_t b = __builtin_convertvector(v, bf16x2_t); return __builtin_bit_cast(unsigned, b); }

template <class Epi, class Sched, bool ALIGN_EPI, bool GATHER, bool BJUMP>
__device__ __forceinline__ void gemm_phase(LAS unsigned char* lds, const int lda, const int ldb, const int K, const Sched& S, const Epi& E) {
    const int tid = threadIdx.x, wid = __builtin_amdgcn_readfirstlane(tid >> 6), lane = tid & 63, wr = wid >> 2, wc = wid & 3, fr = lane & 15, fq = lane >> 4;
    const int nt = K / BK;
    int Rr[2], Cc[2];
    unsigned voffA[2], voffB[2];
#pragma unroll
    for (int i = 0; i < 2; ++i) { int R, C; stage_rc(tid * 16 + i * 8192, R, C); const int Rb = Epi::PERM ? ((R & ~31) + perm32(R & 31)) : R;
        Rr[i] = R; Cc[i] = C;
        voffA[i] = (unsigned)(R * lda + C) * 2u; voffB[i] = (unsigned)(Rb * ldb + C) * 2u; }
    const size_t kstep = (size_t)(BK * 2);
    const size_t hstepA = GATHER ? 0 : (size_t)HALF * lda * 2, hstepB = (size_t)HALF * ldb * 2;
    const unsigned ldsw = (unsigned)wid * 1024u;
    const int aoff = lds_byte(wr * 64 + fr, fq * 8), boff = lds_byte(wc * 32 + fr, fq * 8);
#define PG8_SA(b, h) (((b) * 2 + (h)) * HTB)
#define PG8_SB(b, h) ((4 + (b) * 2 + (h)) * HTB)
#define PG8_STG(bufoff, gbase, o0, o1) do { \
        __builtin_amdgcn_global_load_lds((const unsigned*)((const char*)(gbase) + (o0)), (LAS unsigned*)(lds + (bufoff) + ldsw), 16, 0, 0); \
        __builtin_amdgcn_global_load_lds((const unsigned*)((const char*)(gbase) + (o1)), (LAS unsigned*)(lds + (bufoff) + ldsw + 8192), 16, 0, 0); } while (0)
#define PG8_STGB(bufoff, gbase) PG8_STG(bufoff, gbase, voffB[0], voffB[1])
#define PG8_STGA_CUR(bufoff, gbase, h) PG8_STG(bufoff, (gbase) + (h) * hstepA, GATHER ? gvc[h][0] : voffA[0], GATHER ? gvc[h][1] : voffA[1])
#define PG8_STGA_SEL(bufoff, gbase, h) PG8_STG(bufoff, (gbase) + (h) * hstepA, GATHER ? gvs[h][0] : voffA[0], GATHER ? gvs[h][1] : voffA[1])
#define PG8_LDA(dst, b, h) do { _Pragma("unroll") for (int m = 0; m < 4; ++m) _Pragma("unroll") for (int k = 0; k < 2; ++k) dst[m][k] = *(const LAS bf16x8*)(lds + PG8_SA(b, h) + aoff + m * 2048 + k * 1024); } while (0)
#define PG8_LDB(dst, b, h) do { _Pragma("unroll") for (int n = 0; n < 2; ++n) _Pragma("unroll") for (int k = 0; k < 2; ++k) dst[n][k] = *(const LAS bf16x8*)(lds + PG8_SB(b, h) + boff + n * 2048 + k * 1024); } while (0)
#define PG8_MMA(ai, bj, At, Bt) do { __builtin_amdgcn_s_setprio(1); _Pragma("unroll") for (int m = 0; m < 4; ++m) _Pragma("unroll") for (int n = 0; n < 2; ++n) _Pragma("unroll") for (int k = 0; k < 2; ++k) \
        acc[ai][bj][m][n] = __builtin_amdgcn_mfma_f32_16x16x32_bf16(Bt[n][k], At[m][k], acc[ai][bj][m][n], 0, 0, 0); __builtin_amdgcn_s_setprio(0); } while (0)
#define PG8_WAIT_V(n) asm volatile("s_waitcnt vmcnt(" #n ")" ::: "memory")
#define PG8_WAIT_L(n) asm volatile("s_waitcnt lgkmcnt(" #n ")" ::: "memory")
#define PG8_BAR __builtin_amdgcn_s_barrier()
#define PG8_SCHED __builtin_amdgcn_sched_barrier(0)
    Unit cur, nxt; int ui = 0;
    if (!S.next(0, cur)) return;
    f32x4 acc[2][2][4][2];
#pragma unroll
    for (int a = 0; a < 2; ++a)
#pragma unroll
        for (int b = 0; b < 2; ++b)
#pragma unroll
            for (int m = 0; m < 4; ++m)
#pragma unroll
                for (int n = 0; n < 2; ++n) acc[a][b][m][n] = (f32x4){0.f, 0.f, 0.f, 0.f};
    bf16x8 At[4][2], B0[2][2], B1[2][2];
    unsigned gvc[2][2], gvn[2][2], gvs[2][2];
    const char* cA = S.a_base(cur); const char* cB = S.b_base(cur);
    long cJ = 0;
    if constexpr (BJUMP) cJ = S.b_jump(cur);
    if constexpr (GATHER) { S.a_voff(cur, Rr[0], Rr[1], Cc[0], Cc[1], gvc); }
    else { gvc[0][0] = gvc[0][1] = gvc[1][0] = gvc[1][1] = 0u; }
    PG8_STGB(PG8_SB(0, 0), cB); PG8_STGB(PG8_SB(0, 1), cB + hstepB); PG8_STGA_CUR(PG8_SA(0, 0), cA, 0); PG8_STGA_CUR(PG8_SA(0, 1), cA, 1);
    if (wr == 1) PG8_BAR;
    PG8_WAIT_V(2); PG8_BAR;
    PG8_STGB(PG8_SB(1, 0), cB + kstep); PG8_STGA_CUR(PG8_SA(1, 0), cA + kstep, 0); PG8_STGB(PG8_SB(1, 1), cB + hstepB + kstep);
    PG8_WAIT_V(6); PG8_BAR;
    for (;;) {
        const bool has_next = S.next(ui + 1, nxt);
        const char* nA = has_next ? S.a_base(nxt) : cA; const char* nB = has_next ? S.b_base(nxt) : cB;
        if constexpr (GATHER) { if (has_next) S.a_voff(nxt, Rr[0], Rr[1], Cc[0], Cc[1], gvn); else { gvn[0][0] = gvc[0][0]; gvn[0][1] = gvc[0][1]; gvn[1][0] = gvc[1][0]; gvn[1][1] = gvc[1][1]; } }
        for (int t = 0; t < nt; t += 2) {
            const bool last = (t == nt - 2);
            const char* a1 = cA + (size_t)(t + 1) * kstep;
            const char* a2 = last ? nA : cA + (size_t)(t + 2) * kstep;
            const char* b2 = last ? nB : cB + (size_t)(t + 2) * kstep + ((BJUMP && (t + 2) >= 8) ? cJ : 0);
            const char* a3 = a2 + kstep; const char* b3 = b2 + kstep;
            if constexpr (GATHER) {
#pragma unroll
                for (int h = 0; h < 2; ++h)
#pragma unroll
                    for (int i = 0; i < 2; ++i) gvs[h][i] = last ? gvn[h][i] : gvc[h][i];
            }
            PG8_LDB(B0, 0, 0); PG8_LDB(B1, 0, 1); PG8_SCHED; PG8_LDA(At, 0, 0); PG8_STGA_CUR(PG8_SA(1, 1), a1, 1);
            PG8_WAIT_V(8); PG8_WAIT_L(0); PG8_BAR; PG8_MMA(0, 0, At, B0); PG8_MMA(0, 1, At, B1); PG8_BAR; PG8_SCHED;
            PG8_LDA(At, 0, 1); PG8_STGB(PG8_SB(0, 0), b2); PG8_STGB(PG8_SB(0, 1), b2 + hstepB); PG8_STGA_SEL(PG8_SA(0, 0), a2, 0);
            PG8_WAIT_V(8); PG8_WAIT_L(0); PG8_BAR; PG8_MMA(1, 0, At, B0); PG8_MMA(1, 1, At, B1); PG8_BAR; PG8_SCHED;
            PG8_LDB(B0, 1, 0); PG8_LDB(B1, 1, 1); PG8_SCHED; PG8_LDA(At, 1, 0); PG8_STGA_SEL(PG8_SA(0, 1), a2, 1);
            PG8_WAIT_V(8); PG8_WAIT_L(0); PG8_BAR; PG8_MMA(0, 0, At, B0); PG8_MMA(0, 1, At, B1); PG8_BAR; PG8_SCHED;
            PG8_LDA(At, 1, 1); PG8_STGB(PG8_SB(1, 0), b3); PG8_STGB(PG8_SB(1, 1), b3 + hstepB); PG8_STGA_SEL(PG8_SA(1, 0), a3, 0);
            PG8_WAIT_V(8); PG8_WAIT_L(0); PG8_BAR; PG8_MMA(1, 0, At, B0); PG8_MMA(1, 1, At, B1); PG8_BAR; PG8_SCHED;
        }
        if constexpr (ALIGN_EPI) { if (wr == 0) PG8_BAR; }
        E(acc, cur, wr, wc, fr, fq);
        if (!has_next) break;
#pragma unroll
        for (int a = 0; a < 2; ++a)
#pragma unroll
            for (int b = 0; b < 2; ++b)
#pragma unroll
                for (int m = 0; m < 4; ++m)
#pragma unroll
                    for (int n = 0; n < 2; ++n) acc[a][b][m][n] = (f32x4){0.f, 0.f, 0.f, 0.f};
        cur = nxt; cA = nA; cB = nB; ++ui;
        if constexpr (BJUMP) cJ = S.b_jump(cur);
        if constexpr (GATHER) { gvc[0][0] = gvn[0][0]; gvc[0][1] = gvn[0][1]; gvc[1][0] = gvn[1][0]; gvc[1][1] = gvn[1][1]; }
        if constexpr (ALIGN_EPI) { if (wr == 1) PG8_BAR; }
    }
    PG8_WAIT_V(0);
    if constexpr (!ALIGN_EPI) { if (wr == 0) PG8_BAR; }
    PG8_BAR;
#undef PG8_SA
#undef PG8_SB
#undef PG8_STG
#undef PG8_STGB
#undef PG8_STGA_CUR
#undef PG8_STGA_SEL
#undef PG8_LDA
#undef PG8_LDB
#undef PG8_MMA
#undef PG8_WAIT_V
#undef PG8_WAIT_L
#undef PG8_BAR
#undef PG8_SCHED
}
}
constexpr int T = 16384, D = 1024, L = 4096, NB = 4;
constexpr int NWAVES = 8;
constexpr size_t MiB = 1u << 20;
constexpr int CW_BAR = 4096;
constexpr int CW_CLS0 = 8192, CW_CLS1 = 10240; constexpr int CW_CK = 14000;
constexpr size_t WS_SS1 = 64 * 1024;
constexpr size_t WS_SS0 = 128 * 1024;
constexpr size_t WS_SS2 = 192 * 1024;
constexpr size_t CTL_ZERO_BYTES = 1 * MiB;
constexpr size_t WS_TOK = 1 * MiB;
constexpr size_t WS_LIST = 2 * MiB;
constexpr size_t WS_TOKW = 3 * MiB + 512 * 1024;
constexpr size_t WS_TOKC = 3 * MiB + 640 * 1024;
constexpr size_t WS_RTW = 3 * MiB + 768 * 1024;
constexpr size_t WS_CNTWG = 3 * MiB + 704 * 1024;
constexpr size_t WS_ROPE = 4 * MiB;
constexpr size_t WS_S5T = 6 * MiB;
constexpr size_t WS_S5END = 1 * MiB;
constexpr size_t WS_LW = 7 * MiB;
constexpr size_t WS_SSP = 284 * MiB;
constexpr size_t WS_LSE = 11 * MiB;
constexpr size_t WS_WIN = 12 * MiB;
constexpr size_t WS_WOUT = 17 * MiB;
constexpr size_t WS_WGLU = 19 * MiB;
constexpr size_t WS_WQKV = 20 * MiB;
constexpr size_t WS_CWOUT = 26 * MiB;
constexpr size_t WS_WGU = 28 * MiB;
constexpr size_t WS_WD = 60 * MiB;
constexpr size_t WS_MOE_LAYER = 48 * MiB;
constexpr size_t WS_XB = 124 * MiB;
constexpr size_t WS_MG = 156 * MiB;
constexpr size_t WS_P = 188 * MiB;
constexpr size_t WS_END = 286 * MiB;

constexpr int RING_BYTES = 131072;
constexpr int LDSCTL_OFF = RING_BYTES, MISC_OFF = LDSCTL_OFF + 320;
constexpr int MOE_TB_OFF = LDSCTL_OFF + 512;
constexpr int LDS_BYTES = 147456;

#define RLX_AGENT __ATOMIC_RELAXED, __HIP_MEMORY_SCOPE_AGENT
#define LDS_WAIT() asm volatile("s_waitcnt lgkmcnt(0)" ::: "memory")
#define VM_WAIT() asm volatile("s_waitcnt vmcnt(0)" ::: "memory")

#define XB_TMO      128
#define XB_XCNT(j)  (256  + 64 * (j))
#define XB_XSUB(j)  (1280 + 64 * (j))
#define XB_XGEN(j)  (2304 + 64 * (j))
#define XB_TOP      3328
#define XB_TOPGEN   3392
#define XCD_BAR_WORDS 3456
#define XB_SPIN_CAP (1u << 18)
__device__ __forceinline__ unsigned xb_ld(unsigned* p)              { return __hip_atomic_load(p, __ATOMIC_RELAXED, __HIP_MEMORY_SCOPE_AGENT); }
__device__ __forceinline__ unsigned xb_add(unsigned* p, unsigned v) { return __hip_atomic_fetch_add(p, v, __ATOMIC_RELAXED, __HIP_MEMORY_SCOPE_AGENT); }
__device__ __forceinline__ unsigned xb_xcc_id() { return (unsigned)__builtin_amdgcn_s_getreg((3 << 11) | 20) & 0xFu; }
#define XB_SPIN(cond, bar) do { unsigned _sp = 0; while (cond) { __builtin_amdgcn_s_sleep(1); \
    if ((++_sp & 255u) == 0u) { if (xb_ld(&(bar)[XB_TMO])) break; if (_sp > XB_SPIN_CAP) { atomicAdd(&(bar)[XB_TMO], 1u); break; } } } } while (0)
struct XcdBarrier { unsigned* bar; unsigned x; volatile LAS unsigned* st; };
__device__ __forceinline__ XcdBarrier xcd_barrier_post(unsigned* bar, volatile LAS unsigned* st) {
    XcdBarrier b; b.bar = bar; b.x = xb_xcc_id(); b.st = st;
    if (threadIdx.x == 0) (void)xb_add(&bar[XB_XCNT(b.x)], 1u);
    return b;
}
__device__ __forceinline__ void xcd_barrier_complete(unsigned* bar, unsigned x, unsigned& nloc, unsigned& nx) {
    const unsigned G = gridDim.x * gridDim.y * gridDim.z;
    unsigned sum, cnt, mine, sp = 0u;
    for (;;) {
        sum = 0u; cnt = 0u; mine = 0u;
#pragma unroll
        for (unsigned j = 0; j < 16; ++j) { const unsigned c = xb_ld(&bar[XB_XCNT(j)]); sum += c; cnt += (c > 0u) ? 1u : 0u; mine = (j == x) ? c : mine; }
        if (sum == G) break;
        __builtin_amdgcn_s_sleep(1);
        if ((++sp & 255u) == 0u) { if (xb_ld(&bar[XB_TMO])) break; if (sp > XB_SPIN_CAP) { atomicAdd(&bar[XB_TMO], 1u); break; } }
    }
    nloc = mine > 0u ? mine : 1u; nx = cnt > 0u ? cnt : 1u;
}
__device__ __forceinline__ void xcd_barrier(const XcdBarrier& b) {
    asm volatile("s_waitcnt vmcnt(0)" ::: "memory");
    __syncthreads();
    if (threadIdx.x == 0) {
        unsigned* bar = b.bar;
        __builtin_amdgcn_s_waitcnt(0);
        unsigned nloc = b.st[0], nx = b.st[1];
        if (nloc == 0u) { xcd_barrier_complete(bar, b.x, nloc, nx); b.st[0] = nloc; b.st[1] = nx; }
        const unsigned old = xb_add(&bar[XB_XSUB(b.x)], 1u);
        const unsigned gen = old / nloc;
        if (old + 1u == (gen + 1u) * nloc) {
            __builtin_amdgcn_fence(__ATOMIC_RELEASE, "agent");
            asm volatile("s_waitcnt vmcnt(0)" ::: "memory");
            const unsigned og = xb_add(&bar[XB_TOP], 1u);
            const unsigned tg = og / nx;
            if (og + 1u == (tg + 1u) * nx) xb_add(&bar[XB_TOPGEN], 1u);
            else XB_SPIN(xb_ld(&bar[XB_TOPGEN]) == tg, bar);
            __builtin_amdgcn_fence(__ATOMIC_ACQUIRE, "agent");
            xb_add(&bar[XB_XGEN(b.x)], 1u);
            asm volatile("s_waitcnt vmcnt(0)" ::: "memory");
        } else {
            XB_SPIN(xb_ld(&bar[XB_XGEN(b.x)]) == gen, bar);
            __builtin_amdgcn_fence(__ATOMIC_ACQUIRE, "agent");
            asm volatile("s_waitcnt vmcnt(0)" ::: "memory");
        }
    }
    __syncthreads();
}

struct PlainOrder {
    const char* A; const char* Bt; int lda, ldb; int nM, nN, nwg, G, c;
    __device__ void init(const void* A_, const void* Bt_, int lda_, int ldb_, int M, int N, int G_, int c_) { A = (const char*)A_; Bt = (const char*)Bt_; lda = lda_; ldb = ldb_; nM = M / 256; nN = N / 256; nwg = nM * nN; G = G_; c = c_; }
    __device__ bool next(int i, pg8::Unit& u) const {
        const long Lx = (long)i * G + c; if (Lx >= nwg) return false;
        int wgid = (int)Lx; { const int q = nwg / 8, r = nwg % 8, xcd = wgid % 8, off = wgid / 8; wgid = (xcd < r ? xcd * (q + 1) : r * (q + 1) + (xcd - r) * q) + off; }
        const int nig = 8 * nN, gid = wgid / nig, fm = gid * 8, gsz = (nM - fm) < 8 ? (nM - fm) : 8;
        u.pm = fm + ((wgid % nig) % gsz); u.pn = (wgid % nig) / gsz; u.cls = 0; u.nvalid = 256; return true;
    }
    __device__ __forceinline__ const char* a_base(const pg8::Unit& u) const { return A + (size_t)u.pm * 256 * lda * 2; }
    __device__ __forceinline__ const char* b_base(const pg8::Unit& u) const { return Bt + (size_t)u.pn * 256 * ldb * 2; }
    __device__ __forceinline__ long b_jump(const pg8::Unit&) const { return 0; }
    __device__ __forceinline__ void a_voff(const pg8::Unit&, int, int, int, int, unsigned (&)[2][2]) const {}
};

using pg8::Unit; using pg8::cvt_pk_bf16; using pg8::cvt_pk_bf16_c;
constexpr float RMS_EPS = 1e-6f;
struct EpiInProj {
    static constexpr bool PERM = true;
    bf16_t* P; const float* ss; const float* rope;
    __device__ __forceinline__ void operator()(const f32x4 (&acc)[2][2][4][2], const Unit& u, int wr, int wc, int fr, int fq) const {
        const int row0 = u.pm * 256 + wr * 64 + fr; const int tile = u.pn;
        float ssv[8];
#pragma unroll
        for (int it = 0; it < 8; ++it) ssv[it] = ss[row0 + (it >> 2) * 128 + (it & 3) * 16];
#pragma unroll
        for (int ai = 0; ai < 2; ++ai)
#pragma unroll
            for (int m = 0; m < 4; ++m) {
                const int row = row0 + ai * 128 + m * 16;
                const float rstd = rsqrtf(ssv[ai * 4 + m] * (1.0f / D) + RMS_EPS);
                bf16_t* rowp = P + (size_t)row * 2560 + tile * 256;
#pragma unroll
                for (int bj = 0; bj < 2; ++bj) {
                    const int cb = bj * 128 + wc * 32 + 8 * fq;
                    f32x4 v0 = acc[ai][bj][m][0] * rstd, v1 = acc[ai][bj][m][1] * rstd;
                    if (tile < 4) {
                        const int i4 = (cb & 127) >> 1;
                        const int pos = row & (L - 1);
                        const f32x4 cs = *(const f32x4*)(rope + (size_t)pos * 64 + i4), sn = *(const f32x4*)(rope + (size_t)L * 64 + (size_t)pos * 64 + i4);
                        f32x4 o1 = v0 * cs - v1 * sn, o2 = v0 * sn + v1 * cs;
                        if (tile >= 2) { o1 = o1 * 0.08838834764831845f; o2 = o2 * 0.08838834764831845f; }
                        u32x2 w1, w2; w1.x = cvt_pk_bf16(o1[0], o1[1]); w1.y = cvt_pk_bf16(o1[2], o1[3]); w2.x = cvt_pk_bf16(o2[0], o2[1]); w2.y = cvt_pk_bf16(o2[2], o2[3]);
                        const auto sx = __builtin_amdgcn_permlane16_swap(w1.x, w2.x, false, false);
                        const auto sy = __builtin_amdgcn_permlane16_swap(w1.y, w2.y, false, false);
                        u32x4 wv; wv.x = sx[0]; wv.y = sy[0]; wv.z = sx[1]; wv.w = sy[1];
                        bf16_t* hp = rowp + (cb & 128) + wc * 16 + 4 * (fq & 2) + (fq & 1) * 64;
                        *(u32x4*)hp = wv;
                    } else {
                        if (tile == 6 || tile == 7) {
#pragma unroll
                            for (int e = 0; e < 4; ++e) { v0[e] = v0[e] * fast_sigmoid(v0[e]); v1[e] = v1[e] * fast_sigmoid(v1[e]); }
                        }
                        u32x4 w; w.x = cvt_pk_bf16(v0[0], v0[1]); w.y = cvt_pk_bf16(v0[2], v0[3]); w.z = cvt_pk_bf16(v1[0], v1[1]); w.w = cvt_pk_bf16(v1[2], v1[3]);
                        *(u32x4*)(rowp + cb) = w;
                    }
                }
            }
    }
};

struct EpiQKV {
    static constexpr bool PERM = true;
    bf16_t* P; const float* ss; float qscale;
    __device__ __forceinline__ void operator()(const f32x4 (&acc)[2][2][4][2], const Unit& u, int wr, int wc, int fr, int fq) const {
        const int row0 = u.pm * 256 + wr * 64 + fr;
        const float sc = (u.pn < 4) ? qscale : 1.0f;
#pragma unroll
        for (int ai = 0; ai < 2; ++ai)
#pragma unroll
            for (int m = 0; m < 4; ++m) {
                const int row = row0 + ai * 128 + m * 16;
                const f32x4* sp = (const f32x4*)(ss + (size_t)row * 32);
                const f32x4 s4 = (sp[0] + sp[1]) + (sp[2] + sp[3]);
                const float rstd = rsqrtf(((s4[0] + s4[1]) + (s4[2] + s4[3])) * (1.0f / D) + RMS_EPS) * sc;
                bf16_t* rowp = P + (size_t)row * 3072 + u.pn * 256 + wc * 32 + 8 * fq;
#pragma unroll
                for (int bj = 0; bj < 2; ++bj) {
                    const f32x4 v0 = acc[ai][bj][m][0] * rstd, v1 = acc[ai][bj][m][1] * rstd;
                    u32x4 w; w.x = cvt_pk_bf16(v0[0], v0[1]); w.y = cvt_pk_bf16(v0[2], v0[3]); w.z = cvt_pk_bf16(v1[0], v1[1]); w.w = cvt_pk_bf16(v1[2], v1[3]);
                    *(u32x4*)(rowp + bj * 128) = w;
                }
            }
    }
};
template <bool RF32>
struct EpiOutRes {
    static constexpr bool PERM = true;
    const float* residf; const bf16_t* residb; bf16_t* Hout;
    __device__ __forceinline__ void operator()(const f32x4 (&acc)[2][2][4][2], const Unit& u, int wr, int wc, int fr, int fq) const {
        const int row0 = u.pm * 256 + wr * 64 + fr;
#pragma unroll
        for (int ai = 0; ai < 2; ++ai)
#pragma unroll
            for (int m = 0; m < 4; ++m) {
                const size_t off = (size_t)(row0 + ai * 128 + m * 16) * D + u.pn * 256 + wc * 32 + 8 * fq;
#pragma unroll
                for (int bj = 0; bj < 2; ++bj) {
                    f32x4 r0, r1;
                    if (RF32) { r0 = *(const f32x4*)(residf + off + bj * 128); r1 = *(const f32x4*)(residf + off + bj * 128 + 4); }
                    else { const u32x4 q = *(const u32x4*)(residb + off + bj * 128); r0 = (f32x4){bflo(q.x), bfhi(q.x), bflo(q.y), bfhi(q.y)}; r1 = (f32x4){bflo(q.z), bfhi(q.z), bflo(q.w), bfhi(q.w)}; }
                    const f32x4 o0 = r0 + acc[ai][bj][m][0], o1 = r1 + acc[ai][bj][m][1];
                    u32x4 w; w.x = cvt_pk_bf16(o0[0], o0[1]); w.y = cvt_pk_bf16(o0[2], o0[3]); w.z = cvt_pk_bf16(o1[0], o1[1]); w.w = cvt_pk_bf16(o1[2], o1[3]);
                    *(u32x4*)(Hout + off + bj * 128) = w;
                }
            }
    }
};

__device__ __forceinline__ void cls_decode(int cls, int& g, int& lo, int& hi) { g = cls / 6; const int p = cls - 6 * g; lo = p < 3 ? 0 : (p < 5 ? 1 : 2); hi = p < 3 ? p + 1 : (p < 5 ? p - 1 : 3); }
struct MoeOrder {
    const char* A; const char* Bt; const int* list; const LAS int* tb; const LAS int* cc; int NPN, G, c, down, lo, hi;
    __device__ bool next(int i, pg8::Unit& u) const {
        const int idx = lo + i * G + c; if (c < 0 || idx >= hi) return false;
        const int ct = idx / NPN; int k = 0;
#pragma unroll 1
        for (int j = 1; j < 24; ++j) if (ct >= tb[j]) k = j;
        u.pm = ct; u.pn = idx - ct * NPN; u.cls = k; const int rem = cc[k] - (ct - tb[k]) * 256; u.nvalid = rem < 256 ? rem : 256; return true;
    }
    __device__ __forceinline__ const char* a_base(const pg8::Unit& u) const { return down ? A + (size_t)u.pm * 256 * 1024 * 2 : A; }
    __device__ __forceinline__ const char* b_base(const pg8::Unit& u) const {
        int g, lo, hi; cls_decode(u.cls, g, lo, hi);
        if (down) return Bt + ((size_t)(g * 1024 + u.pn * 256) * 2048 + lo * 512) * 2;
        const int e = u.pn < 4 ? lo : hi; return Bt + ((size_t)((g * 4 + e) * 1024 + (u.pn & 3) * 256) * 1024) * 2;
    }
    __device__ __forceinline__ long b_jump(const pg8::Unit& u) const { int g, lo, hi; cls_decode(u.cls, g, lo, hi); return (long)(hi - lo - 1) * 1024; }
    __device__ __forceinline__ void a_voff(const pg8::Unit& u, int R0, int R1, int C0, int C1, unsigned (&v)[2][2]) const {
        const int* lp = list + u.cls * 16384 + (u.pm - tb[u.cls]) * 256;
#pragma unroll
        for (int h = 0; h < 2; ++h) {
            const int r0 = h * 128 + R0, r1 = h * 128 + R1;
            const int t0 = lp[r0 < u.nvalid ? r0 : 0], t1 = lp[r1 < u.nvalid ? r1 : 0];
            v[h][0] = (unsigned)t0 * 2048u + (unsigned)C0 * 2u; v[h][1] = (unsigned)t1 * 2048u + (unsigned)C1 * 2u;
        }
    }
};
struct EpiGateUp {
    static constexpr bool PERM = true;
    bf16_t* HC; const f32x2* lw; const LAS int* tb;
    __device__ __forceinline__ void operator()(const f32x4 (&acc)[2][2][4][2], const Unit& u, int wr, int wc, int fr, int fq) const {
        const int slot = u.pn >> 2;
        const f32x2* lwp = lw + u.cls * 16384 + (u.pm - tb[u.cls]) * 256;
        f32x2 w2v[8];
#pragma unroll
        for (int it = 0; it < 8; ++it) { const int rl = wr * 64 + fr + (it >> 2) * 128 + (it & 3) * 16; w2v[it] = lwp[rl < u.nvalid ? rl : 0]; }
#pragma unroll
        for (int ai = 0; ai < 2; ++ai)
#pragma unroll
            for (int m = 0; m < 4; ++m) {
                const int rl = wr * 64 + fr + ai * 128 + m * 16;
                const f32x2 w2 = w2v[ai * 4 + m]; const unsigned wb = __float_as_uint(w2.x); const float w = slot ? bfhi(wb) : bflo(wb), rs = w2.y;
                u32x2 o[2];
#pragma unroll
                for (int bj = 0; bj < 2; ++bj) {
                    const f32x4 v0 = acc[ai][bj][m][0] * rs, v1 = acc[ai][bj][m][1] * rs;
                    const float h0 = v0[0] * fast_sigmoid(v0[0]) * v0[1] * w, h1 = v0[2] * fast_sigmoid(v0[2]) * v0[3] * w;
                    const float h2 = v1[0] * fast_sigmoid(v1[0]) * v1[1] * w, h3 = v1[2] * fast_sigmoid(v1[2]) * v1[3] * w;
                    o[bj].x = cvt_pk_bf16(h0, h1); o[bj].y = cvt_pk_bf16(h2, h3);
                }
                const auto sx = __builtin_amdgcn_permlane16_swap(o[0].x, o[1].x, false, false);
                const auto sy = __builtin_amdgcn_permlane16_swap(o[0].y, o[1].y, false, false);
                u32x4 wv; wv.x = sx[0]; wv.y = sy[0]; wv.z = sx[1]; wv.w = sy[1];
                bf16_t* rowp = HC + (size_t)(u.pm * 256 + rl) * 1024 + slot * 512 + (u.pn & 3) * 128 + wc * 16 + 4 * (fq & 2) + (fq & 1) * 64;
                if (rl < u.nvalid) *(u32x4*)rowp = wv;
            }
    }
};

struct EpiDown {
    static constexpr bool PERM = true;
    const bf16_t* Hin; bf16_t* Hout; float* ss; const int* list; const LAS int* tb;
    __device__ __forceinline__ void operator()(const f32x4 (&acc)[2][2][4][2], const Unit& u, int wr, int wc, int fr, int fq) const {
        const int* lp = list + u.cls * 16384 + (u.pm - tb[u.cls]) * 256;
        int tokv[8];
#pragma unroll
        for (int it = 0; it < 8; ++it) { const int rl = wr * 64 + fr + (it >> 2) * 128 + (it & 3) * 16; tokv[it] = lp[rl < u.nvalid ? rl : 0]; }
#pragma unroll
        for (int ai = 0; ai < 2; ++ai) {
            u32x4 q[4][2];
#pragma unroll
            for (int m = 0; m < 4; ++m) { const size_t off = (size_t)tokv[ai * 4 + m] * D + u.pn * 256 + wc * 32 + 8 * fq;
                q[m][0] = *(const u32x4*)(Hin + off); q[m][1] = *(const u32x4*)(Hin + off + 128); }
#pragma unroll
            for (int m = 0; m < 4; ++m) {
                const int rl = wr * 64 + fr + ai * 128 + m * 16;
                const bool ok = rl < u.nvalid;
                const int tok = tokv[ai * 4 + m];
                const size_t off = (size_t)tok * D + u.pn * 256 + wc * 32 + 8 * fq;
                float sq = 0.f;
#pragma unroll
                for (int bj = 0; bj < 2; ++bj) {
                    const u32x4 qq = q[m][bj];
                    const f32x4 o0 = (f32x4){bflo(qq.x), bfhi(qq.x), bflo(qq.y), bfhi(qq.y)} + acc[ai][bj][m][0], o1 = (f32x4){bflo(qq.z), bfhi(qq.z), bflo(qq.w), bfhi(qq.w)} + acc[ai][bj][m][1];
                    sq += (o0[0] * o0[0] + o0[1] * o0[1]) + (o0[2] * o0[2] + o0[3] * o0[3]) + (o1[0] * o1[0] + o1[1] * o1[1]) + (o1[2] * o1[2] + o1[3] * o1[3]);
                    u32x4 w; w.x = cvt_pk_bf16(o0[0], o0[1]); w.y = cvt_pk_bf16(o0[2], o0[3]); w.z = cvt_pk_bf16(o1[0], o1[1]); w.w = cvt_pk_bf16(o1[2], o1[3]);
                    if (ok) *(u32x4*)(Hout + off + bj * 128) = w;
                }
                sq += __shfl_xor(sq, 16); sq += __shfl_xor(sq, 32);
                if (ok && fq == 0) __hip_atomic_store(ss + (size_t)tok * 32 + u.pn * 4 + wc, sq, RLX_AGENT);
            }
        }
    }
};

struct Frame {
    LAS unsigned char* lds;
    volatile LAS unsigned* MISC;
    unsigned* ctl;
    int tid, lane, wave, vcu, G;
};

template <int ROWMODE>
__device__ __forceinline__ int tr_rowmap(int n, int row_off) {
    if (ROWMODE == 0) return row_off + n;
    if (ROWMODE == 1) { if (n >= 1024) return n; const int hb = n >> 7, jj = n & 127; return (hb << 7) + (jj < 64 ? 8 * (jj >> 2) + (jj & 3) : 8 * ((jj - 64) >> 2) + 4 + (jj & 3)); }
    if (ROWMODE == 2) return row_off + 2 * n;
    return row_off + 2 * n + 1;
}
template <int ROWMODE>
__device__ __forceinline__ void tr_item(const float* W, int N, bf16_t* WT, int ldt, int koff, int row_off, const float* gain, LAS float* scr, int item, int lane) {
    const int nblk = N / 32, kb = item / nblk, nb = item % nblk, k0 = 64 * kb, n0 = 32 * nb;
    float tv[32];
#pragma unroll
    for (int i = 0; i < 32; ++i) tv[i] = __builtin_nontemporal_load(&W[(size_t)(k0 + 2 * i + (lane >> 5)) * N + n0 + (lane & 31)]);
#pragma unroll
    for (int i = 0; i < 32; ++i) { const int kk = 2 * i + (lane >> 5); float v = tv[i]; if (gain) v *= gain[k0 + kk]; scr[kk * 33 + (lane & 31)] = v; }
    LDS_WAIT(); asm volatile("" ::: "memory");
    const int c = lane & 7;
#pragma unroll
    for (int j = 0; j < 4; ++j) { const int n = (lane >> 3) + 8 * j; const LAS float* s = scr + (8 * c) * 33 + n;
        u32x4 o; o.x = pk2(s[0 * 33], s[1 * 33]); o.y = pk2(s[2 * 33], s[3 * 33]); o.z = pk2(s[4 * 33], s[5 * 33]); o.w = pk2(s[6 * 33], s[7 * 33]);
        *(u32x4*)(WT + (size_t)tr_rowmap<ROWMODE>(n0 + n, row_off) * ldt + koff + k0 + 8 * c) = o; }
    LDS_WAIT(); asm volatile("" ::: "memory");
}
typedef short v4i16_t __attribute__((ext_vector_type(4)));
__device__ __forceinline__ s16x4 ds_tr16(unsigned addr) { return __builtin_bit_cast(s16x4, __builtin_amdgcn_ds_read_tr16_b64_v4i16((LAS v4i16_t*)(uintptr_t)addr)); }

__device__ __forceinline__ void attn_load_half(const bf16_t* __restrict__ P, int b, int h, int r, int blk, int dil, int tid, u32x4* kreg, u32x4* vreg) {
#pragma unroll
    for (int i = 0; i < 4; ++i) {
        const int id = tid + 512 * i, row = id >> 4, ch = id & 15;
        const size_t grow = (size_t)b * L + r + (size_t)dil * (128 * blk + row);
        const bf16_t* src = P + grow * 3072 + 1024 + h * 128 + ch * 8;
        kreg[i] = *(const u32x4*)src; vreg[i] = *(const u32x4*)(src + 1024);
    }
}
__device__ __forceinline__ void attn_store_half(LAS unsigned char* lds, int tid, int slot, const u32x4* kreg, const u32x4* vreg) {
#pragma unroll
    for (int i = 0; i < 4; ++i) {
        const int id = tid + 512 * i, row = slot * 128 + (id >> 4), ch = id & 15;
        const int off = row * 256 + ((ch ^ (row & 15)) << 4);
        *(LAS u32x4*)(lds + off) = kreg[i]; *(LAS u32x4*)(lds + 65536 + off) = vreg[i];
    }
}
__device__ __forceinline__ void attn_load(const bf16_t* __restrict__ P, int b, int h, int r, int n, int dil, int tid, bool full, u32x4 (&kreg)[8], u32x4 (&vreg)[8]) {
    if (full) attn_load_half(P, b, h, r, n > 0 ? n - 1 : 0, dil, tid, kreg, vreg);
    attn_load_half(P, b, h, r, n, dil, tid, kreg + 4, vreg + 4);
}
__device__ __forceinline__ void attn_store(LAS unsigned char* lds, int tid, int n, bool full, const u32x4 (&kreg)[8], const u32x4 (&vreg)[8]) {
    if (full) attn_store_half(lds, tid, (n - 1) & 1, kreg, vreg);
    attn_store_half(lds, tid, n & 1, kreg + 4, vreg + 4);
}
__device__ __forceinline__ void attn_loadq(const bf16_t* __restrict__ P, int b, int h, int r, int n, int dil, int tid, bf16x8 (&qf)[4]) {
    const int lane = tid & 63, w = __builtin_amdgcn_readfirstlane(tid >> 6), fr = lane & 15, fq = lane >> 4;
    const size_t qrow = (size_t)b * L + r + (size_t)dil * (128 * n + 16 * w + fr);
#pragma unroll
    for (int ks = 0; ks < 4; ++ks) qf[ks] = *(const bf16x8*)(P + qrow * 3072 + h * 128 + 32 * ks + 8 * fq);
}
template <bool MERGE>
__device__ __forceinline__ void attn_compute(LAS unsigned char* lds, const bf16_t* __restrict__ P, bf16_t* O, float* lse_out, const bf16_t* OA, const bf16_t* OB, const float* lseA, const float* lseB,
                                             int b, int h, int r, int n, int dil, int tid, const bf16x8 (&qf)[4]) {
    const int lane = tid & 63, w = __builtin_amdgcn_readfirstlane(tid >> 6), fr = lane & 15, fq = lane >> 4;
    const size_t qrow = (size_t)b * L + r + (size_t)dil * (128 * n + 16 * w + fr);
    float m = -1e30f, lsum = 0.f;
    f32x4 ot[8];
#pragma unroll
    for (int dt = 0; dt < 8; ++dt) ot[dt] = (f32x4){0.f, 0.f, 0.f, 0.f};
    const float NEG = -__builtin_inff();
    const int pxor = ((n - 1) & 1) << 7;
    const unsigned ldsb = (unsigned)(uintptr_t)lds;
#pragma unroll
    for (int g = 0; g < 5; ++g) {
        const int tixA = w + 2 * g, tixB = tixA + 1;
        f32x4 sA = (f32x4){0.f, 0.f, 0.f, 0.f}, sB = (f32x4){0.f, 0.f, 0.f, 0.f};
        {
            const int rowA = (16 * tixA + fr) ^ pxor;
#pragma unroll
            for (int ks = 0; ks < 4; ++ks) {
                const bf16x8 kf = *(const LAS bf16x8*)(lds + rowA * 256 + (((4 * ks + fq) ^ (rowA & 15)) << 4));
                sA = __builtin_amdgcn_mfma_f32_16x16x32_bf16(kf, qf[ks], sA, 0, 0, 0);
            }
        }
        if (g < 4) {
            const int rowB = (16 * tixB + fr) ^ pxor;
#pragma unroll
            for (int ks = 0; ks < 4; ++ks) {
                const bf16x8 kf = *(const LAS bf16x8*)(lds + rowB * 256 + (((4 * ks + fq) ^ (rowB & 15)) << 4));
                sB = __builtin_amdgcn_mfma_f32_16x16x32_bf16(kf, qf[ks], sB, 0, 0, 0);
            }
        }
        const bool invA = (n == 0 && tixA < 8), invB = (g == 4) || (n == 0 && tixB < 8);
#pragma unroll
        for (int e = 0; e < 4; ++e) {
            bool okA = !invA, okB = !invB;
            if (g == 0) okA = okA && (4 * fq + e >= fr);
            if (g == 4) okA = okA && (4 * fq + e <= fr);
            if (!okA) sA[e] = NEG;
            if (!okB) sB[e] = NEG;
        }
        float mx = fmaxf(fmaxf(fmaxf(sA[0], sA[1]), fmaxf(sA[2], sA[3])), fmaxf(fmaxf(sB[0], sB[1]), fmaxf(sB[2], sB[3])));
        mx = fmaxf(mx, __shfl_xor(mx, 16)); mx = fmaxf(mx, __shfl_xor(mx, 32));
        const float mn = fmaxf(m, mx);
        const float alpha = __builtin_amdgcn_exp2f(m - mn);
        m = mn;
        float ps = 0.f;
#pragma unroll
        for (int e = 0; e < 4; ++e) { sA[e] = __builtin_amdgcn_exp2f(sA[e] - mn); sB[e] = __builtin_amdgcn_exp2f(sB[e] - mn); ps += sA[e] + sB[e]; }
        lsum = lsum * alpha + ps;
        u32x4 pw; pw.x = cvt_pk_bf16_c(sA[0], sA[1]); pw.y = cvt_pk_bf16_c(sA[2], sA[3]); pw.z = cvt_pk_bf16_c(sB[0], sB[1]); pw.w = cvt_pk_bf16_c(sB[2], sB[3]);
        const bf16x8 pf = __builtin_bit_cast(bf16x8, pw);
        const int qp = fr >> 2, pp = fr & 3;
        const int vrowA = (16 * tixA + 4 * fq + qp) ^ pxor, vrowB = (g < 4) ? ((16 * tixB + 4 * fq + qp) ^ pxor) : vrowA;
#pragma unroll
        for (int dt = 0; dt < 8; ++dt) {
            const unsigned aA = ldsb + 65536u + (unsigned)(vrowA * 256 + (((2 * dt + (pp >> 1)) ^ (vrowA & 15)) << 4) + (pp & 1) * 8);
            const unsigned aB = ldsb + 65536u + (unsigned)(vrowB * 256 + (((2 * dt + (pp >> 1)) ^ (vrowB & 15)) << 4) + (pp & 1) * 8);
            const s16x4 lo = ds_tr16(aA), hi = ds_tr16(aB);
            const bf16x8 vf = (bf16x8){lo[0], lo[1], lo[2], lo[3], hi[0], hi[1], hi[2], hi[3]};
            ot[dt] = ot[dt] * alpha;
            ot[dt] = __builtin_amdgcn_mfma_f32_16x16x32_bf16(vf, pf, ot[dt], 0, 0, 0);
        }
    }
    float lt = lsum; lt += __shfl_xor(lt, 16); lt += __shfl_xor(lt, 32);
    const float inv = 1.0f / lt;
    const float lse2 = m + __builtin_amdgcn_logf(lt);
    if (!MERGE) {
        if (fq == 0) lse_out[(size_t)((b * 8 + h) * dil + r) * (L / dil) + 128 * n + 16 * w + fr] = lse2;
#pragma unroll
        for (int dp = 0; dp < 4; ++dp) {
            u32x2 o[2];
#pragma unroll
            for (int q = 0; q < 2; ++q) { const int dt = 2 * dp + q; o[q].x = cvt_pk_bf16(ot[dt][0] * inv, ot[dt][1] * inv); o[q].y = cvt_pk_bf16(ot[dt][2] * inv, ot[dt][3] * inv); }
            const auto sx = __builtin_amdgcn_permlane16_swap(o[0].x, o[1].x, false, false);
            const auto sy = __builtin_amdgcn_permlane16_swap(o[0].y, o[1].y, false, false);
            u32x4 wv; wv.x = sx[0]; wv.y = sy[0]; wv.z = sx[1]; wv.w = sy[1];
            *(u32x4*)(O + qrow * D + h * 128 + 16 * (2 * dp + (fq & 1)) + 4 * (fq & 2)) = wv; }
    } else {
        const int pos = r + dil * (128 * n + 16 * w + fr);
        const float la = lseA[(size_t)(b * 8 + h) * L + pos], lb = lseB[(size_t)((b * 8 + h) * 4 + (pos & 3)) * (L / 4) + (pos >> 2)];
        const float M = fmaxf(fmaxf(la, lb), lse2);
        float wa = __builtin_amdgcn_exp2f(la - M), wb = __builtin_amdgcn_exp2f(lb - M), wc = __builtin_amdgcn_exp2f(lse2 - M);
        const float iw = 1.0f / (wa + wb + wc); wa *= iw; wb *= iw; wc *= iw * inv;
#pragma unroll
        for (int dt = 0; dt < 8; ++dt) {
            const size_t off = qrow * D + h * 128 + 16 * dt + 4 * fq;
            const u32x2 a = *(const u32x2*)(OA + off), bb = *(const u32x2*)(OB + off);
            const float r0 = wa * bflo(a.x) + wb * bflo(bb.x) + wc * ot[dt][0], r1 = wa * bfhi(a.x) + wb * bfhi(bb.x) + wc * ot[dt][1];
            const float r2 = wa * bflo(a.y) + wb * bflo(bb.y) + wc * ot[dt][2], r3 = wa * bfhi(a.y) + wb * bfhi(bb.y) + wc * ot[dt][3];
            u32x2 o; o.x = cvt_pk_bf16(r0, r1); o.y = cvt_pk_bf16(r2, r3);
            *(u32x2*)(O + off) = o;
        }
    }
}
__device__ __forceinline__ u32x4 scale_bf16x8(u32x4 v, float z) {
    u32x4 o; o.x = cvt_pk_bf16(bflo(v.x) * z, bfhi(v.x) * z); o.y = cvt_pk_bf16(bflo(v.y) * z, bfhi(v.y) * z);
    o.z = cvt_pk_bf16(bflo(v.z) * z, bfhi(v.z) * z); o.w = cvt_pk_bf16(bflo(v.w) * z, bfhi(v.w) * z); return o;
}
__device__ __forceinline__ int swz_tr(int row, int ch) { return row * 256 + ((ch ^ ((row & 3) << 2)) << 4); }
__device__ __forceinline__ int swz_row(int row, int ch) { return row * 256 + ((ch ^ (row & 15)) << 4); }

__device__ __forceinline__ void ret_kv_unit(LAS unsigned char* lds, const bf16_t* __restrict__ P, bf16_t* KVT, int b, int h, int N, int tid) {
    const int lane = tid & 63, w = __builtin_amdgcn_readfirstlane(tid >> 6);
    const float lg2 = log2f(1.0f - exp2f(-5.0f - (float)h));
    {
        u32x4 kreg[8], vreg[8];
#pragma unroll
        for (int i = 0; i < 8; ++i) {
            const int id = tid + 512 * i, row = id >> 4, ch = id & 15;
            const bf16_t* src = P + ((size_t)b * L + 256 * N + row) * 2560 + 512 + h * 128 + ch * 8;
            kreg[i] = *(const u32x4*)src; vreg[i] = *(const u32x4*)(src + 512);
        }
#pragma unroll
        for (int i = 0; i < 8; ++i) {
            const int id = tid + 512 * i, row = id >> 4, ch = id & 15;
            const int off = swz_tr(row, ch);
            *(LAS u32x4*)(lds + off) = kreg[i];
            *(LAS u32x4*)(lds + 65536 + off) = scale_bf16x8(vreg[i], exp2f((float)(255 - row) * lg2));
        }
    }
    __syncthreads();
    const int dkt = w >> 1, dvt0 = 2 * (w & 1);
    const int gq = lane >> 4, hi = gq >> 1, qp = (lane & 15) >> 2, pp = lane & 3;
    const unsigned ldsb = (unsigned)(uintptr_t)lds;
    f32x16 acc[2];
#pragma unroll
    for (int t = 0; t < 2; ++t)
#pragma unroll
        for (int r = 0; r < 16; ++r) acc[t][r] = 0.f;
    const int chA = 4 * dkt + 2 * (gq & 1) + (pp >> 1);
#pragma unroll 4
    for (int ks = 0; ks < 16; ++ks) {
        const int r1 = 16 * ks + 8 * hi + qp, r2 = r1 + 4;
        const s16x4 alo = ds_tr16(ldsb + swz_tr(r1, chA) + (pp & 1) * 8), ahi = ds_tr16(ldsb + swz_tr(r2, chA) + (pp & 1) * 8);
        const bf16x8 af = (bf16x8){alo[0], alo[1], alo[2], alo[3], ahi[0], ahi[1], ahi[2], ahi[3]};
#pragma unroll
        for (int t = 0; t < 2; ++t) {
            const int chB = 4 * (dvt0 + t) + 2 * (gq & 1) + (pp >> 1);
            const s16x4 blo = ds_tr16(ldsb + 65536u + swz_tr(r1, chB) + (pp & 1) * 8), bhi = ds_tr16(ldsb + 65536u + swz_tr(r2, chB) + (pp & 1) * 8);
            const bf16x8 bf = (bf16x8){blo[0], blo[1], blo[2], blo[3], bhi[0], bhi[1], bhi[2], bhi[3]};
            acc[t] = __builtin_amdgcn_mfma_f32_32x32x16_bf16(af, bf, acc[t], 0, 0, 0);
        }
    }
    bf16_t* out = KVT + ((size_t)((b * 4 + h) * 16 + N)) * 16384;
#pragma unroll
    for (int t = 0; t < 2; ++t) {
        const int dv = 32 * (dvt0 + t) + (lane & 31);
#pragma unroll
        for (int rg = 0; rg < 4; ++rg) {
            u32x2 o; o.x = cvt_pk_bf16_c(acc[t][4 * rg], acc[t][4 * rg + 1]); o.y = cvt_pk_bf16_c(acc[t][4 * rg + 2], acc[t][4 * rg + 3]);
            *(u32x2*)(out + dv * 128 + 32 * dkt + 8 * rg + 4 * (lane >> 5)) = o;
        }
    }
    __syncthreads();
}

__device__ __forceinline__ void ret_out_unit(LAS unsigned char* lds, const bf16_t* __restrict__ P, const bf16_t* __restrict__ KVT, bf16_t* MG, int b, int h, int N, int tid) {
    const int lane = tid & 63, w = __builtin_amdgcn_readfirstlane(tid >> 6), l31 = lane & 31, hi = lane >> 5;
    const float lg2 = log2f(1.0f - exp2f(-5.0f - (float)h));
    const size_t rowbase = (size_t)b * L + 256 * N;
    {
        const bf16_t* kvb = KVT + ((size_t)((b * 4 + h) * 16)) * 16384;
        float a8[4][8];
#pragma unroll
        for (int i = 0; i < 4; ++i)
#pragma unroll
            for (int e = 0; e < 8; ++e) a8[i][e] = 0.f;
#pragma unroll 1
        for (int m = 0; m < N; ++m) {
            const float wgt = exp2f((float)(256 * (N - 1 - m)) * lg2);
            u32x4 v[4];
#pragma unroll
            for (int i = 0; i < 4; ++i) { const int cid = tid + 512 * i, dv = cid >> 4, ch = cid & 15; v[i] = *(const u32x4*)(kvb + (size_t)m * 16384 + dv * 128 + ch * 8); }
#pragma unroll
            for (int i = 0; i < 4; ++i) {
                a8[i][0] += wgt * bflo(v[i].x); a8[i][1] += wgt * bfhi(v[i].x); a8[i][2] += wgt * bflo(v[i].y); a8[i][3] += wgt * bfhi(v[i].y);
                a8[i][4] += wgt * bflo(v[i].z); a8[i][5] += wgt * bfhi(v[i].z); a8[i][6] += wgt * bflo(v[i].w); a8[i][7] += wgt * bfhi(v[i].w); }
        }
#pragma unroll
        for (int i = 0; i < 4; ++i) {
            const int cid = tid + 512 * i, dv = cid >> 4, ch = cid & 15;
            u32x4 o; o.x = cvt_pk_bf16(a8[i][0], a8[i][1]); o.y = cvt_pk_bf16(a8[i][2], a8[i][3]); o.z = cvt_pk_bf16(a8[i][4], a8[i][5]); o.w = cvt_pk_bf16(a8[i][6], a8[i][7]);
            *(LAS u32x4*)(lds + swz_row(dv, ch)) = o;
        }
    }
    const size_t qrow = rowbase + 32 * w + l31;
    bf16x8 qf[8];
#pragma unroll
    for (int ks = 0; ks < 8; ++ks) qf[ks] = *(const bf16x8*)(P + qrow * 2560 + h * 128 + 16 * ks + 8 * hi);
    __syncthreads();
    f32x16 acc[4];
#pragma unroll
    for (int dvt = 0; dvt < 4; ++dvt) {
#pragma unroll
        for (int r = 0; r < 16; ++r) acc[dvt][r] = 0.f;
        const int dv = 32 * dvt + l31;
#pragma unroll
        for (int ks = 0; ks < 8; ++ks) {
            const bf16x8 pf = *(const LAS bf16x8*)(lds + swz_row(dv, 2 * ks + hi));
            acc[dvt] = __builtin_amdgcn_mfma_f32_32x32x16_bf16(pf, qf[ks], acc[dvt], 0, 0, 0);
        }
    }
    {
        const float xi = exp2f((float)(32 * w + l31 + 1) * lg2);
#pragma unroll
        for (int dvt = 0; dvt < 4; ++dvt)
#pragma unroll
            for (int r = 0; r < 16; ++r) acc[dvt][r] *= xi;
    }
    __syncthreads();
    {
        u32x4 kreg[8], vreg[8];
#pragma unroll
        for (int i = 0; i < 8; ++i) {
            const int id = tid + 512 * i, row = id >> 4, ch = id & 15;
            const bf16_t* src = P + (rowbase + row) * 2560 + 512 + h * 128 + ch * 8;
            kreg[i] = *(const u32x4*)src; vreg[i] = *(const u32x4*)(src + 512);
        }
#pragma unroll
        for (int i = 0; i < 8; ++i) {
            const int id = tid + 512 * i, row = id >> 4, ch = id & 15;
            *(LAS u32x4*)(lds + swz_row(row, ch)) = kreg[i];
            *(LAS u32x4*)(lds + 65536 + swz_tr(row, ch)) = vreg[i];
        }
    }
    __syncthreads();
    float dvec[16];
#pragma unroll
    for (int r = 0; r < 16; ++r) dvec[r] = exp2f((float)(l31 - ((r & 3) + 8 * (r >> 2) + 4 * hi)) * lg2);
    const int gq = lane >> 4, qp = (lane & 15) >> 2, pp = lane & 3;
    const unsigned ldsb = (unsigned)(uintptr_t)lds;
#pragma unroll 1
    for (int kt = 0; kt <= w; ++kt) {
        f32x16 st;
#pragma unroll
        for (int r = 0; r < 16; ++r) st[r] = 0.f;
        const int key = 32 * kt + l31;
#pragma unroll
        for (int ks = 0; ks < 8; ++ks) {
            const bf16x8 kf = *(const LAS bf16x8*)(lds + swz_row(key, 2 * ks + hi));
            st = __builtin_amdgcn_mfma_f32_32x32x16_bf16(kf, qf[ks], st, 0, 0, 0);
        }
        const float tsc = exp2f((float)(32 * (w - kt)) * lg2);
        const bool diag = (kt == w);
#pragma unroll
        for (int r = 0; r < 16; ++r) {
            const int krow = (r & 3) + 8 * (r >> 2) + 4 * hi;
            float pv = st[r] * dvec[r] * tsc;
            if (diag && krow > l31) pv = 0.f;
            st[r] = pv;
        }
        bf16x8 pf[2];
#pragma unroll
        for (int s = 0; s < 2; ++s) { u32x4 pw; pw.x = cvt_pk_bf16(st[8 * s], st[8 * s + 1]); pw.y = cvt_pk_bf16(st[8 * s + 2], st[8 * s + 3]);
            pw.z = cvt_pk_bf16(st[8 * s + 4], st[8 * s + 5]); pw.w = cvt_pk_bf16(st[8 * s + 6], st[8 * s + 7]); pf[s] = __builtin_bit_cast(bf16x8, pw); }
#pragma unroll
        for (int dvt = 0; dvt < 4; ++dvt) {
            const int chV = 4 * dvt + 2 * (gq & 1) + (pp >> 1);
#pragma unroll
            for (int s = 0; s < 2; ++s) {
                const int r1 = 32 * kt + 16 * s + 4 * hi + qp, r2 = r1 + 8;
                const s16x4 vlo = ds_tr16(ldsb + 65536u + swz_tr(r1, chV) + (pp & 1) * 8), vhi = ds_tr16(ldsb + 65536u + swz_tr(r2, chV) + (pp & 1) * 8);
                const bf16x8 vf = (bf16x8){vlo[0], vlo[1], vlo[2], vlo[3], vhi[0], vhi[1], vhi[2], vhi[3]};
                acc[dvt] = __builtin_amdgcn_mfma_f32_32x32x16_bf16(vf, pf[s], acc[dvt], 0, 0, 0);
            }
        }
    }
    float s1 = 0.f;
#pragma unroll
    for (int dvt = 0; dvt < 4; ++dvt)
#pragma unroll
        for (int r = 0; r < 16; ++r) s1 += acc[dvt][r];
    s1 += __shfl_xor(s1, 32);
    const float mu = s1 * (1.0f / 128.0f);
    float s2 = 0.f;
#pragma unroll
    for (int dvt = 0; dvt < 4; ++dvt)
#pragma unroll
        for (int r = 0; r < 16; ++r) { const float d = acc[dvt][r] - mu; s2 += d * d; }
    s2 += __shfl_xor(s2, 32);
    const float rs = rsqrtf(s2 * (1.0f / 128.0f) + 1e-6f);
#pragma unroll
    for (int dvt = 0; dvt < 4; ++dvt)
#pragma unroll
        for (int rg = 0; rg < 4; ++rg) {
            const int col = h * 128 + 32 * dvt + 8 * rg + 4 * hi;
            const u32x2 g = *(const u32x2*)(P + qrow * 2560 + 1536 + col);
            u32x2 o; o.x = cvt_pk_bf16(bflo(g.x) * (acc[dvt][4 * rg] - mu) * rs, bfhi(g.x) * (acc[dvt][4 * rg + 1] - mu) * rs);
            o.y = cvt_pk_bf16(bflo(g.y) * (acc[dvt][4 * rg + 2] - mu) * rs, bfhi(g.y) * (acc[dvt][4 * rg + 3] - mu) * rs);
            *(u32x2*)(MG + qrow * D + col) = o;
        }
    __syncthreads();
}
constexpr size_t S5_BB_OFF = 0, S5_CM_OFF = 128 * 1024, S5_LAM_OFF = 448 * 1024;
struct S5P { float lr, li; };
__device__ __forceinline__ void cmul(float ar, float ai, float br, float bi, float& cr, float& ci) { float r_ = ar * br - ai * bi; asm volatile("" : "+v"(r_)); float i_ = ar * bi + ai * br; asm volatile("" : "+v"(i_)); cr = r_; ci = i_; }
__device__ __forceinline__ void s5_coefs(const float* a_re, const float* a_im, const float* log_dt, int g, int st, float& lr, float& li, float& cr, float& ci) {
    const float dt = expf(log_dt[g]); const float are = a_re[g * 64 + st], aim = a_im[g * 64 + st];
    const float zr = are * dt, zi = aim * dt, mag = expf(zr);
    lr = mag * cosf(zi); li = mag * sinf(zi);
    const float nr = lr - 1.0f, ni = li, den = are * are + aim * aim;
    cr = (nr * are + ni * aim) / den; ci = (ni * are - nr * aim) / den;
}
__device__ __forceinline__ void s5_tables(unsigned char* tab, const float* a_re, const float* a_im, const float* b_re, const float* b_im, const float* c_re, const float* c_im,
                                          const float* dsk, const float* log_dt, int gtid, int gthreads) {
    for (int i = gtid; i < 32 * 64; i += gthreads) {
        const int g = i >> 6, st = i & 63;
        const float dt = expf(log_dt[g]); const float zr = a_re[g * 64 + st] * dt, zi = a_im[g * 64 + st] * dt;
        float* o = (float*)(tab + S5_LAM_OFF) + (size_t)i * 16;
        const float kk[7] = {1.f, 2.f, 3.f, 4.f, 32.f, 64.f, 256.f};
#pragma unroll
        for (int q = 0; q < 7; ++q) { const float mag = expf(kk[q] * zr); o[2 * q] = mag * cosf(kk[q] * zi); o[2 * q + 1] = mag * sinf(kk[q] * zi); }
        o[14] = 0.f; o[15] = 0.f;
    }
    for (int i = gtid; i < 32 * 4 * 64; i += gthreads) {
        const int lane = i & 63, tt = (i >> 6) & 3, g = i >> 8;
        const int st = 32 * (tt >> 1) + (lane & 31); float lr, li, cr, ci; s5_coefs(a_re, a_im, log_dt, g, st, lr, li, cr, ci);
        float v[8];
#pragma unroll
        for (int j = 0; j < 8; ++j) { const int h = 8 * (lane >> 5) + j; const float br = b_re[(g * 64 + st) * 16 + h], bi = b_im[(g * 64 + st) * 16 + h];
            v[j] = (tt & 1) ? (cr * bi + ci * br) : (cr * br - ci * bi); }
        u32x4 o; o.x = pk2(v[0], v[1]); o.y = pk2(v[2], v[3]); o.z = pk2(v[4], v[5]); o.w = pk2(v[6], v[7]);
        *((u32x4*)(tab + S5_BB_OFF) + i) = o;
    }
    for (int i = gtid; i < 32 * 9 * 64; i += gthreads) {
        const int lane = i & 63, s9 = (i >> 6) % 9, g = i / (9 * 64);
        const int h = lane & 31; float v[8];
#pragma unroll
        for (int j = 0; j < 8; ++j) {
            float x = 0.f;
            if (h < 16) {
                if (s9 < 8) { const int st = 8 * s9 + 4 * (lane >> 5) + (j >> 1); x = (j & 1) ? -c_im[(g * 16 + h) * 64 + st] : c_re[(g * 16 + h) * 64 + st]; }
                else { const int hp = 8 * (lane >> 5) + j; x = (hp == h) ? dsk[g * 16 + h] : 0.f; }
            }
            v[j] = x;
        }
        u32x4 o; o.x = pk2(v[0], v[1]); o.y = pk2(v[2], v[3]); o.z = pk2(v[4], v[5]); o.w = pk2(v[6], v[7]);
        *((u32x4*)(tab + S5_CM_OFF) + i) = o;
    }
}

template <bool OUT>
__device__ __forceinline__ void s5_task(const bf16_t* __restrict__ P, const unsigned char* __restrict__ tab, float* END, bf16_t* G, LAS unsigned char* xl, int b, int g, int c, int lane) {
    const int l31 = lane & 31, hi = lane >> 5;
    bf16x8 bbt[4];
#pragma unroll
    for (int tt = 0; tt < 4; ++tt) bbt[tt] = *((const bf16x8*)(tab + S5_BB_OFF) + (g * 4 + tt) * 64 + lane);
    float l1r[2], l1i[2], l2r[2], l2i[2], l3r[2], l3i[2], l4r[2], l4i[2], cr[2], ci[2];
#pragma unroll
    for (int cc = 0; cc < 2; ++cc) {
        const float* lp = (const float*)(tab + S5_LAM_OFF) + (size_t)(g * 64 + 32 * cc + l31) * 16;
        const f32x4 a = *(const f32x4*)lp, bq = *(const f32x4*)(lp + 4);
        l1r[cc] = a[0]; l1i[cc] = a[1]; l2r[cc] = a[2]; l2i[cc] = a[3]; l3r[cc] = bq[0]; l3i[cc] = bq[1]; l4r[cc] = bq[2]; l4i[cc] = bq[3];
        cr[cc] = 0.f; ci[cc] = 0.f;
        if (OUT) {
            const float p256r = lp[12], p256i = lp[13];
            const float* ep = END + ((size_t)((b * 32 + g) * 16) * 64 + 32 * cc + l31) * 2;
#pragma unroll
            for (int m = 0; m < 15; ++m) { const int mm = m < c ? m : 0; f32x2 e = *(const f32x2*)(ep + (size_t)mm * 128); float tr_, ti_; cmul(p256r, p256i, cr[cc], ci[cc], tr_, ti_);
                if (m < c) { cr[cc] = tr_ + e.x; ci[cc] = ti_ + e.y; } }
        }
    }
    bf16x8 cm[9];
    if (OUT) {
#pragma unroll
        for (int s = 0; s < 9; ++s) cm[s] = *((const bf16x8*)(tab + S5_CM_OFF) + (g * 9 + s) * 64 + lane);
    }
    const size_t row0 = (size_t)b * L + 256 * c;
    bf16x8 ufn = *(const bf16x8*)(P + (row0 + l31) * 2560 + 2048 + g * 16 + 8 * hi);
#pragma unroll 1
    for (int step = 0; step < 8; ++step) {
        const bf16x8 uf = ufn;
        if (step < 7) ufn = *(const bf16x8*)(P + (row0 + 32 * (step + 1) + l31) * 2560 + 2048 + g * 16 + 8 * hi);
        f32x16 acc[4];
#pragma unroll
        for (int tt = 0; tt < 4; ++tt) {
#pragma unroll
            for (int r = 0; r < 16; ++r) acc[tt][r] = 0.f;
            acc[tt] = __builtin_amdgcn_mfma_f32_32x32x16_bf16(uf, bbt[tt], acc[tt], 0, 0, 0);
        }
#pragma unroll
        for (int cc = 0; cc < 2; ++cc) {
            f32x16& xr = acc[2 * cc]; f32x16& xi = acc[2 * cc + 1];
#pragma unroll
            for (int k = 0; k < 4; ++k)
#pragma unroll
                for (int i = 1; i < 4; ++i) { const int r = 4 * k + i;
                    const float nr = l1r[cc] * xr[r - 1] - l1i[cc] * xi[r - 1] + xr[r], ni = l1r[cc] * xi[r - 1] + l1i[cc] * xr[r - 1] + xi[r];
                    xr[r] = nr; xi[r] = ni; }
            float C0r = cr[cc], C0i = ci[cc];
            float mr[4], mi[4];
#pragma unroll
            for (int k = 0; k < 4; ++k) {
                const float er = xr[4 * k + 3], ei = xi[4 * k + 3];
                const float pr = __shfl_xor(er, 32), pi = __shfl_xor(ei, 32);
                const float e0r = hi ? pr : er, e0i = hi ? pi : ei, e1r = hi ? er : pr, e1i = hi ? ei : pi;
                float t1r, t1i; cmul(l4r[cc], l4i[cc], C0r, C0i, t1r, t1i); float C1r = t1r + e0r, C1i = t1i + e0i;
                asm volatile("s_nop 3" : "+v"(C1r), "+v"(C1i));
                mr[k] = hi ? C1r : C0r; mi[k] = hi ? C1i : C0i;
                float t2r, t2i; cmul(l4r[cc], l4i[cc], C1r, C1i, t2r, t2i); C0r = t2r + e1r; C0i = t2i + e1i;
                asm volatile("s_nop 3" : "+v"(C0r), "+v"(C0i), "+v"(mr[k]), "+v"(mi[k]));
            }
            cr[cc] = C0r; ci[cc] = C0i;
            if (OUT) {
#pragma unroll
                for (int k = 0; k < 4; ++k) {
                    float tr_, ti_;
                    cmul(l1r[cc], l1i[cc], mr[k], mi[k], tr_, ti_); xr[4 * k] += tr_; xi[4 * k] += ti_;
                    cmul(l2r[cc], l2i[cc], mr[k], mi[k], tr_, ti_); xr[4 * k + 1] += tr_; xi[4 * k + 1] += ti_;
                    cmul(l3r[cc], l3i[cc], mr[k], mi[k], tr_, ti_); xr[4 * k + 2] += tr_; xi[4 * k + 2] += ti_;
                    cmul(l4r[cc], l4i[cc], mr[k], mi[k], tr_, ti_); xr[4 * k + 3] += tr_; xi[4 * k + 3] += ti_;
                }
#pragma unroll
                for (int r = 0; r < 16; ++r) { const int tk = (r & 3) + 8 * (r >> 2) + 4 * hi;
                    *(LAS unsigned*)(xl + tk * 272 + (32 * cc + l31) * 4) = cvt_pk_bf16(xr[r], xi[r]); }
            }
        }
        if (!OUT) {
            if (step == 7 && hi == 0) {
                float* ep = END + ((size_t)((b * 32 + g) * 16 + c) * 64) * 2;
                f32x2 e0; e0.x = cr[0]; e0.y = ci[0]; f32x2 e1; e1.x = cr[1]; e1.y = ci[1];
                *(f32x2*)(ep + l31 * 2) = e0; *(f32x2*)(ep + (32 + l31) * 2) = e1;
            }
        } else {
            LDS_WAIT(); asm volatile("" ::: "memory");
            f32x16 y;
#pragma unroll
            for (int r = 0; r < 16; ++r) y[r] = 0.f;
#pragma unroll
            for (int s = 0; s < 8; ++s) { const bf16x8 xf = *(const LAS bf16x8*)(xl + l31 * 272 + 32 * s + 16 * hi);
                y = __builtin_amdgcn_mfma_f32_32x32x16_bf16(cm[s], xf, y, 0, 0, 0); }
            y = __builtin_amdgcn_mfma_f32_32x32x16_bf16(cm[8], uf, y, 0, 0, 0);
            bf16_t* gp = G + (row0 + 32 * step + l31) * 512 + g * 16 + 4 * hi;
#pragma unroll
            for (int rg = 0; rg < 2; ++rg) {
                float gv[4];
#pragma unroll
                for (int e = 0; e < 4; ++e) { const float v = y[4 * rg + e]; gv[e] = v * fast_sigmoid(1.5957691216057308f * (v + 0.044715f * v * v * v)); }
                u32x2 o; o.x = cvt_pk_bf16(gv[0], gv[1]); o.y = cvt_pk_bf16(gv[2], gv[3]);
                *(u32x2*)(gp + 8 * rg) = o;
            }
            LDS_WAIT(); asm volatile("" ::: "memory");
        }
    }
}

struct EpiGlu {
    static constexpr bool PERM = true;
    const bf16_t* G; const float* bias; bf16_t* MG;
    __device__ __forceinline__ void operator()(const f32x4 (&acc)[2][2][4][2], const Unit& u, int wr, int wc, int fr, int fq) const {
        const int row0 = u.pm * 256 + wr * 64 + fr;
#pragma unroll
        for (int ai = 0; ai < 2; ++ai)
#pragma unroll
            for (int m = 0; m < 4; ++m) {
                const int row = row0 + ai * 128 + m * 16;
#pragma unroll
                for (int bj = 0; bj < 2; ++bj) {
                    const int col = u.pn * 256 + bj * 128 + wc * 32 + 8 * fq;
                    const u32x4 gq = *(const u32x4*)(G + (size_t)row * 512 + col);
                    const f32x4 b0 = *(const f32x4*)(bias + col), b1 = *(const f32x4*)(bias + col + 4);
                    const f32x4 z0 = acc[ai][bj][m][0] + b0, z1 = acc[ai][bj][m][1] + b1;
                    u32x4 o;
                    o.x = cvt_pk_bf16(bflo(gq.x) * fast_sigmoid(z0[0]), bfhi(gq.x) * fast_sigmoid(z0[1]));
                    o.y = cvt_pk_bf16(bflo(gq.y) * fast_sigmoid(z0[2]), bfhi(gq.y) * fast_sigmoid(z0[3]));
                    o.z = cvt_pk_bf16(bflo(gq.z) * fast_sigmoid(z1[0]), bfhi(gq.z) * fast_sigmoid(z1[1]));
                    o.w = cvt_pk_bf16(bflo(gq.w) * fast_sigmoid(z1[2]), bfhi(gq.w) * fast_sigmoid(z1[3]));
                    *(u32x4*)(MG + (size_t)row * D + 512 + col) = o;
                }
            }
    }
};
struct Args {
    const float* in[25]; float* out; unsigned char* ws; int ph_lo, ph_hi;
};
enum { PH_PROLOGUE = 0, PH_INPROJ = 1, PH_MIX_A = 2, PH_MIX_B = 3, PH_GLU = 4, PH_OUTPROJ0 = 5, PH_ROUTER0 = 6, PH_GATEUP0 = 7, PH_DOWN0 = 8, PH_QKV = 9, PH_ATTN_AB = 10, PH_ATTN_C = 11, PH_OUTPROJ1 = 12, PH_ROUTER1 = 13, PH_MOE1X = 14, PH_MOE1Y = 15, PH_MOE1Z = 16, PH_FINAL = 17, PH_COUNT = 18 };

enum { CF_IN = 0, CF_OUT = 1, CF_GLU = 2, CF_QKV = 3, CF_CO = 4, CF_G = 5, CF_U = 6, CF_D = 7 };
struct ConvSeg { int fam, lo, n; };
template <int FAM>
__device__ __forceinline__ void conv_item(const Args& a, LAS float* scr, int r, int lane) {
    unsigned char* ws = a.ws;
    if (FAM == CF_IN) tr_item<1>(a.in[4], 2560, (bf16_t*)(ws + WS_WIN), 1024, 0, 0, a.in[1], scr, r, lane);
    else if (FAM == CF_OUT) tr_item<0>(a.in[5], 1024, (bf16_t*)(ws + WS_WOUT), 1024, 0, 0, nullptr, scr, r, lane);
    else if (FAM == CF_GLU) tr_item<0>(a.in[14], 512, (bf16_t*)(ws + WS_WGLU), 512, 0, 0, nullptr, scr, r, lane);
    else if (FAM == CF_QKV) tr_item<0>(a.in[16], 3072, (bf16_t*)(ws + WS_WQKV), 1024, 0, 0, a.in[1] + D, scr, r, lane);
    else if (FAM == CF_CO) tr_item<0>(a.in[17], 1024, (bf16_t*)(ws + WS_CWOUT), 1024, 0, 0, nullptr, scr, r, lane);
    else if (FAM == CF_G) { const int le = r >> 8, layer = le >> 4, ge = le & 15;
        tr_item<2>(a.in[22] + (size_t)le * 1024 * 512, 512, (bf16_t*)(ws + WS_WGU + layer * WS_MOE_LAYER) + (size_t)ge * 1024 * 1024, 1024, 0, 0, a.in[2] + layer * D, scr, r & 255, lane); }
    else if (FAM == CF_U) { const int le = r >> 8, layer = le >> 4, ge = le & 15;
        tr_item<3>(a.in[23] + (size_t)le * 1024 * 512, 512, (bf16_t*)(ws + WS_WGU + layer * WS_MOE_LAYER) + (size_t)ge * 1024 * 1024, 1024, 0, 0, a.in[2] + layer * D, scr, r & 255, lane); }
    else { const int le = r >> 8, layer = le >> 4, g = (le >> 2) & 3, e = le & 3;
        tr_item<0>(a.in[24] + (size_t)le * 512 * 1024, 1024, (bf16_t*)(ws + WS_WD + layer * WS_MOE_LAYER) + (size_t)g * 1024 * 2048, 2048, e * 512, 0, nullptr, scr, r & 255, lane); }
}
template <int SLOT>
__device__ __forceinline__ void conv_run(Frame& F, const Args& a, int widx, int wcount) {
    LAS float* scr = (LAS float*)(F.lds + F.wave * 16384);
    if (SLOT == 0) {
        constexpr int N0 = 16 * 80, N1 = 16 * 32, N2 = 8 * 16;
        for (int it = widx; it < N0 + N1 + N2; it += wcount) { int r = it;
            if (r < N0) { conv_item<CF_IN>(a, scr, r, F.lane); continue; } r -= N0;
            if (r < N1) { conv_item<CF_OUT>(a, scr, r, F.lane); continue; } r -= N1;
            conv_item<CF_GLU>(a, scr, r, F.lane); }
    } else if (SLOT == 1) {
        constexpr int N0 = 4096, N1 = 2048;
        for (int it = widx; it < N0 + N1; it += wcount) { int r = it;
            if (r < N0) { conv_item<CF_U>(a, scr, r, F.lane); continue; } r -= N0;
            conv_item<CF_G>(a, scr, r, F.lane); }
    } else if (SLOT == 4) {
        constexpr int N0 = 16 * 32, N1 = 4096, N2 = 16 * 96;
        for (int it = widx; it < N0 + N1 + N2; it += wcount) { int r = it;
            if (r < N0) { conv_item<CF_CO>(a, scr, r, F.lane); continue; } r -= N0;
            if (r < N1) { conv_item<CF_G>(a, scr, 4096 + r, F.lane); continue; } r -= N1;
            conv_item<CF_QKV>(a, scr, r, F.lane); }
    } else if (SLOT == 3) {
        for (int it = widx; it < 6144; it += wcount) { if (it < 4096) conv_item<CF_D>(a, scr, it, F.lane); else conv_item<CF_G>(a, scr, it - 2048, F.lane); }
    } else {
        for (int it = widx; it < 8192; it += wcount) {
            if (it < 4096) conv_item<CF_U>(a, scr, 4096 + it, F.lane); else conv_item<CF_D>(a, scr, it, F.lane); }
    }
}
__device__ __forceinline__ void p0_prologue(Frame& F, const Args& a) {
    unsigned char* ws = a.ws;
    const int gw = F.vcu * NWAVES + F.wave, NGW = F.G * NWAVES;
    conv_run<0>(F, a, gw, NGW);
    const float* x = a.in[0]; bf16_t* XB = (bf16_t*)(ws + WS_XB); float* ss0 = (float*)(ws + WS_SS0);
    for (int m = gw; m < T; m += NGW) {
        const f32x4* xr = (const f32x4*)(x + (size_t)m * D) + F.lane;
        f32x4 v[4]; float s = 0.f;
#pragma unroll
        for (int j = 0; j < 4; ++j) { v[j] = xr[64 * j]; s += (v[j].x * v[j].x + v[j].y * v[j].y) + (v[j].z * v[j].z + v[j].w * v[j].w); }
        s = wave_sum(s);
        u32x2* o8 = (u32x2*)(XB + (size_t)m * D) + F.lane;
#pragma unroll
        for (int j = 0; j < 4; ++j) { u32x2 w; w.x = pk2(v[j].x, v[j].y); w.y = pk2(v[j].z, v[j].w); o8[64 * j] = w; }
        if (F.lane == 0) __hip_atomic_store(ss0 + m, s, RLX_AGENT);
    }
    s5_tables(ws + WS_S5T, a.in[6], a.in[7], a.in[8], a.in[9], a.in[10], a.in[11], a.in[12], a.in[13], F.vcu * NWAVES * 64 + F.tid, F.G * NWAVES * 64);
    {   float* rtw = (float*)(ws + WS_RTW);
        for (int i = (F.vcu * NWAVES * 64) + F.tid; i < 2 * 20 * 1024; i += F.G * NWAVES * 64) {
            const int layer = i / 20480, r = i - layer * 20480, j = r >> 10, k = r & 1023;
            const float wv = j < 4 ? a.in[18][(size_t)layer * 4096 + k * 4 + j] : a.in[20][(size_t)layer * 16384 + k * 16 + (j - 4)];
            rtw[i] = wv * a.in[2][layer * D + k]; } }
    float* rope = (float*)(ws + WS_ROPE);
    for (int i = (F.vcu * NWAVES * 64) + F.tid; i < L * 64; i += F.G * NWAVES * 64) {
        const int j = i & 63, pos = i >> 6;
        const float inv = powf(10000.0f, -(float)j / 64.0f);
        const float ang = (float)pos * inv;
        rope[i] = cosf(ang); rope[L * 64 + i] = sinf(ang);
    }
}

__device__ __forceinline__ void router_phase(Frame& F, const Args& a, int layer) {
    unsigned char* ws = a.ws;
    LAS float* wT = (LAS float*)F.lds;
    LAS float* gn = wT + 20 * 1024;
    LAS float* bias = gn + 1024;
    LAS int* rcls = (LAS int*)(bias + 32);
    LAS float* rwl = (LAS float*)(rcls + 64);
    LAS float* rwh = rwl + 64;
    LAS int* cbase = (LAS int*)(rwh + 64);
    const float* wg = a.in[18] + (size_t)layer * 4096; const float* bg = a.in[19] + layer * 4;
    const float* wrr = a.in[20] + (size_t)layer * 16384; const float* brr = a.in[21] + layer * 16;
    const float* gain = a.in[2] + layer * D;
    unsigned* cnt = F.ctl + (layer ? CW_CLS1 : CW_CLS0);
    const bf16_t* H = layer ? (const bf16_t*)(ws + WS_XB) : (const bf16_t*)a.out;
    int* list = (int*)(ws + WS_LIST); f32x2* lw = (f32x2*)(ws + WS_LW);
    {   const f32x4* rt = (const f32x4*)(ws + WS_RTW) + (size_t)layer * 5120;
#pragma unroll
        for (int i = 0; i < 10; ++i) ((LAS f32x4*)wT)[F.tid + 512 * i] = rt[F.tid + 512 * i]; }
    if (F.tid < 4) bias[F.tid] = bg[F.tid]; else if (F.tid < 20) bias[F.tid] = brr[F.tid - 4];
    __syncthreads();
    for (int rb = F.vcu; rb < T / 64; rb += F.G) {
        constexpr int RB = 4;
        u32x2 nv[RB][4];
#pragma unroll
        for (int r = 0; r < RB; ++r) { const u32x2* hr0 = (const u32x2*)(H + (size_t)(rb * 64 + F.wave * 8 + r) * D) + F.lane;
#pragma unroll
            for (int j = 0; j < 4; ++j) nv[r][j] = hr0[64 * j]; }
#pragma unroll 1
        for (int rg = 0; rg < 8 / RB; ++rg) {
            const int rloc0 = F.wave * 8 + rg * RB, row0 = rb * 64 + rloc0;
            f32x4 v[RB][4]; float rstd[RB];
#pragma unroll
            for (int r = 0; r < RB; ++r)
#pragma unroll
                for (int j = 0; j < 4; ++j) v[r][j] = (f32x4){bflo(nv[r][j].x), bfhi(nv[r][j].x), bflo(nv[r][j].y), bfhi(nv[r][j].y)};
            if (rg + 1 < 8 / RB) {
#pragma unroll
                for (int r = 0; r < RB; ++r) { const u32x2* hr = (const u32x2*)(H + (size_t)(row0 + RB + r) * D) + F.lane;
#pragma unroll
                    for (int j = 0; j < 4; ++j) nv[r][j] = hr[64 * j]; } }
#pragma unroll
            for (int r = 0; r < RB; ++r) { float s = 0.f;
#pragma unroll
                for (int j = 0; j < 4; ++j) s += (v[r][j].x * v[r][j].x + v[r][j].y * v[r][j].y) + (v[r][j].z * v[r][j].z + v[r][j].w * v[r][j].w);
                rstd[r] = rsqrtf(wave_allsum(s) * (1.0f / D) + RMS_EPS); }
            float lgg[RB][4];
#pragma unroll
            for (int i = 0; i < 4; ++i) { float acc[RB];
#pragma unroll
                for (int r = 0; r < RB; ++r) acc[r] = 0.f;
#pragma unroll
                for (int j = 0; j < 4; ++j) { const f32x4 w4 = *(const LAS f32x4*)(wT + i * 1024 + 256 * j + 4 * F.lane);
#pragma unroll
                    for (int r = 0; r < RB; ++r) acc[r] += (v[r][j].x * w4.x + v[r][j].y * w4.y) + (v[r][j].z * w4.z + v[r][j].w * w4.w); }
                const float bi = bias[i];
#pragma unroll
                for (int r = 0; r < RB; ++r) lgg[r][i] = wave_allsum(acc[r]) * rstd[r] + bi; }
#pragma unroll
            for (int r = 0; r < RB; ++r) {
                const float* lg = lgg[r]; const int rloc = rloc0 + r;
                int gs = 0; float gm = lg[0];
#pragma unroll
                for (int i = 1; i < 4; ++i) if (lg[i] > gm) { gm = lg[i]; gs = i; }
                float se = 0.f;
#pragma unroll
                for (int i = 0; i < 4; ++i) se += expf(lg[i] - gm);
                const float gval = 1.0f / se;
                float ev[4];
#pragma unroll
                for (int i = 0; i < 4; ++i) { const LAS float* wrow = wT + (4 + gs * 4 + i) * 1024; float acc = 0.f;
#pragma unroll
                    for (int j = 0; j < 4; ++j) { const f32x4 w4 = *(const LAS f32x4*)(wrow + 256 * j + 4 * F.lane); acc += (v[r][j].x * w4.x + v[r][j].y * w4.y) + (v[r][j].z * w4.z + v[r][j].w * w4.w); }
                    ev[i] = wave_allsum(acc) * rstd[r] + bias[4 + gs * 4 + i]; }
                int i1 = 0; float v1 = ev[0];
#pragma unroll
                for (int i = 1; i < 4; ++i) if (ev[i] > v1) { v1 = ev[i]; i1 = i; }
                int i2 = -1; float v2 = -3.0e38f;
#pragma unroll
                for (int i = 0; i < 4; ++i) if (i != i1 && ev[i] > v2) { v2 = ev[i]; i2 = i; }
                const float e2 = expf(v2 - v1);
                const float w1 = gval / (1.0f + e2), w2 = gval * e2 / (1.0f + e2);
                const int lo = i1 < i2 ? i1 : i2, hi = i1 < i2 ? i2 : i1;
                const int pidx = lo == 0 ? hi - 1 : (lo == 1 ? hi + 1 : 5);
                if (F.lane == 0) { rcls[rloc] = gs * 6 + pidx; rwl[rloc] = __uint_as_float(pk2(i1 < i2 ? w1 : w2, i1 < i2 ? w2 : w1)); rwh[rloc] = rstd[r]; }
            }
        }
        __syncthreads();
        if (F.tid < 24) { int tot = 0; for (int r = 0; r < 64; ++r) tot += (rcls[r] == F.tid) ? 1 : 0;
            cbase[F.tid] = tot ? (int)__hip_atomic_fetch_add(cnt + 64 * F.tid, (unsigned)tot, RLX_AGENT) : 0; }
        __syncthreads();
        if (F.tid < 64) { const int myc = rcls[F.tid]; int rank = 0; for (int r = 0; r < F.tid; ++r) rank += (rcls[r] == myc) ? 1 : 0;
            const int pos = cbase[myc] + rank; __hip_atomic_store(list + myc * 16384 + pos, rb * 64 + F.tid, RLX_AGENT);
            __hip_atomic_store((unsigned long long*)(lw + myc * 16384 + pos), ((unsigned long long)__float_as_uint(rwh[F.tid]) << 32) | __float_as_uint(rwl[F.tid]), RLX_AGENT); }
        __syncthreads();
    }
}
__device__ __forceinline__ void moe_setup(Frame& F, int layer) {
    LAS int* tb = (LAS int*)(F.lds + MOE_TB_OFF); LAS int* cc = tb + 25;
    if (F.tid == 0) { const unsigned* cnt = F.ctl + (layer ? CW_CLS1 : CW_CLS0); int run = 0;
        for (int c = 0; c < 24; ++c) { const int n = (int)__hip_atomic_load(cnt + 64 * c, RLX_AGENT); cc[c] = n; tb[c] = run; run += (n + 255) >> 8; }
        tb[24] = run; }
    __syncthreads();
}
template <bool LAST>
__device__ __forceinline__ void moe_phases(Frame& F, const Args& a, int layer, int which) {
    unsigned char* ws = a.ws;
    moe_setup(F, layer);
    const LAS int* tb = (const LAS int*)(F.lds + MOE_TB_OFF); const LAS int* cc = tb + 25;
    if (which == 0) {
        MoeOrder S{layer ? (const char*)(ws + WS_XB) : (const char*)a.out, (const char*)(ws + WS_WGU + layer * WS_MOE_LAYER), (const int*)(ws + WS_LIST), tb, cc, 8, F.G, F.vcu, 0, 0, tb[24] * 8};
        EpiGateUp E{(bf16_t*)(ws + WS_P), (const f32x2*)(ws + WS_LW), tb};
        pg8::gemm_phase<EpiGateUp, MoeOrder, true, true, false>(F.lds, 1024, 1024, 1024, S, E);
        if (layer == 0) {
            __syncthreads();
            const int nGU = tb[24] * 8, start = nGU % F.G;
            if (F.vcu >= start) conv_run<4>(F, a, (F.vcu - start) * NWAVES + F.wave, (F.G - start) * NWAVES);
        }
    } else {
        MoeOrder S{(const char*)(ws + WS_P), (const char*)(ws + WS_WD + layer * WS_MOE_LAYER), (const int*)(ws + WS_LIST), tb, cc, 4, F.G, F.vcu, 1, 0, tb[24] * 4};
        EpiDown E{layer ? (const bf16_t*)(ws + WS_XB) : (const bf16_t*)a.out, (bf16_t*)(ws + WS_XB), (float*)(ws + WS_SSP), (const int*)(ws + WS_LIST), tb};
        pg8::gemm_phase<EpiDown, MoeOrder, true, false, true>(F.lds, 1024, 2048, 1024, S, E);
        if (layer == 0) {
            __syncthreads();
            const int nD = tb[24] * 4, start = nD % F.G;
            if (F.vcu >= start) conv_run<2>(F, a, (F.vcu - start) * NWAVES + F.wave, (F.G - start) * NWAVES);
        }
    }
    __syncthreads();
}
template <int SUB>
__device__ __forceinline__ void moe_sub(Frame& F, const Args& a) {
    unsigned char* ws = a.ws; constexpr int layer = 1;
    moe_setup(F, layer);
    const LAS int* tb = (const LAS int*)(F.lds + MOE_TB_OFF); const LAS int* cc = tb + 25;
    const int nt = tb[24], nGU = nt * 8, nD = nt * 4, full = (nGU / F.G) * F.G, rest = nGU - full;
    int dY = F.G - rest; { const int cap = (full >> 3) * 4; dY = dY < cap ? dY : cap; dY = dY < nD ? dY : nD; }
    if (SUB < 2) {
        MoeOrder S{(const char*)(ws + WS_XB), (const char*)(ws + WS_WGU + layer * WS_MOE_LAYER), (const int*)(ws + WS_LIST), tb, cc, 8, F.G, F.vcu, 0, SUB == 0 ? 0 : full, SUB == 0 ? full : nGU};
        EpiGateUp E{(bf16_t*)(ws + WS_P), (const f32x2*)(ws + WS_LW), tb};
        pg8::gemm_phase<EpiGateUp, MoeOrder, true, true, false>(F.lds, 1024, 1024, 1024, S, E);
    }
    if (SUB > 0) {
        MoeOrder S{(const char*)(ws + WS_P), (const char*)(ws + WS_WD + layer * WS_MOE_LAYER), (const int*)(ws + WS_LIST), tb, cc, 4, SUB == 1 ? F.G - rest : F.G, SUB == 1 ? F.vcu - rest : F.vcu, 1, SUB == 1 ? 0 : dY, SUB == 1 ? dY : nD};
        EpiDown E{(const bf16_t*)(ws + WS_XB), (bf16_t*)(ws + WS_XB), (float*)(ws + WS_SSP), (const int*)(ws + WS_LIST), tb};
        pg8::gemm_phase<EpiDown, MoeOrder, true, false, true>(F.lds, 1024, 2048, 1024, S, E);
    }
    __syncthreads();
}
__device__ __forceinline__ void final_phase(Frame& F, const Args& a) {
    const float* ss = (const float*)(a.ws + WS_SSP); const float* gain = a.in[3]; const bf16_t* H = (const bf16_t*)(a.ws + WS_XB);
    const int gw = F.vcu * NWAVES + F.wave, NGW = F.G * NWAVES;
    f32x4 g4[4];
#pragma unroll
    for (int j = 0; j < 4; ++j) g4[j] = *((const f32x4*)gain + F.lane + 64 * j);
    for (int m = gw; m < T; m += NGW) {
        f32x4* hr = (f32x4*)(a.out + (size_t)m * D) + F.lane;
        const u32x2* hs = (const u32x2*)(H + (size_t)m * D) + F.lane;
        const f32x4* sp = (const f32x4*)(ss + (size_t)m * 32);
        const f32x4 s4 = (sp[0] + sp[1]) + (sp[2] + sp[3]);
        const float rstd = rsqrtf(((s4[0] + s4[1]) + (s4[2] + s4[3])) * (1.0f / D) + RMS_EPS);
#pragma unroll
        for (int j = 0; j < 4; ++j) { const u32x2 q = hs[64 * j]; hr[64 * j] = (f32x4){bflo(q.x), bfhi(q.x), bflo(q.y), bfhi(q.y)} * rstd * g4[j]; }
    }
}

__global__ void __launch_bounds__(NWAVES * 64, 2) mega(Args args) {
    extern __shared__ __attribute__((aligned(16))) unsigned char lds[];
    Frame F;
    F.lds = (LAS unsigned char*)lds;
    F.MISC = (volatile LAS unsigned*)(F.lds + MISC_OFF);
    F.tid = threadIdx.x; F.lane = F.tid & 63; F.wave = __builtin_amdgcn_readfirstlane(F.tid >> 6);
    F.G = gridDim.x; { const int bx = blockIdx.x; F.vcu = (F.G % 8 == 0) ? (bx % 8) * (F.G / 8) + bx / 8 : bx; }
    unsigned char* ws = args.ws;
    F.ctl = (unsigned*)ws;
    for (int u = F.tid; u < (LDS_BYTES - LDSCTL_OFF) / 4; u += NWAVES * 64) ((LAS unsigned*)(F.lds + LDSCTL_OFF))[u] = 0u;
    __syncthreads();
    const int lo = args.ph_lo, hi = args.ph_hi;
    XcdBarrier bar; bar.bar = F.ctl + CW_BAR; bar.x = 0; bar.st = nullptr;
    if (hi - lo > 1) bar = xcd_barrier_post(F.ctl + CW_BAR, F.MISC + 8);
#define IN(k) (lo <= (k) && (k) < hi)
#define SEAM(k) do { if (IN(k) && IN((k) + 1)) xcd_barrier(bar); } while (0)

    if (IN(PH_PROLOGUE)) {
        p0_prologue(F, args); SEAM(PH_PROLOGUE); }
    if (IN(PH_INPROJ)) {
        PlainOrder S; S.init(ws + WS_XB, ws + WS_WIN, 1024, 1024, T, 2560, F.G, (int)blockIdx.x);
        EpiInProj E{(bf16_t*)(ws + WS_P), (const float*)(ws + WS_SS0), (const float*)(ws + WS_ROPE)};
        pg8::gemm_phase<EpiInProj, PlainOrder, true, false, false>(F.lds, 1024, 1024, 1024, S, E);
        { const int nun = (T / 256) * 10, start = nun % F.G, bx = (int)blockIdx.x;
          __syncthreads();
          if (bx >= start) conv_run<3>(F, args, (bx - start) * NWAVES + F.wave, (F.G - start) * NWAVES); }
        SEAM(PH_INPROJ);
    }
    if (IN(PH_MIX_A)) {
        for (int u = F.vcu; u < 256; u += F.G) ret_kv_unit(F.lds, (const bf16_t*)(ws + WS_P), (bf16_t*)(ws + WS_XB), u >> 6, (u >> 4) & 3, u & 15, F.tid);
        for (int t = F.vcu * NWAVES + F.wave; t < 2048; t += F.G * NWAVES)
            s5_task<false>((const bf16_t*)(ws + WS_P), ws + WS_S5T, (float*)(ws + WS_S5END), nullptr, F.lds + F.wave * 8704, t >> 9, (t >> 4) & 31, t & 15, F.lane);
        SEAM(PH_MIX_A);
    }
    if (IN(PH_MIX_B)) {
        for (int u = F.vcu; u < 256; u += F.G) ret_out_unit(F.lds, (const bf16_t*)(ws + WS_P), (const bf16_t*)(ws + WS_XB), (bf16_t*)(ws + WS_MG), u >> 6, (u >> 4) & 3, u & 15, F.tid);
        for (int t = F.vcu * NWAVES + F.wave; t < 2048; t += F.G * NWAVES)
        {   const int v_ = t >> 3, wv_ = t & 7;
            s5_task<true>((const bf16_t*)(ws + WS_P), ws + WS_S5T, (float*)(ws + WS_S5END), (bf16_t*)(ws + WS_XB + 8 * MiB), F.lds + F.wave * 8704, v_ >> 6, (v_ & 3) * 8 + wv_, (v_ >> 2) & 15, F.lane); }
        SEAM(PH_MIX_B);
    }
    if (IN(PH_GLU)) {
        PlainOrder S; S.init(ws + WS_XB + 8 * MiB, ws + WS_WGLU, 512, 512, T, 512, F.G, (int)blockIdx.x);
        EpiGlu E{(const bf16_t*)(ws + WS_XB + 8 * MiB), args.in[15], (bf16_t*)(ws + WS_MG)};
        pg8::gemm_phase<EpiGlu, PlainOrder, true, false, false>(F.lds, 512, 512, 512, S, E);
        { const int nun = (T / 256) * 2, bx = (int)blockIdx.x;
          if (bx >= nun && F.G > nun) conv_run<1>(F, args, (bx - nun) * NWAVES + F.wave, (F.G - nun) * NWAVES);
          else if (F.G <= nun) conv_run<1>(F, args, bx * NWAVES + F.wave, F.G * NWAVES); }
        SEAM(PH_GLU);
    }
    if (IN(PH_OUTPROJ0)) {
        PlainOrder S; S.init(ws + WS_MG, ws + WS_WOUT, 1024, 1024, T, 1024, F.G, (int)blockIdx.x);
        EpiOutRes<true> E{args.in[0], nullptr, (bf16_t*)args.out};
        pg8::gemm_phase<EpiOutRes<true>, PlainOrder, true, false, false>(F.lds, 1024, 1024, 1024, S, E);
        SEAM(PH_OUTPROJ0);
    }
    if (IN(PH_ROUTER0)) { router_phase(F, args, 0); SEAM(PH_ROUTER0); }
    if (IN(PH_GATEUP0)) { moe_phases<false>(F, args, 0, 0); SEAM(PH_GATEUP0); }
    if (IN(PH_DOWN0)) { moe_phases<false>(F, args, 0, 1); SEAM(PH_DOWN0); }
    if (IN(PH_QKV)) {
        PlainOrder S; S.init(ws + WS_XB, ws + WS_WQKV, 1024, 1024, T, 3072, F.G, (int)blockIdx.x);
        EpiQKV E{(bf16_t*)(ws + WS_P), (const float*)(ws + WS_SSP), 0.08838834764831845f * 1.4426950408889634f};
        pg8::gemm_phase<EpiQKV, PlainOrder, true, false, false>(F.lds, 1024, 1024, 1024, S, E);
        SEAM(PH_QKV);
    }
    if (IN(PH_ATTN_AB)) {
        const bf16_t* P = (const bf16_t*)(ws + WS_P); float* lse = (float*)(ws + WS_LSE);
        const int per = (2048 + F.G - 1) / F.G; const int u0 = F.vcu * per, u1 = (u0 + per < 2048) ? u0 + per : 2048;
        u32x4 kreg[8], vreg[8];
#define ATT_DEC_AB(u, b_, h_, r_, n_, d_) const int b_ = (u) < 1024 ? (u) >> 8 : ((u) - 1024) >> 8, h_ = (u) < 1024 ? ((u) >> 5) & 7 : (((u) - 1024) >> 5) & 7, r_ = (u) < 1024 ? 0 : (((u) - 1024) >> 3) & 3, n_ = (u) < 1024 ? (u) & 31 : ((u) - 1024) & 7, d_ = (u) < 1024 ? 1 : 4
        bool full = true;
        if (u0 < u1) { ATT_DEC_AB(u0, b0, h0, r0, n0, d0); attn_load(P, b0, h0, r0, n0, d0, F.tid, true, kreg, vreg); }
#pragma unroll 1
        for (int u = u0; u < u1; ++u) {
            ATT_DEC_AB(u, bc, hc, rc, nc, dc);
            attn_store(F.lds, F.tid, nc, full, kreg, vreg);
            __syncthreads();
            bf16x8 qf[4]; attn_loadq(P, bc, hc, rc, nc, dc, F.tid, qf);
            if (u + 1 < u1) { ATT_DEC_AB(u + 1, b1, h1, r1, n1, d1);
                full = !(b1 == bc && h1 == hc && r1 == rc && d1 == dc && n1 == nc + 1);
                attn_load(P, b1, h1, r1, n1, d1, F.tid, full, kreg, vreg); }
            attn_compute<false>(F.lds, P, (u < 1024 ? (bf16_t*)args.out + (size_t)T * D : (bf16_t*)(ws + WS_MG)), lse + (u < 1024 ? 0 : (size_t)T * 8), nullptr, nullptr, nullptr, nullptr, bc, hc, rc, nc, dc, F.tid, qf);
            __syncthreads();
        }
        SEAM(PH_ATTN_AB);
    }
    if (IN(PH_ATTN_C)) {
        const bf16_t* P = (const bf16_t*)(ws + WS_P); float* lse = (float*)(ws + WS_LSE);
        const int per = (1024 + F.G - 1) / F.G; const int u0 = F.vcu * per, u1 = (u0 + per < 1024) ? u0 + per : 1024;
        u32x4 kreg[8], vreg[8];
        bool full = true;
        if (u0 < u1) attn_load(P, u0 >> 8, (u0 >> 5) & 7, (u0 >> 1) & 15, u0 & 1, 16, F.tid, true, kreg, vreg);
#pragma unroll 1
        for (int u = u0; u < u1; ++u) {
            attn_store(F.lds, F.tid, u & 1, full, kreg, vreg);
            __syncthreads();
            bf16x8 qf[4]; attn_loadq(P, u >> 8, (u >> 5) & 7, (u >> 1) & 15, u & 1, 16, F.tid, qf);
            if (u + 1 < u1) { full = !(((u + 1) >> 1) == (u >> 1) && ((u + 1) & 1) == (u & 1) + 1);
                attn_load(P, (u + 1) >> 8, ((u + 1) >> 5) & 7, ((u + 1) >> 1) & 15, (u + 1) & 1, 16, F.tid, full, kreg, vreg); }
            attn_compute<true>(F.lds, P, (bf16_t*)(ws + WS_MG), nullptr, (const bf16_t*)args.out + (size_t)T * D, (const bf16_t*)(ws + WS_MG), lse, lse + (size_t)T * 8, u >> 8, (u >> 5) & 7, (u >> 1) & 15, u & 1, 16, F.tid, qf);
            __syncthreads();
        }
        SEAM(PH_ATTN_C);
    }
    if (IN(PH_OUTPROJ1)) {
        PlainOrder S; S.init(ws + WS_MG, ws + WS_CWOUT, 1024, 1024, T, 1024, F.G, (int)blockIdx.x);
        EpiOutRes<false> E{nullptr, (const bf16_t*)(ws + WS_XB), (bf16_t*)(ws + WS_XB)};
        pg8::gemm_phase<EpiOutRes<false>, PlainOrder, true, false, false>(F.lds, 1024, 1024, 1024, S, E);
        SEAM(PH_OUTPROJ1);
    }
    if (IN(PH_ROUTER1)) { router_phase(F, args, 1); SEAM(PH_ROUTER1); }
    if (IN(PH_MOE1X)) { moe_sub<0>(F, args); SEAM(PH_MOE1X); }
    if (IN(PH_MOE1Y)) { moe_sub<1>(F, args); SEAM(PH_MOE1Y); }
    if (IN(PH_MOE1Z)) { moe_sub<2>(F, args); SEAM(PH_MOE1Z); }
    if (IN(PH_FINAL)) { final_phase(F, args); }
#undef IN
#undef SEAM
}

extern "C" void kernel_launch(void* const* d_in, const int* in_sizes, int n_in, void* d_out, int out_size, void* d_ws, size_t ws_size, hipStream_t stream) {
    static int grid = 0;
    if (grid == 0) {
        if (ws_size < WS_END || n_in != 25) { fprintf(stderr, "kernel_launch: ws %zu < %zu or n_in %d\n", ws_size, (size_t)WS_END, n_in); grid = -1; return; }
        int dev = 0, cus = 0;
        if (hipGetDevice(&dev) != hipSuccess || hipDeviceGetAttribute(&cus, hipDeviceAttributeMultiprocessorCount, dev) != hipSuccess) { grid = -1; return; }
        if (hipFuncSetAttribute((const void*)mega, hipFuncAttributeMaxDynamicSharedMemorySize, LDS_BYTES) != hipSuccess) { fprintf(stderr, "hipFuncSetAttribute failed\n"); grid = -1; return; }
        int per_cu = 0;
        if (hipOccupancyMaxActiveBlocksPerMultiprocessor(&per_cu, (const void*)mega, NWAVES * 64, LDS_BYTES) != hipSuccess || per_cu < 1) fprintf(stderr, "occupancy query says %d\n", per_cu);
        (void)hipGetLastError();
        grid = cus;
    }
    if (grid < 0) return;
    unsigned char* ws = (unsigned char*)d_ws;
    (void)hipMemsetAsync(ws, 0, CTL_ZERO_BYTES, stream);
    Args a{};
    for (int i = 0; i < 25; ++i) a.in[i] = (const float*)d_in[i];
    a.out = (float*)d_out; a.ws = ws;
    a.ph_lo = 0; a.ph_hi = PH_COUNT;
    hipLaunchKernelGGL(mega, dim3(grid), dim3(NWAVES * 64), LDS_BYTES, stream, a);
}
```
